# Optimizing an MI355X kernel written in HIP

```python
import math
import jax, jax.numpy as jnp
from jax import lax
import numpy as np

D_MODEL = 2048
BATCH = 4
SEQ = 2048
DEPTH = 1
DEC_BATCH = 128
DEC_SEQ = 8
PAST_LEN = 16384
PAGE_SIZE = 128

MIX_A = D_MODEL // 2
MIX_B = D_MODEL - MIX_A
DN_HEAD_DIM = 128
DN_HEADS = MIX_A // DN_HEAD_DIM
CONV_WIDTH = 4
CHUNK = 64
S5_GROUP = 16
S5_GROUPS = MIX_B // S5_GROUP
S5_STATE = 64
QKV_DIM = 3 * MIX_A
PROJ_DIM = QKV_DIM + MIX_A + 2 * DN_HEADS + MIX_B
D_FF = ((8 * D_MODEL + 767) // 768) * 256
EPS = 1e-6

kernel_name = 'hybrid_gdn_s5_decoder_step'


def rmsnorm(x, w):
    x32 = x.astype(jnp.float32)
    y = x32 * lax.rsqrt(jnp.mean(x32 * x32, axis=-1, keepdims=True) + EPS)
    return (y * w.astype(jnp.float32)).astype(x.dtype)


def l2norm(x):
    return x * lax.rsqrt(jnp.sum(x * x, axis=-1, keepdims=True) + 1e-6)


def gated_delta_rule(q, k, v, g, beta, s0):
    bsz, t, h, _ = q.shape
    dv = v.shape[-1]
    c = CHUNK if t >= CHUNK else t
    pad = (-t) % c
    if pad:
        pw = ((0, 0), (0, pad), (0, 0), (0, 0))
        q, k, v = jnp.pad(q, pw), jnp.pad(k, pw), jnp.pad(v, pw)
        g, beta = jnp.pad(g, pw[:3]), jnp.pad(beta, pw[:3])
    n = (t + pad) // c

    def chunks(a):
        a = a.reshape((bsz, n, c, h) + a.shape[3:])
        return jnp.moveaxis(a, 3, 2).swapaxes(0, 1)

    qc, kc, vc, gc, bc = [chunks(a) for a in (q, k, v, g, beta)]
    gcum = jnp.cumsum(gc, axis=-1)
    idx = jnp.arange(c)
    causal = idx[:, None] >= idx[None, :]
    strict = idx[:, None] > idx[None, :]
    decay = jnp.exp(jnp.where(causal, gcum[..., :, None] - gcum[..., None, :], -jnp.inf))
    kb = kc * bc[..., None]
    lmat = jnp.where(strict, jnp.einsum('nbhik,nbhjk->nbhij', kb, kc) * decay, 0.0)
    eye = jnp.broadcast_to(jnp.eye(c, dtype=jnp.float32), lmat.shape)
    tinv = lax.linalg.triangular_solve(eye + lmat, eye, left_side=True, lower=True)
    u = jnp.einsum('nbhij,nbhjv->nbhiv', tinv, vc * bc[..., None])
    w = jnp.einsum('nbhij,nbhjk->nbhik', tinv, kb * jnp.exp(gcum)[..., None])
    attn = jnp.einsum('nbhik,nbhjk->nbhij', qc, kc) * decay

    def step(s, xs):
        q_i, k_i, u_i, w_i, a_i, g_i = xs
        v_new = u_i - jnp.einsum('bhck,bhkv->bhcv', w_i, s)
        o = (jnp.einsum('bhck,bhkv->bhcv', q_i * jnp.exp(g_i)[..., None], s)
             + jnp.einsum('bhij,bhjv->bhiv', a_i, v_new))
        g_last = g_i[..., -1]
        s = (s * jnp.exp(g_last)[..., None, None]
             + jnp.einsum('bhck,bhcv->bhkv', k_i * jnp.exp(g_last[..., None] - g_i)[..., None], v_new))
        return s, o

    s_fin, o = lax.scan(step, s0, (qc, kc, u, w, attn, gcum))
    o = jnp.moveaxis(o.swapaxes(0, 1), 2, 3).reshape(bsz, n * c, h, dv)[:, :t]
    return o, s_fin


def s5_ssm(u, lam_re, lam_im, log_step, b_re, b_im, c_re, c_im, d_skip, h0_re, h0_im):
    f32 = jnp.float32
    u = u.astype(f32)
    lre = jnp.minimum(lam_re.astype(f32), -1e-4)
    lim = lam_im.astype(f32)
    dt = jnp.exp(log_step.astype(f32))[:, None]
    mag = jnp.exp(lre * dt)
    ang = lim * dt
    ab_re, ab_im = mag * jnp.cos(ang), mag * jnp.sin(ang)
    nr, ni = ab_re - 1.0, ab_im
    den = lre * lre + lim * lim
    co_re = (nr * lre + ni * lim) / den
    co_im = (ni * lre - nr * lim) / den
    br, bi = b_re.astype(f32), b_im.astype(f32)
    bb_re = co_re[..., None] * br - co_im[..., None] * bi
    bb_im = co_re[..., None] * bi + co_im[..., None] * br
    bu_re = jnp.einsum('btgh,gph->btgp', u, bb_re)
    bu_im = jnp.einsum('btgh,gph->btgp', u, bb_im)
    h0r, h0i = h0_re.astype(f32), h0_im.astype(f32)
    bu_re = bu_re.at[:, 0].add(ab_re * h0r - ab_im * h0i)
    bu_im = bu_im.at[:, 0].add(ab_re * h0i + ab_im * h0r)
    a_re = jnp.broadcast_to(ab_re, bu_re.shape)
    a_im = jnp.broadcast_to(ab_im, bu_im.shape)

    def combine(e1, e2):
        a1r, a1i, b1r, b1i = e1
        a2r, a2i, b2r, b2i = e2
        return (a2r * a1r - a2i * a1i, a2r * a1i + a2i * a1r,
                a2r * b1r - a2i * b1i + b2r, a2r * b1i + a2i * b1r + b2i)

    _, _, h_re, h_im = lax.associative_scan(combine, (a_re, a_im, bu_re, bu_im), axis=1)
    y = (jnp.einsum('ghp,btgp->btgh', c_re.astype(f32), h_re)
         - jnp.einsum('ghp,btgp->btgh', c_im.astype(f32), h_im)
         + d_skip.astype(f32) * u)
    return y, h_re[:, -1], h_im[:, -1]


def decoder_layer(x, c, conv_buf, s0, h0_re, h0_im,
                  w_ada, b_ada, g_pre_mix, g_post_mix, g_pre_ffn, g_post_ffn,
                  w_in, w_conv, a_log, dt_bias, g_dn_out,
                  lam_re, lam_im, log_step, b_re, b_im, c_re, c_im, d_skip,
                  w_glu, g_s5_out, w_out, w_gate, w_up, w_down):
    f32 = jnp.float32
    bsz, t, _ = x.shape
    mod = jax.nn.silu(c) @ w_ada + b_ada
    sh1, sc1, gt1, sh2, sc2, gt2 = [m[:, None, :] for m in jnp.split(mod, 6, axis=-1)]

    h = rmsnorm(x, g_pre_mix) * (1 + sc1) + sh1
    proj = h @ w_in
    cuts = [QKV_DIM, QKV_DIM + MIX_A, QKV_DIM + MIX_A + DN_HEADS, QKV_DIM + MIX_A + 2 * DN_HEADS]
    qkv, z, a_raw, b_raw, u = jnp.split(proj, cuts, axis=-1)

    xcat = jnp.concatenate([conv_buf.astype(qkv.dtype), qkv], axis=1)
    conv = sum(xcat[:, j:j + t] * w_conv[j] for j in range(CONV_WIDTH))
    new_conv = xcat[:, t:]
    qkv = jax.nn.silu(conv.astype(f32))
    q, k, v = [a.reshape(bsz, t, DN_HEADS, DN_HEAD_DIM) for a in jnp.split(qkv, 3, axis=-1)]
    q = l2norm(q) * (DN_HEAD_DIM ** -0.5)
    k = l2norm(k)
    beta = jax.nn.sigmoid(b_raw.astype(f32))
    g = -jnp.exp(a_log.astype(f32)) * jax.nn.softplus(a_raw.astype(f32) + dt_bias.astype(f32))
    o, s_new = gated_delta_rule(q, k, v, g, beta, s0.astype(f32))
    o = rmsnorm(o, g_dn_out) * jax.nn.silu(z.astype(f32).reshape(bsz, t, DN_HEADS, DN_HEAD_DIM))
    o = o.reshape(bsz, t, MIX_A).astype(x.dtype)

    y5, hr, hi = s5_ssm(u.reshape(bsz, t, S5_GROUPS, S5_GROUP), lam_re, lam_im, log_step,
                        b_re, b_im, c_re, c_im, d_skip, h0_re, h0_im)
    y5 = jax.nn.gelu(y5.reshape(bsz, t, MIX_B)).astype(x.dtype)
    ab = y5 @ w_glu
    y5 = ab[..., :MIX_B] * jax.nn.sigmoid(ab[..., MIX_B:])
    y5 = rmsnorm(y5, g_s5_out)

    mix = jnp.concatenate([o, y5], axis=-1) @ w_out
    x = x + gt1 * rmsnorm(mix, g_post_mix)

    h = rmsnorm(x, g_pre_ffn) * (1 + sc2) + sh2
    f = (jax.nn.silu(h @ w_gate) * (h @ w_up)) @ w_down
    x = x + gt2 * rmsnorm(f, g_post_ffn)
    return x, new_conv.astype(x.dtype), s_new.astype(x.dtype), hr.astype(x.dtype), hi.astype(x.dtype)


def setup_inputs(seed: int = 0) -> dict:
    key = jax.random.key(seed)
    ks = iter(jax.random.split(key, 48))
    nrm = lambda shape, s: jax.random.normal(next(ks), shape, jnp.float32) * s
    L = DEPTH
    gain = lambda n: 1.0 + nrm((L, n), 0.01)
    dt = jnp.exp(jax.random.uniform(next(ks), (L, DN_HEADS), jnp.float32, math.log(1e-3), math.log(1e-1)))
    lam_im0 = jnp.broadcast_to(math.pi * jnp.arange(S5_STATE, dtype=jnp.float32), (L, S5_GROUPS, S5_STATE))
    return {
        'x_prompt': nrm((BATCH, SEQ, D_MODEL), 1.0),
        'x_sample': nrm((DEC_BATCH, DEC_SEQ, D_MODEL), 1.0),
        'c_prompt': nrm((BATCH, D_MODEL), 1.0),
        'c_sample': nrm((DEC_BATCH, D_MODEL), 1.0),
        'state_conv': nrm((L, DEC_BATCH, CONV_WIDTH - 1, QKV_DIM), 1.0),
        'state_delta': nrm((L, DEC_BATCH, DN_HEADS, DN_HEAD_DIM, DN_HEAD_DIM), 0.1),
        'state_ssm_re': nrm((L, DEC_BATCH, S5_GROUPS, S5_STATE), 0.5),
        'state_ssm_im': nrm((L, DEC_BATCH, S5_GROUPS, S5_STATE), 0.5),
        'w_ada': nrm((L, D_MODEL, 6 * D_MODEL), D_MODEL ** -0.5),
        'b_ada': nrm((L, 6 * D_MODEL), 0.01),
        'g_pre_mix': gain(D_MODEL),
        'g_post_mix': gain(D_MODEL),
        'g_pre_ffn': gain(D_MODEL),
        'g_post_ffn': gain(D_MODEL),
        'w_in': nrm((L, D_MODEL, PROJ_DIM), D_MODEL ** -0.5),
        'w_conv': nrm((L, CONV_WIDTH, QKV_DIM), CONV_WIDTH ** -0.5),
        'a_log': jnp.log(jax.random.uniform(next(ks), (L, DN_HEADS), jnp.float32, 1.0, 16.0)),
        'dt_bias': dt + jnp.log(-jnp.expm1(-dt)),
        'g_dn_out': gain(DN_HEAD_DIM),
        'lam_re': -0.5 + nrm((L, S5_GROUPS, S5_STATE), 0.01),
        'lam_im': lam_im0 + nrm((L, S5_GROUPS, S5_STATE), 0.01),
        'log_step': jax.random.uniform(next(ks), (L, S5_GROUPS), jnp.float32, math.log(1e-3), math.log(1e-1)),
        'b_re': nrm((L, S5_GROUPS, S5_STATE, S5_GROUP), (2 * S5_GROUP) ** -0.5),
        'b_im': nrm((L, S5_GROUPS, S5_STATE, S5_GROUP), (2 * S5_GROUP) ** -0.5),
        'c_re': nrm((L, S5_GROUPS, S5_GROUP, S5_STATE), (2 * S5_STATE) ** -0.5),
        'c_im': nrm((L, S5_GROUPS, S5_GROUP, S5_STATE), (2 * S5_STATE) ** -0.5),
        'd_skip': nrm((L, S5_GROUPS, S5_GROUP), 1.0),
        'w_glu': nrm((L, MIX_B, 2 * MIX_B), MIX_B ** -0.5),
        'g_s5_out': gain(MIX_B),
        'w_out': nrm((L, D_MODEL, D_MODEL), D_MODEL ** -0.5),
        'w_gate': nrm((L, D_MODEL, D_FF), D_MODEL ** -0.5),
        'w_up': nrm((L, D_MODEL, D_FF), D_MODEL ** -0.5),
        'w_down': nrm((L, D_FF, D_MODEL), D_FF ** -0.5),
    }


def reference(x_prompt, x_sample, c_prompt, c_sample, state_conv, state_delta, state_ssm_re, state_ssm_im,
              w_ada, b_ada, g_pre_mix, g_post_mix, g_pre_ffn, g_post_ffn,
              w_in, w_conv, a_log, dt_bias, g_dn_out,
              lam_re, lam_im, log_step, b_re, b_im, c_re, c_im, d_skip,
              w_glu, g_s5_out, w_out, w_gate, w_up, w_down):
    weights = (w_ada, b_ada, g_pre_mix, g_post_mix, g_pre_ffn, g_post_ffn,
               w_in, w_conv, a_log, dt_bias, g_dn_out,
               lam_re, lam_im, log_step, b_re, b_im, c_re, c_im, d_skip,
               w_glu, g_s5_out, w_out, w_gate, w_up, w_down)
    bp = x_prompt.shape[0]
    dt_ = x_prompt.dtype
    yp, ys = x_prompt, x_sample
    pc, pd, pr, pim, sc, sd, sr, sim = [], [], [], [], [], [], [], []
    for l in range(DEPTH):
        lw = [w[l] for w in weights]
        zc = jnp.zeros((bp, CONV_WIDTH - 1, QKV_DIM), dt_)
        zd = jnp.zeros((bp, DN_HEADS, DN_HEAD_DIM, DN_HEAD_DIM), dt_)
        zs = jnp.zeros((bp, S5_GROUPS, S5_STATE), dt_)
        yp, c1, d1, r1, i1 = decoder_layer(yp, c_prompt, zc, zd, zs, zs, *lw)
        ys, c2, d2, r2, i2 = decoder_layer(ys, c_sample, state_conv[l], state_delta[l],
                                           state_ssm_re[l], state_ssm_im[l], *lw)
        pc.append(c1); pd.append(d1); pr.append(r1); pim.append(i1)
        sc.append(c2); sd.append(d2); sr.append(r2); sim.append(i2)
    conv_prompt, delta_prompt = jnp.stack(pc), jnp.stack(pd)
    ssm_re_prompt, ssm_im_prompt = jnp.stack(pr), jnp.stack(pim)
    conv_sample, delta_sample = jnp.stack(sc), jnp.stack(sd)
    ssm_re_sample, ssm_im_sample = jnp.stack(sr), jnp.stack(sim)
    return (yp, ys, conv_prompt, delta_prompt, ssm_re_prompt, ssm_im_prompt,
            conv_sample, delta_sample, ssm_re_sample, ssm_im_sample)
```

```cpp
#ifndef HOST_EMU
#include <hip/hip_runtime.h>
#include <hip/hip_cooperative_groups.h>
#endif
#include <cstdio>
#include <cstdint>
#include <cmath>

#ifdef HOST_EMU
constexpr int D_MODEL = 512, BATCH = 2, SEQ = 128, DEC_BATCH = 32, DEC_SEQ = 8;
#else
constexpr int D_MODEL = 2048, BATCH = 4, SEQ = 2048, DEC_BATCH = 128, DEC_SEQ = 8;
#endif
constexpr int D = D_MODEL, MIX_A = D / 2, MIX_B = D - MIX_A, HD = 128, NH = MIX_A / HD, CHUNK = 64, NG = MIX_B / 16, NP = 64;
constexpr int QKV = 3 * MIX_A, PROJ = QKV + MIX_A + 2 * NH + MIX_B;
constexpr int D_FF = ((8 * D + 767) / 768) * 256;
constexpr int MP = BATCH * SEQ, MS = DEC_BATCH * DEC_SEQ, M = MP + MS, NB = BATCH + DEC_BATCH;
constexpr int NIN = QKV + MIX_A + MIX_B + 256;
constexpr int NT_QKV = QKV / 256, NT_Z = MIX_A / 256, NT_U = MIX_B / 256;
constexpr float EPS = 1e-6f;
static_assert(MP % 256 == 0 && MS % 256 == 0 && D % 256 == 0 && QKV % 256 == 0 && MIX_A % 256 == 0 && D_FF % 128 == 0 && 2 * NH <= 16, "shape");
static_assert(MIX_A == MIX_B && SEQ % CHUNK == 0 && DEC_SEQ == 8 && DEC_BATCH % 4 == 0, "shape");

#ifdef HOST_EMU
#define LAS
#define GAS
#define DEVI inline
#define WAIT_VM(n)
#define WAIT_LGKM(n)
#define CFENCE()
#define WAVE_LDS_SYNC() emu_wave_sync()
DEVI float f_exp(float x) { return expf(x); }
DEVI float f_rsqrt(float x) { return 1.0f / sqrtf(x); }
DEVI float f_sin(float x) { return sinf(x); }
DEVI float f_cos(float x) { return cosf(x); }
DEVI float f_rcp(float x) { return 1.0f / x; }
#else
#define LAS __attribute__((address_space(3)))
#define GAS __attribute__((address_space(1)))
#define DEVI __device__ __forceinline__
#define WAIT_VM(n) asm volatile("s_waitcnt vmcnt(" #n ")" ::: "memory")
#define WAIT_LGKM(n) asm volatile("s_waitcnt lgkmcnt(" #n ")" ::: "memory")
#define CFENCE() asm volatile("" ::: "memory")
#define WAVE_LDS_SYNC() asm volatile("s_waitcnt lgkmcnt(0)" ::: "memory")
DEVI float f_exp(float x) { return __expf(x); }
DEVI float f_rsqrt(float x) { return rsqrtf(x); }
DEVI float f_sin(float x) { return sinf(x); }
DEVI float f_cos(float x) { return cosf(x); }
DEVI float f_rcp(float x) { return __builtin_amdgcn_rcpf(x); }
namespace cg = cooperative_groups;
#endif

typedef unsigned short bf16;
typedef short bf16x8 __attribute__((ext_vector_type(8)));
typedef float f32x4 __attribute__((ext_vector_type(4)));
typedef float f32x16 __attribute__((ext_vector_type(16)));
typedef unsigned u32x4 __attribute__((ext_vector_type(4)));
typedef unsigned u32x2 __attribute__((ext_vector_type(2)));

DEVI unsigned f2bf(float f) { unsigned u = __builtin_bit_cast(unsigned, f); return (u + 0x7fffu + ((u >> 16) & 1u)) >> 16; }
DEVI float bf2f(unsigned h) { return __builtin_bit_cast(float, (h & 0xffffu) << 16); }
#ifndef HOST_EMU
typedef float f32x2_ __attribute__((ext_vector_type(2)));
typedef __bf16 bf16x2_ __attribute__((ext_vector_type(2)));
#endif
DEVI unsigned pk2(float lo, float hi) {
#ifdef HOST_EMU
    return f2bf(lo) | (f2bf(hi) << 16);
#else
    const f32x2_ v = {lo, hi}; return __builtin_bit_cast(unsigned, __builtin_convertvector(v, bf16x2_));
#endif
}
DEVI float sigmoidf_(float x) { return f_rcp(1.0f + f_exp(-x)); }
DEVI float siluf_(float x) { return x * sigmoidf_(x); }
DEVI float geluf_(float x) { const float u = 0.7978845608028654f * (x + 0.044715f * x * x * x); const float e = f_exp(2.0f * u); return 0.5f * x * (2.0f - 2.0f * f_rcp(e + 1.0f)); }
DEVI float wave_sum(float v) {
#pragma unroll
    for (int o = 1; o < 64; o <<= 1) v += __shfl_xor(v, o);
    return v;
}

namespace pg8 {
constexpr int BM = 256, BK = 64, HALF = 128, HTB = HALF * BK * 2, STAGE_BYTES = 8 * HTB, NXCD = 8, WGM = 8;
DEVI int lds_byte(int r, int c) { const int st = (r >> 4) * 2 + (c >> 5), rr = r & 15, cc = c & 31, ob = rr * 64 + cc * 2; return st * 1024 + (ob ^ (((ob >> 9) & 1) << 5)); }
DEVI void stage_rc(int b, int& R, int& C) { const int st = b / 1024, sb = b % 1024, swz = sb ^ (((sb >> 9) & 1) << 5); R = (st >> 1) * 16 + swz / 64; C = (st & 1) * 32 + (swz % 64) / 2; }
DEVI int perm32(int rho) { const int n = rho >> 4, i = rho & 15; return 8 * (i >> 2) + 4 * n + (i & 3); }
struct Unit { int pm, pn; };
struct Gemm { const bf16* A; const bf16* Bt; int M, N, K; };
struct StaticOrder {
    int nM, nN, nwg, G, c;
    DEVI void init(int M_, int N_, int G_, int c_) { nM = M_ / BM; nN = N_ / BM; nwg = nM * nN; G = G_; c = c_; }
    DEVI bool next(int i, Unit& u) const {
        const long L = (long)i * G + c; if (L >= nwg) return false;
        int wgid = (int)L; { const int q = nwg / NXCD, r = nwg % NXCD, xcd = wgid % NXCD, off = wgid / NXCD; wgid = (xcd < r ? xcd * (q + 1) : r * (q + 1) + (xcd - r) * q) + off; }
        const int nig = WGM * nN, gid = wgid / nig, fm = gid * WGM, gsz = (nM - fm) < WGM ? (nM - fm) : WGM;
        u.pm = fm + ((wgid % nig) % gsz); u.pn = (wgid % nig) / gsz; return true;
    }
};
template <class Epi, bool ALIGN_EPI, bool SP2>
DEVI void gemm_phase(LAS unsigned char* lds, const Gemm g, const StaticOrder& S, const Epi& E) {
    const int tid = threadIdx.x, wid = __builtin_amdgcn_readfirstlane(tid >> 6), lane = tid & 63, wr = wid >> 2, wc = wid & 3, fr = lane & 15, fq = lane >> 4;
    const int K = g.K, nt = K / BK;
    unsigned voffA[2], voffB[2];
#pragma unroll
    for (int i = 0; i < 2; ++i) { int R, C; stage_rc(tid * 16 + i * 8192, R, C); const int Rb = Epi::PERM ? ((R & ~31) + perm32(R & 31)) : R;
        voffA[i] = (unsigned)(R * K + C) * 2u; voffB[i] = (unsigned)(Rb * K + C) * 2u; }
    const size_t kstep = (size_t)(BK * 2);
    const size_t hstep = (size_t)HALF * K * 2;
    const size_t tstep = 2 * hstep;
    const unsigned ldsw = (unsigned)wid * 1024u;
    const int aoff = lds_byte(wr * 64 + fr, fq * 8), boff = lds_byte(wc * 32 + fr, fq * 8);
#define PG8_SA(b, h) (((b) * 2 + (h)) * HTB)
#define PG8_SB(b, h) ((4 + (b) * 2 + (h)) * HTB)
#define PG8_STAGE(bufoff, gbase, voff) do { _Pragma("unroll") for (int _i = 0; _i < 2; ++_i) \
        __builtin_amdgcn_global_load_lds((const unsigned*)((const char*)(gbase) + (voff)[_i]), (LAS unsigned*)(lds + (bufoff) + ldsw + _i * 8192), 16, 0, 0); } while (0)
#define PG8_LDA(dst, b, h) do { _Pragma("unroll") for (int m = 0; m < 4; ++m) _Pragma("unroll") for (int k = 0; k < 2; ++k) dst[m][k] = *(const LAS bf16x8*)(lds + PG8_SA(b, h) + aoff + m * 2048 + k * 1024); } while (0)
#define PG8_LDB(dst, b, h) do { _Pragma("unroll") for (int n = 0; n < 2; ++n) _Pragma("unroll") for (int k = 0; k < 2; ++k) dst[n][k] = *(const LAS bf16x8*)(lds + PG8_SB(b, h) + boff + n * 2048 + k * 1024); } while (0)
#define PG8_MMA(ai, bj, At, Bt) do { __builtin_amdgcn_s_setprio(1); _Pragma("unroll") for (int m = 0; m < 4; ++m) _Pragma("unroll") for (int n = 0; n < 2; ++n) _Pragma("unroll") for (int k = 0; k < 2; ++k) \
        acc[ai][bj][m][n] = __builtin_amdgcn_mfma_f32_16x16x32_bf16(Bt[n][k], At[m][k], acc[ai][bj][m][n], 0, 0, 0); __builtin_amdgcn_s_setprio(0); } while (0)
#define PG8_WAIT_V(n) WAIT_VM(n)
#define PG8_WAIT_L(n) WAIT_LGKM(n)
#define PG8_BAR __builtin_amdgcn_s_barrier()
#define PG8_SCHED __builtin_amdgcn_sched_barrier(0)
    Unit cur, nxt; int ui = 0;
    if (!S.next(0, cur)) return;
    f32x4 acc[2][2][4][2];
#pragma unroll
    for (int a = 0; a < 2; ++a)
#pragma unroll
        for (int b = 0; b < 2; ++b)
#pragma unroll
            for (int m = 0; m < 4; ++m)
#pragma unroll
                for (int n = 0; n < 2; ++n) acc[a][b][m][n] = (f32x4){0.f, 0.f, 0.f, 0.f};
    bf16x8 At[4][2], B0[2][2], B1[2][2];
    const char* cA = (const char*)g.A + (size_t)cur.pm * tstep; const char* cB = (const char*)g.Bt + (size_t)cur.pn * tstep;
    if constexpr (SP2) {
        PG8_STAGE(PG8_SB(0, 0), cB, voffB); PG8_STAGE(PG8_SB(0, 1), cB + hstep, voffB); PG8_STAGE(PG8_SA(0, 0), cA, voffA); PG8_STAGE(PG8_SA(0, 1), cA + hstep, voffA);
        if (wr == 1) PG8_BAR;
        PG8_WAIT_V(2); PG8_BAR;
        PG8_STAGE(PG8_SB(1, 0), cB + kstep, voffB); PG8_STAGE(PG8_SA(1, 0), cA + kstep, voffA); PG8_STAGE(PG8_SB(1, 1), cB + hstep + kstep, voffB);
        PG8_WAIT_V(6); PG8_BAR;
    } else {
        PG8_STAGE(PG8_SB(0, 0), cB, voffB); PG8_STAGE(PG8_SA(0, 0), cA, voffA); PG8_STAGE(PG8_SB(0, 1), cB + hstep, voffB); PG8_STAGE(PG8_SA(0, 1), cA + hstep, voffA);
        if (wr == 1) PG8_BAR;
        PG8_WAIT_V(4); PG8_BAR;
        PG8_STAGE(PG8_SB(1, 0), cB + kstep, voffB); PG8_STAGE(PG8_SA(1, 0), cA + kstep, voffA); PG8_STAGE(PG8_SB(1, 1), cB + hstep + kstep, voffB);
        PG8_WAIT_V(6); PG8_BAR;
    }
    for (;;) {
        const bool has_next = S.next(ui + 1, nxt);
        const char* nA = has_next ? (const char*)g.A + (size_t)nxt.pm * tstep : cA; const char* nB = has_next ? (const char*)g.Bt + (size_t)nxt.pn * tstep : cB;
#define PG8_KBODY \
            const bool last = (t == nt - 2); \
            const char* a1 = cA + (size_t)(t + 1) * kstep; \
            const char* a2 = last ? nA : cA + (size_t)(t + 2) * kstep; const char* b2 = last ? nB : cB + (size_t)(t + 2) * kstep; \
            const char* a3 = a2 + kstep; const char* b3 = b2 + kstep; \
            if constexpr (SP2) { \
            PG8_LDB(B0, 0, 0); PG8_LDB(B1, 0, 1); PG8_SCHED; PG8_LDA(At, 0, 0); PG8_STAGE(PG8_SA(1, 1), a1 + hstep, voffA); \
            PG8_WAIT_V(8); PG8_WAIT_L(0); PG8_BAR; PG8_MMA(0, 0, At, B0); PG8_MMA(0, 1, At, B1); PG8_BAR; PG8_SCHED; \
            PG8_LDA(At, 0, 1); PG8_STAGE(PG8_SB(0, 0), b2, voffB); PG8_STAGE(PG8_SB(0, 1), b2 + hstep, voffB); PG8_STAGE(PG8_SA(0, 0), a2, voffA); \
            PG8_WAIT_V(8); PG8_WAIT_L(0); PG8_BAR; PG8_MMA(1, 0, At, B0); PG8_MMA(1, 1, At, B1); PG8_BAR; PG8_SCHED; \
            PG8_LDB(B0, 1, 0); PG8_LDB(B1, 1, 1); PG8_SCHED; PG8_LDA(At, 1, 0); PG8_STAGE(PG8_SA(0, 1), a2 + hstep, voffA); \
            PG8_WAIT_V(8); PG8_WAIT_L(0); PG8_BAR; PG8_MMA(0, 0, At, B0); PG8_MMA(0, 1, At, B1); PG8_BAR; PG8_SCHED; \
            PG8_LDA(At, 1, 1); PG8_STAGE(PG8_SB(1, 0), b3, voffB); PG8_STAGE(PG8_SB(1, 1), b3 + hstep, voffB); PG8_STAGE(PG8_SA(1, 0), a3, voffA); \
            PG8_WAIT_V(8); PG8_WAIT_L(0); PG8_BAR; PG8_MMA(1, 0, At, B0); PG8_MMA(1, 1, At, B1); PG8_BAR; PG8_SCHED; \
            } else { \
            PG8_LDB(B0, 0, 0); PG8_SCHED; PG8_LDA(At, 0, 0); PG8_STAGE(PG8_SA(1, 1), a1 + hstep, voffA); \
            PG8_WAIT_L(8); PG8_BAR; PG8_WAIT_L(0); PG8_MMA(0, 0, At, B0); PG8_BAR; PG8_SCHED; \
            PG8_LDB(B1, 0, 1); PG8_STAGE(PG8_SB(0, 0), b2, voffB); \
            PG8_BAR; PG8_WAIT_L(0); PG8_MMA(0, 1, At, B1); PG8_BAR; \
            PG8_LDA(At, 0, 1); PG8_STAGE(PG8_SA(0, 0), a2, voffA); \
            PG8_BAR; PG8_WAIT_L(0); PG8_MMA(1, 0, At, B0); PG8_BAR; PG8_SCHED; \
            PG8_STAGE(PG8_SB(0, 1), b2 + hstep, voffB); \
            PG8_WAIT_V(6); PG8_BAR; PG8_MMA(1, 1, At, B1); PG8_BAR; \
            PG8_LDB(B0, 1, 0); PG8_SCHED; PG8_LDA(At, 1, 0); PG8_STAGE(PG8_SA(0, 1), a2 + hstep, voffA); \
            PG8_WAIT_L(8); PG8_BAR; PG8_WAIT_L(0); PG8_MMA(0, 0, At, B0); PG8_BAR; PG8_SCHED; \
            PG8_LDB(B1, 1, 1); PG8_STAGE(PG8_SB(1, 0), b3, voffB); \
            PG8_BAR; PG8_WAIT_L(0); PG8_MMA(0, 1, At, B1); PG8_BAR; \
            PG8_LDA(At, 1, 1); PG8_STAGE(PG8_SA(1, 0), a3, voffA); \
            PG8_BAR; PG8_WAIT_L(0); PG8_MMA(1, 0, At, B0); PG8_BAR; PG8_SCHED; \
            PG8_STAGE(PG8_SB(1, 1), b3 + hstep, voffB); \
            PG8_WAIT_V(6); PG8_BAR; PG8_MMA(1, 1, At, B1); PG8_BAR; \
            } \
         \

        if constexpr (Epi::HAS_MID) {
            for (int t = 0; t < E.tmid; t += 2) { PG8_KBODY }
            E.mid(acc, cur, wr, fr);
            for (int t = E.tmid; t < nt; t += 2) { PG8_KBODY }
        } else {
            for (int t = 0; t < nt; t += 2) { PG8_KBODY }
        }
#undef PG8_KBODY
        if constexpr (ALIGN_EPI) { if (wr == 0) PG8_BAR; }
        E(acc, cur, wr, wc, fr, fq);
        if (!has_next) break;
#pragma unroll
        for (int a = 0; a < 2; ++a)
#pragma unroll
            for (int b = 0; b < 2; ++b)
#pragma unroll
                for (int m = 0; m < 4; ++m)
#pragma unroll
                    for (int n = 0; n < 2; ++n) acc[a][b][m][n] = (f32x4){0.f, 0.f, 0.f, 0.f};
        cur = nxt; cA = nA; cB = nB; ++ui;
        if constexpr (ALIGN_EPI) { if (wr == 1) PG8_BAR; }
    }
    PG8_WAIT_V(0);
    if constexpr (!ALIGN_EPI) { if (wr == 0) PG8_BAR; }
    PG8_BAR;
#undef PG8_SA
#undef PG8_SB
#undef PG8_STAGE
#undef PG8_LDA
#undef PG8_LDB
#undef PG8_MMA
#undef PG8_WAIT_V
#undef PG8_WAIT_L
#undef PG8_BAR
#undef PG8_SCHED
}
}

constexpr size_t al256(size_t x) { return (x + 255) & ~(size_t)255; }
constexpr size_t WS_CTL = 0, CTL_BYTES = 1u << 20;
constexpr size_t CTL_RS5 = 65536;
static_assert(CTL_RS5 + (size_t)M * 8 <= CTL_BYTES, "ctl");
constexpr float FX_SCALE = 4294967296.0f, FX_INV = 1.0f / 4294967296.0f;
constexpr size_t WS_WIN = WS_CTL + CTL_BYTES;
constexpr size_t WS_WGLU = WS_WIN + al256((size_t)NIN * D * 2);
constexpr size_t WS_WOUT = WS_WGLU + al256((size_t)2 * MIX_B * MIX_B * 2);
constexpr size_t WS_WGU = WS_WOUT + al256((size_t)D * D * 2);
constexpr size_t WS_WDN = WS_WGU + al256((size_t)2 * D_FF * D * 2);
constexpr size_t WS_ASILU = WS_WDN + al256((size_t)D * D_FF * 2);
constexpr size_t WS_MOD = WS_ASILU + al256((size_t)256 * D * 2);
constexpr size_t WS_AB = WS_MOD + al256((size_t)NB * 6 * D * 4);
constexpr size_t WS_H12 = WS_AB + al256((size_t)M * 16 * 4);
constexpr size_t WS_ACAT = WS_H12 + al256((size_t)M * D * 2);
constexpr size_t WS_F = WS_H12;
constexpr size_t WS_QKVB = WS_ACAT + al256((size_t)M * D * 2);
constexpr size_t WS_ZB = WS_QKVB + al256((size_t)M * QKV * 2);
constexpr size_t WS_UB = WS_ZB + al256((size_t)M * MIX_A * 2);
constexpr size_t WS_Y5 = WS_UB + al256((size_t)M * MIX_B * 2);
constexpr size_t WS_HMID = WS_QKVB;
constexpr size_t WS_MIX = WS_Y5 + al256((size_t)M * MIX_B * 2);
static_assert(WS_ACAT == WS_H12 + (size_t)M * D * 2 && WS_MIX - WS_QKVB >= (size_t)M * D_FF * 2, "overlay");
constexpr int FR_U = 0, FR_W = 32768, FR_Q = FR_W + 16384, FR_A = FR_Q + 16384, FR_K = FR_A + 8192, FR_SC = FR_K + 16384, CHUNK_BYTES = FR_SC + 256;
constexpr int NCHUNK_P = BATCH * NH * (SEQ / CHUNK);
constexpr size_t WS_FRAG = WS_MIX;
constexpr size_t FRAG_TOTAL = (size_t)NCHUNK_P * CHUNK_BYTES;
constexpr size_t WS_END = WS_MIX + (FRAG_TOTAL > (size_t)M * D * 4 ? FRAG_TOTAL : (size_t)M * D * 4);

constexpr size_t O_YP = 0, O_YS = O_YP + (size_t)MP * D, O_CONVP = O_YS + (size_t)MS * D, O_DELP = O_CONVP + (size_t)BATCH * 3 * QKV,
                 O_SREP = O_DELP + (size_t)BATCH * NH * HD * HD, O_SIMP = O_SREP + (size_t)BATCH * NG * NP, O_CONVS = O_SIMP + (size_t)BATCH * NG * NP,
                 O_DELS = O_CONVS + (size_t)DEC_BATCH * 3 * QKV, O_SRES = O_DELS + (size_t)DEC_BATCH * NH * HD * HD, O_SIMS = O_SRES + (size_t)DEC_BATCH * NG * NP,
                 O_END = O_SIMS + (size_t)DEC_BATCH * NG * NP;

constexpr int RING_BYTES = 131072, LDS_BYTES = 147456;
constexpr int NWAVES = 8, NTHREADS = 512;

enum InIdx { I_XP = 0, I_XS, I_CP, I_CS, I_SCONV, I_SDELTA, I_SSRE, I_SSIM, I_WADA, I_BADA, I_GPREMIX, I_GPOSTMIX, I_GPREFFN, I_GPOSTFFN, I_WIN, I_WCONV, I_ALOG, I_DTBIAS,
             I_GDN, I_LAMRE, I_LAMIM, I_LOGSTEP, I_BRE, I_BIM, I_CRE, I_CIM, I_DSKIP, I_WGLU, I_GS5, I_WOUT, I_WGATE, I_WUP, I_WDOWN, N_IN };
struct Args { const float* in[N_IN]; float* out; unsigned char* ws; int ph_lo, ph_hi; };

struct Frame {
    LAS unsigned char* lds;
    const float* const* in; float* out; unsigned char* ws;
    int tid, lane, wave, vcu, G;
};
DEVI const float* xrow(const Frame& F, int m) { return m < MP ? F.in[I_XP] + (size_t)m * D : F.in[I_XS] + (size_t)(m - MP) * D; }
DEVI int modrow(int m) { return m < MP ? m / SEQ : BATCH + (m - MP) / DEC_SEQ; }

DEVI void tr_item(const float* W, int ldw, int srccol, int k0, const float* kscale, bf16* WT, int dstK, int drow, int dk0, LAS float* scr, int lane) {
#pragma unroll 8
    for (int i = 0; i < 32; ++i) { const int kk = 2 * i + (lane >> 5); float v = W[(size_t)(k0 + kk) * ldw + srccol + (lane & 31)]; if (kscale) v *= kscale[k0 + kk]; scr[kk * 33 + (lane & 31)] = v; }
    WAVE_LDS_SYNC();
    const int c = lane & 7;
#pragma unroll
    for (int j = 0; j < 4; ++j) { const int n = (lane >> 3) + 8 * j; const LAS float* s = scr + (8 * c) * 33 + n;
        u32x4 o; o.x = pk2(s[0 * 33], s[1 * 33]); o.y = pk2(s[2 * 33], s[3 * 33]); o.z = pk2(s[4 * 33], s[5 * 33]); o.w = pk2(s[6 * 33], s[7 * 33]);
        *(u32x4*)(WT + (size_t)(drow + n) * dstK + dk0 + 8 * c) = o; }
    WAVE_LDS_SYNC();
}
DEVI void p0_prologue(Frame& F) {
    LAS float* scr = (LAS float*)(F.lds + F.wave * 16384);
    const int gw = F.vcu * NWAVES + F.wave, NGW = F.G * NWAVES;
    bf16* Win = (bf16*)(F.ws + WS_WIN); bf16* Wglu = (bf16*)(F.ws + WS_WGLU); bf16* Wout = (bf16*)(F.ws + WS_WOUT); bf16* Wgu = (bf16*)(F.ws + WS_WGU); bf16* Wdn = (bf16*)(F.ws + WS_WDN);
    constexpr int NB_IN = (QKV + MIX_A + MIX_B) / 32, I_IN = (D / 64) * NB_IN;
    constexpr int NB_GLU = 2 * MIX_B / 32, I_GLU = (MIX_B / 64) * NB_GLU;
    constexpr int NB_OUT = D / 32, I_OUT = (D / 64) * NB_OUT;
    constexpr int NB_GU = 2 * D_FF / 32, I_GU = (D / 64) * NB_GU;
    constexpr int NB_DN = D / 32, I_DN = (D_FF / 64) * NB_DN;
    constexpr int NITEMS = I_IN + I_GLU + I_OUT + I_GU + I_DN;
    for (int it = gw; it < NITEMS; it += NGW) {
        int r = it;
        if (r < I_IN) { const int kb = r / NB_IN, drow = 32 * (r % NB_IN); const int src = drow + (drow >= QKV + MIX_A ? 2 * NH : 0);
            tr_item(F.in[I_WIN], PROJ, src, 64 * kb, nullptr, Win, D, drow, 64 * kb, scr, F.lane); continue; } r -= I_IN;
        if (r < I_GLU) { const int kb = r / NB_GLU, drow = 32 * (r % NB_GLU); const int src = ((drow >> 7) & 1) * MIX_B + 128 * (drow >> 8) + (drow & 127);
            tr_item(F.in[I_WGLU], 2 * MIX_B, src, 64 * kb, nullptr, Wglu, MIX_B, drow, 64 * kb, scr, F.lane); continue; } r -= I_GLU;
        if (r < I_OUT) { const int kb = r / NB_OUT, drow = 32 * (r % NB_OUT); const int k0 = 64 * kb;
            tr_item(F.in[I_WOUT], D, drow, k0, k0 >= MIX_A ? F.in[I_GS5] - MIX_A : nullptr, Wout, D, drow, (k0 + MIX_B) % D, scr, F.lane); continue; } r -= I_OUT;
        if (r < I_GU) { const int kb = r / NB_GU, drow = 32 * (r % NB_GU); const int src = 128 * (drow >> 8) + (drow & 127);
            tr_item(((drow >> 7) & 1) ? F.in[I_WUP] : F.in[I_WGATE], D_FF, src, 64 * kb, nullptr, Wgu, D, drow, 64 * kb, scr, F.lane); continue; } r -= I_GU;
        { const int kb = r / NB_DN, drow = 32 * (r % NB_DN); tr_item(F.in[I_WDOWN], D, drow, 64 * kb, nullptr, Wdn, D_FF, drow, 64 * kb, scr, F.lane); }
    }
    const int gt = F.vcu * NTHREADS + F.tid, NGT = F.G * NTHREADS;
    for (int i = gt; i < 256 * D; i += NGT) { const int r = i / D, k = i % D;
        Win[(size_t)(QKV + MIX_A + MIX_B + r) * D + k] = (bf16)(r < 2 * NH ? f2bf(F.in[I_WIN][(size_t)k * PROJ + QKV + MIX_A + r]) : 0u); }
    bf16* As = (bf16*)(F.ws + WS_ASILU);
    for (int i = gt; i < 256 * D; i += NGT) { const int r = i / D, k = i % D; float v = 0.f;
        if (r < NB) v = siluf_(r < BATCH ? F.in[I_CP][(size_t)r * D + k] : F.in[I_CS][(size_t)(r - BATCH) * D + k]);
        As[i] = (bf16)f2bf(v); }
}

DEVI void p1_ada(Frame& F) {
    constexpr int MT = (NB + 15) / 16, NCOL = 48, UNITS = 6 * D / NCOL, KW = D / NWAVES, KS = KW / 32, SLOT = MT * 3 * 256;
    static_assert(6 * D % NCOL == 0 && KW % 32 == 0 && 4 * SLOT * 4 <= RING_BYTES, "ada");
    const bf16* As = (const bf16*)(F.ws + WS_ASILU); const float* W = F.in[I_WADA]; float* mod = (float*)(F.ws + WS_MOD);
    const int lane = F.lane, q = lane >> 4, c16 = lane & 15, wid = F.wave;
    LAS float* red = (LAS float*)F.lds;
    for (int unit = F.vcu; unit < UNITS; unit += F.G) {
        const int n0 = unit * NCOL;
        f32x4 acc[MT][3];
#pragma unroll
        for (int mt = 0; mt < MT; ++mt)
#pragma unroll
            for (int nt = 0; nt < 3; ++nt) acc[mt][nt] = (f32x4){0.f, 0.f, 0.f, 0.f};
        for (int ks = 0; ks < KS; ++ks) {
            const int k0 = wid * KW + 32 * ks;
            bf16x8 b[3];
#pragma unroll
            for (int nt = 0; nt < 3; ++nt) { float w[8];
#pragma unroll
                for (int j = 0; j < 8; ++j) w[j] = W[(size_t)(k0 + 8 * q + j) * (6 * D) + n0 + 16 * nt + c16];
                u32x4 p; p.x = pk2(w[0], w[1]); p.y = pk2(w[2], w[3]); p.z = pk2(w[4], w[5]); p.w = pk2(w[6], w[7]); b[nt] = __builtin_bit_cast(bf16x8, p); }
#pragma unroll
            for (int mt = 0; mt < MT; ++mt) { const bf16x8 a = *(const bf16x8*)(As + (size_t)(16 * mt + c16) * D + k0 + 8 * q);
#pragma unroll
                for (int nt = 0; nt < 3; ++nt) acc[mt][nt] = __builtin_amdgcn_mfma_f32_16x16x32_bf16(a, b[nt], acc[mt][nt], 0, 0, 0); }
        }
        for (int s = 4; s >= 1; s >>= 1) {
            if (wid >= s && wid < 2 * s) {
#pragma unroll
                for (int mt = 0; mt < MT; ++mt)
#pragma unroll
                    for (int nt = 0; nt < 3; ++nt) *(LAS f32x4*)(red + (wid - s) * SLOT + (mt * 3 + nt) * 256 + lane * 4) = acc[mt][nt];
            }
            __syncthreads();
            if (wid < s) {
#pragma unroll
                for (int mt = 0; mt < MT; ++mt)
#pragma unroll
                    for (int nt = 0; nt < 3; ++nt) acc[mt][nt] += *(const LAS f32x4*)(red + wid * SLOT + (mt * 3 + nt) * 256 + lane * 4);
            }
            __syncthreads();
        }
        if (wid == 0) {
#pragma unroll
            for (int mt = 0; mt < MT; ++mt)
#pragma unroll
                for (int nt = 0; nt < 3; ++nt) { const int col = n0 + 16 * nt + c16; const float bias = F.in[I_BADA][col];
#pragma unroll
                    for (int r = 0; r < 4; ++r) { const int row = 16 * mt + 4 * q + r; if (row < NB) mod[(size_t)row * (6 * D) + col] = acc[mt][nt][r] + bias; } }
        }
    }
}

constexpr int NV = D / 256;
DEVI void p2_h1(Frame& F) {
    const int gw = F.wave * F.G + F.vcu, NGW = F.G * NWAVES; const float* mod = (const float*)(F.ws + WS_MOD); bf16* H = (bf16*)(F.ws + WS_H12);
    for (int m = gw; m < M; m += NGW) {
        const f32x4* xr = (const f32x4*)xrow(F, m) + F.lane; const float* md = mod + (size_t)modrow(m) * 6 * D;
        f32x4 v[NV]; float s = 0.f;
#pragma unroll
        for (int j = 0; j < NV; ++j) { v[j] = xr[64 * j]; s += (v[j].x * v[j].x + v[j].y * v[j].y) + (v[j].z * v[j].z + v[j].w * v[j].w); }
        const float rstd = f_rsqrt(wave_sum(s) * (1.f / D) + EPS);
#pragma unroll
        for (int j = 0; j < NV; ++j) { const int idx = 4 * (F.lane + 64 * j);
            const f32x4 g = *(const f32x4*)(F.in[I_GPREMIX] + idx), sh = *(const f32x4*)(md + idx), sc = *(const f32x4*)(md + D + idx);
            const f32x4 h = v[j] * rstd * g * (sc + 1.0f) + sh; u32x2 o; o.x = pk2(h.x, h.y); o.y = pk2(h.z, h.w);
            *(u32x2*)(H + (size_t)m * D + idx) = o; }
    }
}
DEVI void p8_x1h2(Frame& F) {
    const int gw = F.wave * F.G + F.vcu, NGW = F.G * NWAVES; const float* mod = (const float*)(F.ws + WS_MOD); bf16* H = (bf16*)(F.ws + WS_H12);
    float* mix = (float*)(F.ws + WS_MIX);
    for (int m = gw; m < M; m += NGW) {
        const f32x4* xr = (const f32x4*)xrow(F, m) + F.lane; const float* md = mod + (size_t)modrow(m) * 6 * D; f32x4* mr = (f32x4*)(mix + (size_t)m * D) + F.lane;
        f32x4 v[NV]; float sm = 0.f;
#pragma unroll
        for (int j = 0; j < NV; ++j) { v[j] = mr[64 * j]; sm += (v[j].x * v[j].x + v[j].y * v[j].y) + (v[j].z * v[j].z + v[j].w * v[j].w); }
        const float rm = f_rsqrt(wave_sum(sm) * (1.f / D) + EPS);
        float s = 0.f;
#pragma unroll
        for (int j = 0; j < NV; ++j) { const int idx = 4 * (F.lane + 64 * j);
            const f32x4 g = *(const f32x4*)(F.in[I_GPOSTMIX] + idx), gt = *(const f32x4*)(md + 2 * D + idx);
            v[j] = xr[64 * j] + gt * (v[j] * rm * g); mr[64 * j] = v[j];
            s += (v[j].x * v[j].x + v[j].y * v[j].y) + (v[j].z * v[j].z + v[j].w * v[j].w); }
        const float rstd = f_rsqrt(wave_sum(s) * (1.f / D) + EPS);
#pragma unroll
        for (int j = 0; j < NV; ++j) { const int idx = 4 * (F.lane + 64 * j);
            const f32x4 g = *(const f32x4*)(F.in[I_GPREFFN] + idx), sh = *(const f32x4*)(md + 3 * D + idx), sc = *(const f32x4*)(md + 4 * D + idx);
            const f32x4 h = v[j] * rstd * g * (sc + 1.0f) + sh; u32x2 o; o.x = pk2(h.x, h.y); o.y = pk2(h.z, h.w);
            *(u32x2*)(H + (size_t)m * D + idx) = o; }
    }
}
DEVI void p11_out(Frame& F) {
    const int gw = F.wave * F.G + F.vcu, NGW = F.G * NWAVES; const float* mod = (const float*)(F.ws + WS_MOD);
    const float* x1 = (const float*)(F.ws + WS_MIX); const float* f = (const float*)(F.ws + WS_F);
    for (int m = gw; m < M; m += NGW) {
        const float* md = mod + (size_t)modrow(m) * 6 * D;
        const f32x4* xr = (const f32x4*)(x1 + (size_t)m * D) + F.lane; const f32x4* fr = (const f32x4*)(f + (size_t)m * D) + F.lane; f32x4* o = (f32x4*)(F.out + O_YP + (size_t)m * D) + F.lane;
        f32x4 v[NV]; float s = 0.f;
#pragma unroll
        for (int j = 0; j < NV; ++j) { v[j] = fr[64 * j]; s += (v[j].x * v[j].x + v[j].y * v[j].y) + (v[j].z * v[j].z + v[j].w * v[j].w); }
        const float rf = f_rsqrt(wave_sum(s) * (1.f / D) + EPS);
#pragma unroll
        for (int j = 0; j < NV; ++j) { const int idx = 4 * (F.lane + 64 * j);
            const f32x4 g = *(const f32x4*)(F.in[I_GPOSTFFN] + idx), gt = *(const f32x4*)(md + 5 * D + idx);
            o[64 * j] = xr[64 * j] + gt * (v[j] * rf * g); }
    }
}
template <int VW> DEVI void ld_bf(const bf16* p, float* o) {
    if constexpr (VW == 8) { const u32x4 w = *(const u32x4*)p; const unsigned ww[4] = {w.x, w.y, w.z, w.w};
#pragma unroll
        for (int e = 0; e < 4; ++e) { o[2 * e] = bf2f(ww[e]); o[2 * e + 1] = bf2f(ww[e] >> 16); } }
    else { const u32x2 w = *(const u32x2*)p; o[0] = bf2f(w.x); o[1] = bf2f(w.x >> 16); o[2] = bf2f(w.y); o[3] = bf2f(w.y >> 16); }
}
DEVI void p6_onorm(Frame& F) {
    constexpr int PL = MIX_A / 64, LPH = HD / PL, VW = PL >= 8 ? 8 : 4;
    static_assert(PL % VW == 0 && (LPH & (LPH - 1)) == 0, "onorm");
    const int gw = F.wave * F.G + F.vcu, NGW = F.G * NWAVES;
    const bf16* oraw = (const bf16*)(F.ws + WS_H12); const bf16* zb = (const bf16*)(F.ws + WS_ZB); bf16* acat = (bf16*)(F.ws + WS_ACAT);
    for (int m = gw; m < M; m += NGW) {
        float o[PL], z[PL]; float s = 0.f; const int c0 = F.lane * PL;
#pragma unroll
        for (int j = 0; j < PL / VW; ++j) { ld_bf<VW>(oraw + (size_t)m * D + c0 + VW * j, o + VW * j); ld_bf<VW>(zb + (size_t)m * MIX_A + c0 + VW * j, z + VW * j); }
#pragma unroll
        for (int j = 0; j < PL; ++j) s += o[j] * o[j];
#pragma unroll
        for (int d = 1; d < LPH; d <<= 1) s += __shfl_xor(s, d);
        const float rstd = f_rsqrt(s * (1.f / HD) + EPS);
#pragma unroll
        for (int j = 0; j < PL; j += 2) { const int d0 = (c0 + j) % HD;
            const float a = o[j] * rstd * F.in[I_GDN][d0] * siluf_(z[j]), b = o[j + 1] * rstd * F.in[I_GDN][d0 + 1] * siluf_(z[j + 1]);
            *(unsigned*)(acat + (size_t)m * D + MIX_B + c0 + j) = pk2(a, b); }
    }
}

using pg8::Unit;
DEVI void st8bf(bf16* p, const f32x4 v0, const f32x4 v1) { u32x4 w; w.x = pk2(v0[0], v0[1]); w.y = pk2(v0[2], v0[3]); w.z = pk2(v1[0], v1[1]); w.w = pk2(v1[2], v1[3]); *(u32x4*)p = w; }
struct EpiInProj {
    static constexpr bool PERM = true, HAS_MID = false; int tmid;
    bf16 *qkv, *z, *u; float *ab, *convp, *convs;
    DEVI void mid(f32x4 (&)[2][2][4][2], const Unit&, int, int) const {}
    DEVI void operator()(const f32x4 (&acc)[2][2][4][2], const Unit& un, int wr, int wc, int fr, int fq) const {
        const int row0 = un.pm * 256 + wr * 64 + fr, pn = un.pn;
#pragma unroll
        for (int ai = 0; ai < 2; ++ai)
#pragma unroll
            for (int m = 0; m < 4; ++m) { const int row = row0 + ai * 128 + m * 16;
                float* ct = nullptr;
                if (pn < NT_QKV) { if (row < MP) { const int t = row % SEQ; if (t >= SEQ - 3) ct = convp + ((size_t)(row / SEQ) * 3 + (t - (SEQ - 3))) * QKV; }
                                   else { const int r2 = row - MP, t = r2 % DEC_SEQ; if (t >= DEC_SEQ - 3) ct = convs + ((size_t)(r2 / DEC_SEQ) * 3 + (t - (DEC_SEQ - 3))) * QKV; } }
#pragma unroll
                for (int bj = 0; bj < 2; ++bj) { const int c0 = 128 * bj + 32 * wc + 8 * fq; const f32x4 v0 = acc[ai][bj][m][0], v1 = acc[ai][bj][m][1];
                    if (pn < NT_QKV) { const int col = pn * 256 + c0; st8bf(qkv + (size_t)row * QKV + col, v0, v1); if (ct) { *(f32x4*)(ct + col) = v0; *(f32x4*)(ct + col + 4) = v1; } }
                    else if (pn < NT_QKV + NT_Z) st8bf(z + (size_t)row * MIX_A + (pn - NT_QKV) * 256 + c0, v0, v1);
                    else if (pn < NT_QKV + NT_Z + NT_U) st8bf(u + (size_t)row * MIX_B + (pn - NT_QKV - NT_Z) * 256 + c0, v0, v1);
                    else if (c0 < 16) { *(f32x4*)(ab + (size_t)row * 16 + c0) = v0; *(f32x4*)(ab + (size_t)row * 16 + c0 + 4) = v1; } } }
    }
};
struct EpiGlu {
    static constexpr bool PERM = true, HAS_MID = false; int tmid;
    bf16* acat; unsigned long long* rs;
    DEVI void mid(f32x4 (&)[2][2][4][2], const Unit&, int, int) const {}
    DEVI void operator()(const f32x4 (&acc)[2][2][4][2], const Unit& un, int wr, int wc, int fr, int fq) const {
        const int row0 = un.pm * 256 + wr * 64 + fr, col = un.pn * 128 + 32 * wc + 8 * fq;
#pragma unroll
        for (int ai = 0; ai < 2; ++ai)
#pragma unroll
            for (int m = 0; m < 4; ++m) { const int row = row0 + ai * 128 + m * 16; f32x4 y[2]; float s = 0.f;
#pragma unroll
                for (int n = 0; n < 2; ++n)
#pragma unroll
                    for (int i = 0; i < 4; ++i) { const float v = acc[ai][0][m][n][i] * sigmoidf_(acc[ai][1][m][n][i]); y[n][i] = v; s += v * v; }
                st8bf(acat + (size_t)row * D + col, y[0], y[1]);
                s += __shfl_xor(s, 16); s += __shfl_xor(s, 32);
                if (fq == 0) atomicAdd(rs + row, (unsigned long long)(s * FX_SCALE)); }
    }
};
struct EpiSwiglu {
    static constexpr bool PERM = true, HAS_MID = false; int tmid;
    bf16* hm;
    DEVI void mid(f32x4 (&)[2][2][4][2], const Unit&, int, int) const {}
    DEVI void operator()(const f32x4 (&acc)[2][2][4][2], const Unit& un, int wr, int wc, int fr, int fq) const {
        const int row0 = un.pm * 256 + wr * 64 + fr, col = un.pn * 128 + 32 * wc + 8 * fq;
#pragma unroll
        for (int ai = 0; ai < 2; ++ai)
#pragma unroll
            for (int m = 0; m < 4; ++m) { const int row = row0 + ai * 128 + m * 16; f32x4 y[2];
#pragma unroll
                for (int n = 0; n < 2; ++n)
#pragma unroll
                    for (int i = 0; i < 4; ++i) y[n][i] = siluf_(acc[ai][0][m][n][i]) * acc[ai][1][m][n][i];
                st8bf(hm + (size_t)row * D_FF + col, y[0], y[1]); }
    }
};
template <bool MID> struct EpiF32Rs {
    static constexpr bool PERM = false, HAS_MID = MID; int tmid;
    float* C; const unsigned long long* rs_in;
    DEVI void mid(f32x4 (&acc)[2][2][4][2], const Unit& un, int wr, int fr) const {
#pragma unroll
        for (int ai = 0; ai < 2; ++ai)
#pragma unroll
            for (int m = 0; m < 4; ++m) { const int row = un.pm * 256 + wr * 64 + fr + ai * 128 + m * 16; const float sc = f_rsqrt((float)rs_in[row] * (FX_INV / MIX_B) + EPS);
#pragma unroll
                for (int bj = 0; bj < 2; ++bj)
#pragma unroll
                    for (int n = 0; n < 2; ++n) acc[ai][bj][m][n] *= sc; }
    }
    DEVI void operator()(const f32x4 (&acc)[2][2][4][2], const Unit& un, int wr, int wc, int fr, int fq) const {
        const int row0 = un.pm * 256 + wr * 64 + fr, col0 = un.pn * 256 + wc * 32 + 4 * fq;
#pragma unroll
        for (int ai = 0; ai < 2; ++ai)
#pragma unroll
            for (int m = 0; m < 4; ++m) { const int row = row0 + ai * 128 + m * 16; float* rp = C + (size_t)row * D + col0;
#pragma unroll
                for (int bj = 0; bj < 2; ++bj)
#pragma unroll
                    for (int n = 0; n < 2; ++n) *(f32x4*)(rp + bj * 128 + n * 16) = acc[ai][bj][m][n]; }
    }
};

template <int C> struct PrepCfg { static constexpr int CP = C < 32 ? 32 : C, MT = C / 16, SC = CP / 32, LDQ = 136, LDT = CP + 8; };
template <int C> struct PrepLds {
    using P = PrepCfg<C>;
    static constexpr int QS = 0, KS = QS + C * P::LDQ * 2, KBS = KS + C * P::LDQ * 2, VBT = KBS + C * P::LDQ * 2, KGT = VBT + 128 * P::LDT * 2,
                         LS = KGT + 128 * P::LDT * 2, TS = LS + C * (C + 4) * 4, AS = TS + C * P::LDT * 2, SCAL = (AS + C * P::LDT * 2 + 15) & ~15, END = SCAL + 3 * C * 4 + 16;
};
template <int C, int NVALID>
DEVI void delta_prep(Frame& F, LAS unsigned char* L, int seq_row0, int t0, int h, const float* conv_state, unsigned char* frag) {
    using P = PrepCfg<C>; using O = PrepLds<C>;
    constexpr int LDQ = P::LDQ, LDT = P::LDT, CP = P::CP, MT = P::MT, SC = P::SC;
    LAS bf16* Qs = (LAS bf16*)(L + O::QS); LAS bf16* Ks = (LAS bf16*)(L + O::KS); LAS bf16* Kbs = (LAS bf16*)(L + O::KBS); LAS bf16* VbT = (LAS bf16*)(L + O::VBT); LAS bf16* KgT = (LAS bf16*)(L + O::KGT);
    LAS float* Ls = (LAS float*)(L + O::LS); LAS bf16* Ts = (LAS bf16*)(L + O::TS); LAS bf16* As = (LAS bf16*)(L + O::AS); LAS float* gcs = (LAS float*)(L + O::SCAL); LAS float* bts = gcs + C; LAS float* egs = bts + C;
    const bf16* qkv = (const bf16*)(F.ws + WS_QKVB); const float* ab = (const float*)(F.ws + WS_AB);
    const int lane = F.lane, wid = F.wave, tid = F.tid, q4 = lane >> 4, c16 = lane & 15;
    if (wid == 0) {
        float g = 0.f, bt = 0.f;
        if (lane < NVALID) { const float* abr = ab + (size_t)(seq_row0 + t0 + lane) * 16; const float x = abr[h] + F.in[I_DTBIAS][h];
            const float sp = x > 20.f ? x : log1pf(f_exp(x)); g = -f_exp(F.in[I_ALOG][h]) * sp; bt = sigmoidf_(abr[NH + h]); }
        float gc = g;
#pragma unroll
        for (int d = 1; d < 64; d <<= 1) { const float o = __shfl_up(gc, d); if (lane >= d) gc += o; }
        if (lane < C) { gcs[lane] = gc; bts[lane] = bt; egs[lane] = f_exp(gc); }
    }
    if constexpr (CP > C) {
        for (int i = tid; i < 128 * (CP - C); i += NTHREADS) { const int r = i / (CP - C), c = C + i % (CP - C); VbT[r * LDT + c] = 0; KgT[r * LDT + c] = 0; }
        for (int i = tid; i < C * (CP - C); i += NTHREADS) { const int r = i / (CP - C), c = C + i % (CP - C); Ts[r * LDT + c] = 0; As[r * LDT + c] = 0; }
    }
    __syncthreads();
    {
        constexpr int RW = C / 8; const float* wc_ = F.in[I_WCONV];
        float w4[6][4]; int gcol[6];
#pragma unroll
        for (int s = 0; s < 6; ++s) { gcol[s] = (s >> 1) * MIX_A + h * HD + (s & 1) * 64 + lane;
#pragma unroll
            for (int j = 0; j < 4; ++j) w4[s][j] = wc_[(size_t)j * QKV + gcol[s]]; }
        const int tb = wid * RW;
        float win[6][3];
#pragma unroll
        for (int s = 0; s < 6; ++s)
#pragma unroll
            for (int j = 0; j < 3; ++j) { const int i = t0 + tb + j;
                float v = 0.f; if (i < 3) { if (conv_state) v = conv_state[(size_t)i * QKV + gcol[s]]; } else v = bf2f(qkv[(size_t)(seq_row0 + i - 3) * QKV + gcol[s]]);
                win[s][j] = v; }
        const float gl = gcs[C - 1];
#pragma unroll
        for (int r = 0; r < RW; ++r) { const int t = tb + r; const bool valid = t < NVALID;
            float val[6];
#pragma unroll
            for (int s = 0; s < 6; ++s) { float cur = 0.f; if (valid) cur = bf2f(qkv[(size_t)(seq_row0 + t0 + t) * QKV + gcol[s]]);
                const float cv = w4[s][0] * win[s][0] + w4[s][1] * win[s][1] + w4[s][2] * win[s][2] + w4[s][3] * cur;
                win[s][0] = win[s][1]; win[s][1] = win[s][2]; win[s][2] = cur; val[s] = valid ? siluf_(cv) : 0.f; }
            const float sq = wave_sum(val[0] * val[0] + val[1] * val[1]), sk = wave_sum(val[2] * val[2] + val[3] * val[3]);
            const float rq = f_rsqrt(sq + 1e-6f) * 0.08838834764831845f, rk = f_rsqrt(sk + 1e-6f);
            const float bt = bts[t], eg = egs[t];
#pragma unroll
            for (int e = 0; e < 2; ++e) { const int c = e * 64 + lane; const float qn = val[e] * rq, kn = val[2 + e] * rk, vv = val[4 + e];
                Qs[t * LDQ + c] = (bf16)f2bf(qn); Ks[t * LDQ + c] = (bf16)f2bf(kn); Kbs[t * LDQ + c] = (bf16)f2bf(kn * bt);
                VbT[c * LDT + t] = (bf16)f2bf(vv * bt); KgT[c * LDT + t] = (bf16)f2bf(kn * bt * eg); }
            (void)gl;
        }
    }
    __syncthreads();
    for (int tix = wid; tix < 2 * MT * MT; tix += NWAVES) {
        const int which = tix / (MT * MT), mi = (tix % (MT * MT)) / MT, nj = tix % MT;
        if (nj > mi) {
            if (which == 0) { for (int r = 0; r < 4; ++r) Ls[(16 * mi + 4 * q4 + r) * (C + 4) + 16 * nj + c16] = 0.f; }
            else { for (int r = 0; r < 4; ++r) As[(16 * mi + 4 * q4 + r) * LDT + 16 * nj + c16] = 0; }
            continue; }
        const LAS bf16* A = which == 0 ? Kbs : Qs; f32x4 acc = {0.f, 0.f, 0.f, 0.f};
#pragma unroll
        for (int s = 0; s < 4; ++s) { const bf16x8 a = *(const LAS bf16x8*)(A + (16 * mi + c16) * LDQ + 32 * s + 8 * q4), b = *(const LAS bf16x8*)(Ks + (16 * nj + c16) * LDQ + 32 * s + 8 * q4);
            acc = __builtin_amdgcn_mfma_f32_16x16x32_bf16(a, b, acc, 0, 0, 0); }
        const int j = 16 * nj + c16; const float gj = gcs[j];
#pragma unroll
        for (int r = 0; r < 4; ++r) { const int i = 16 * mi + 4 * q4 + r; const float dec = f_exp(gcs[i] - gj);
            if (which == 0) Ls[i * (C + 4) + j] = (i > j) ? acc[r] * dec : 0.f;
            else As[i * LDT + j] = (bf16)((i >= j) ? f2bf(acc[r] * dec) : 0u); }
    }
    __syncthreads();
    if (wid == 0) {
        if (lane < C) {
            float x[C];
#pragma unroll
            for (int i = 0; i < C; ++i) { float s = (i == lane) ? 1.f : 0.f;
#pragma unroll
                for (int j = 0; j < i; ++j) s -= Ls[i * (C + 4) + j] * x[j];
                x[i] = s; Ts[i * LDT + lane] = (bf16)f2bf(s); }
        }
    } else {
        const float gl = gcs[C - 1];
        for (int i = tid - 64; i < C * 128; i += NTHREADS - 64) { const int t = i >> 7, c = i & 127;
            Qs[t * LDQ + c] = (bf16)f2bf(bf2f(Qs[t * LDQ + c]) * egs[t]); Ks[t * LDQ + c] = (bf16)f2bf(bf2f(Ks[t * LDQ + c]) * f_exp(gl - gcs[t])); }
    }
    __syncthreads();
    for (int tix = wid; tix < 2 * MT * 8; tix += NWAVES) {
        const int which = tix / (MT * 8), m = (tix % (MT * 8)) / 8, nv = tix % 8; const LAS bf16* Bt = which == 0 ? VbT : KgT; f32x4 acc = {0.f, 0.f, 0.f, 0.f};
#pragma unroll
        for (int s = 0; s < SC; ++s) { const bf16x8 a = *(const LAS bf16x8*)(Ts + (16 * m + c16) * LDT + 32 * s + 8 * q4), b = *(const LAS bf16x8*)(Bt + (16 * nv + c16) * LDT + 32 * s + 8 * q4);
            acc = __builtin_amdgcn_mfma_f32_16x16x32_bf16(a, b, acc, 0, 0, 0); }
        if (which == 0) *(f32x4*)(frag + FR_U + ((size_t)(nv * MT + m) * 64 + lane) * 16) = acc;
        else { for (int r = 0; r < 4; ++r) Kbs[(16 * m + 4 * q4 + r) * LDQ + 16 * nv + c16] = (bf16)f2bf(-acc[r]); }
    }
    __syncthreads();
    constexpr int NFW = MT * 4, NFA = MT * SC, NFK = 8 * SC, NF = 2 * NFW + NFA + NFK;
    for (int it = tid; it < NF * 64; it += NTHREADS) {
        const int f = it >> 6, l = it & 63, i16 = l & 15, q = l >> 4; u32x4 o;
        if (f < 2 * NFW) { const int which = f / NFW, ff = f % NFW, m = ff / 4, s = ff % 4; const LAS bf16* src = (which == 0 ? Kbs : Qs) + (16 * m + i16) * LDQ + 32 * s + 4 * q;
            const u32x2 lo = *(const LAS u32x2*)src, hi = *(const LAS u32x2*)(src + 16); o = (u32x4){lo.x, lo.y, hi.x, hi.y};
            *(u32x4*)(frag + (which == 0 ? FR_W : FR_Q) + ((size_t)ff * 64 + l) * 16) = o; }
        else if (f < 2 * NFW + NFA) { const int ff = f - 2 * NFW, m = ff / SC, s = ff % SC; const LAS bf16* src = As + (16 * m + i16) * LDT + 32 * s + 4 * q;
            const u32x2 lo = *(const LAS u32x2*)src, hi = *(const LAS u32x2*)(src + 16); o = (u32x4){lo.x, lo.y, hi.x, hi.y};
            *(u32x4*)(frag + FR_A + ((size_t)ff * 64 + l) * 16) = o; }
        else { const int ff = f - 2 * NFW - NFA, T = ff / SC, s = ff % SC; unsigned e[8];
#pragma unroll
            for (int j = 0; j < 8; ++j) { const int c = 32 * s + 16 * (j >> 2) + 4 * q + (j & 3); e[j] = (c < C) ? (unsigned)Ks[c * LDQ + 16 * T + i16] : 0u; }
            o = (u32x4){e[0] | (e[1] << 16), e[2] | (e[3] << 16), e[4] | (e[5] << 16), e[6] | (e[7] << 16)};
            *(u32x4*)(frag + FR_K + ((size_t)ff * 64 + l) * 16) = o; }
    }
    if (tid == 0) *(float*)(frag + FR_SC) = egs[C - 1];
    __syncthreads();
}

template <int C, int NVALID>
DEVI void delta_apply(const unsigned char* frag, size_t fstride, int nchunks, const float* S0, float* Sout, bf16* oraw_base  , int vs, int lane) {
    using P = PrepCfg<C>; constexpr int MT = P::MT, SC = P::SC;
    const int q = lane >> 4, c16 = lane & 15;
    f32x4 S[8];
#pragma unroll
    for (int T = 0; T < 8; ++T) { S[T] = (f32x4){0.f, 0.f, 0.f, 0.f}; if (S0) { const float* sp = S0 + (size_t)(16 * T + 4 * q) * HD + 16 * vs + c16; S[T] = (f32x4){sp[0], sp[HD], sp[2 * HD], sp[3 * HD]}; } }
    for (int n = 0; n < nchunks; ++n, frag += fstride) {
        const float egl = *(const float*)(frag + FR_SC);
        bf16x8 Sb[4];
#pragma unroll
        for (int s = 0; s < 4; ++s) { u32x4 p; p.x = pk2(S[2 * s][0], S[2 * s][1]); p.y = pk2(S[2 * s][2], S[2 * s][3]); p.z = pk2(S[2 * s + 1][0], S[2 * s + 1][1]); p.w = pk2(S[2 * s + 1][2], S[2 * s + 1][3]); Sb[s] = __builtin_bit_cast(bf16x8, p); }
        f32x4 vn[MT], o[MT];
#pragma unroll
        for (int m = 0; m < MT; ++m) { vn[m] = *(const f32x4*)(frag + FR_U + ((size_t)(vs * MT + m) * 64 + lane) * 16); o[m] = (f32x4){0.f, 0.f, 0.f, 0.f};
#pragma unroll
            for (int s = 0; s < 4; ++s) { const bf16x8 w = *(const bf16x8*)(frag + FR_W + ((size_t)(m * 4 + s) * 64 + lane) * 16), qf = *(const bf16x8*)(frag + FR_Q + ((size_t)(m * 4 + s) * 64 + lane) * 16);
                vn[m] = __builtin_amdgcn_mfma_f32_16x16x32_bf16(w, Sb[s], vn[m], 0, 0, 0); o[m] = __builtin_amdgcn_mfma_f32_16x16x32_bf16(qf, Sb[s], o[m], 0, 0, 0); } }
        bf16x8 vb[SC];
#pragma unroll
        for (int s = 0; s < SC; ++s) { u32x4 p; p.x = pk2(vn[2 * s < MT ? 2 * s : 0][0], vn[2 * s < MT ? 2 * s : 0][1]); p.y = pk2(vn[2 * s < MT ? 2 * s : 0][2], vn[2 * s < MT ? 2 * s : 0][3]);
            if (2 * s + 1 < MT) { p.z = pk2(vn[2 * s + 1 < MT ? 2 * s + 1 : 0][0], vn[2 * s + 1 < MT ? 2 * s + 1 : 0][1]); p.w = pk2(vn[2 * s + 1 < MT ? 2 * s + 1 : 0][2], vn[2 * s + 1 < MT ? 2 * s + 1 : 0][3]); } else { p.z = 0u; p.w = 0u; }
            vb[s] = __builtin_bit_cast(bf16x8, p); }
#pragma unroll
        for (int m = 0; m < MT; ++m)
#pragma unroll
            for (int s = 0; s < SC; ++s) { const bf16x8 a = *(const bf16x8*)(frag + FR_A + ((size_t)(m * SC + s) * 64 + lane) * 16); o[m] = __builtin_amdgcn_mfma_f32_16x16x32_bf16(a, vb[s], o[m], 0, 0, 0); }
#pragma unroll
        for (int T = 0; T < 8; ++T) { S[T] *= egl;
#pragma unroll
            for (int s = 0; s < SC; ++s) { const bf16x8 kf = *(const bf16x8*)(frag + FR_K + ((size_t)(T * SC + s) * 64 + lane) * 16); S[T] = __builtin_amdgcn_mfma_f32_16x16x32_bf16(kf, vb[s], S[T], 0, 0, 0); } }
#pragma unroll
        for (int m = 0; m < MT; ++m)
#pragma unroll
            for (int r = 0; r < 4; ++r) { const int c = 16 * m + 4 * q + r; if (c < NVALID) oraw_base[(size_t)(n * C + c) * D + 16 * vs + c16] = (bf16)f2bf(o[m][r]); }
    }
#pragma unroll
    for (int T = 0; T < 8; ++T) { float* sp = Sout + (size_t)(16 * T + 4 * q) * HD + 16 * vs + c16; sp[0] = S[T][0]; sp[HD] = S[T][1]; sp[2 * HD] = S[T][2]; sp[3 * HD] = S[T][3]; }
}

DEVI void p4_prep(Frame& F) {
    constexpr int NC = SEQ / CHUNK;
    for (int u = F.vcu; u < NCHUNK_P; u += F.G) {
        const int n = u % NC, bh = u / NC, h = bh % NH, b = bh / NH;
        delta_prep<CHUNK, CHUNK>(F, F.lds, b * SEQ, n * CHUNK, h, nullptr, F.ws + WS_FRAG + (size_t)u * CHUNK_BYTES);
    }
}

template <bool SAMPLE>
DEVI void s5_job(Frame& F, LAS unsigned char* L  , int row0, int nrows, int g, int b0) {
    const int lane = F.lane, hi = lane >> 5, l31 = lane & 31, q = lane >> 4, c16 = lane & 15;
    LAS float* BUT = (LAS float*)L;
    LAS unsigned* Hs = (LAS unsigned*)(L + 10240);
    const bf16* ub = (const bf16*)(F.ws + WS_UB); bf16* y5 = (bf16*)(F.ws + WS_Y5);
    float are, aim;
    {
        const float lre = fminf(F.in[I_LAMRE][g * NP + lane], -1e-4f), lim = F.in[I_LAMIM][g * NP + lane], dt = f_exp(F.in[I_LOGSTEP][g]);
        const float mag = f_exp(lre * dt), ang = lim * dt; are = mag * f_cos(ang); aim = mag * f_sin(ang);
    }
    bf16x8 bbf[4];
#pragma unroll
    for (int nt = 0; nt < 4; ++nt) { const int pp = 32 * nt + l31, p = pp & 63;
        const float lre = fminf(F.in[I_LAMRE][g * NP + p], -1e-4f), lim = F.in[I_LAMIM][g * NP + p], dt = f_exp(F.in[I_LOGSTEP][g]);
        const float mag = f_exp(lre * dt), ang = lim * dt, nr = mag * f_cos(ang) - 1.f, ni = mag * f_sin(ang), den = lre * lre + lim * lim;
        const float cre = (nr * lre + ni * lim) / den, cim = (ni * lre - nr * lim) / den;
        const float* br = F.in[I_BRE] + ((size_t)g * NP + p) * 16 + 8 * hi; const float* bi = F.in[I_BIM] + ((size_t)g * NP + p) * 16 + 8 * hi; float e[8];
#pragma unroll
        for (int j = 0; j < 8; ++j) e[j] = pp < 64 ? cre * br[j] - cim * bi[j] : cre * bi[j] + cim * br[j];
        u32x4 pk; pk.x = pk2(e[0], e[1]); pk.y = pk2(e[2], e[3]); pk.z = pk2(e[4], e[5]); pk.w = pk2(e[6], e[7]); bbf[nt] = __builtin_bit_cast(bf16x8, pk); }
    bf16x8 ccf[4];
#pragma unroll
    for (int s = 0; s < 4; ++s) { float e[8];
#pragma unroll
        for (int j = 0; j < 8; ++j) { const int p = 16 * s + 4 * q + (j >> 1); e[j] = (j & 1) ? -F.in[I_CIM][((size_t)g * 16 + c16) * NP + p] : F.in[I_CRE][((size_t)g * 16 + c16) * NP + p]; }
        u32x4 pk; pk.x = pk2(e[0], e[1]); pk.y = pk2(e[2], e[3]); pk.z = pk2(e[4], e[5]); pk.w = pk2(e[6], e[7]); ccf[s] = __builtin_bit_cast(bf16x8, pk); }
    const float dsk = F.in[I_DSKIP][g * 16 + c16];
    float hre = 0.f, him = 0.f;
    for (int r0 = 0; r0 < nrows; r0 += 32) {
        const bf16x8 uf = *(const bf16x8*)(ub + (size_t)(row0 + r0 + l31) * MIX_B + g * 16 + 8 * hi);
        f32x16 bu[4];
#pragma unroll
        for (int nt = 0; nt < 4; ++nt) { const f32x16 z = {0.f, 0.f, 0.f, 0.f, 0.f, 0.f, 0.f, 0.f, 0.f, 0.f, 0.f, 0.f, 0.f, 0.f, 0.f, 0.f}; bu[nt] = __builtin_amdgcn_mfma_f32_32x32x16_bf16(uf, bbf[nt], z, 0, 0, 0); }
#pragma unroll
        for (int hf = 0; hf < 2; ++hf) {
            WAVE_LDS_SYNC();
#pragma unroll
            for (int nt = 0; nt < 4; ++nt)
#pragma unroll
                for (int i2 = 0; i2 < 2; ++i2) { const int i = 2 * hf + i2; *(LAS f32x4*)(BUT + (32 * nt + l31) * 20 + 8 * i2 + 4 * hi) = (f32x4){bu[nt][4 * i], bu[nt][4 * i + 1], bu[nt][4 * i + 2], bu[nt][4 * i + 3]}; }
            WAVE_LDS_SYNC();
            float br_[16], bi_[16];
#pragma unroll
            for (int j = 0; j < 4; ++j) { const f32x4 a = *(const LAS f32x4*)(BUT + lane * 20 + 4 * j), b = *(const LAS f32x4*)(BUT + (64 + lane) * 20 + 4 * j);
                br_[4 * j] = a[0]; br_[4 * j + 1] = a[1]; br_[4 * j + 2] = a[2]; br_[4 * j + 3] = a[3]; bi_[4 * j] = b[0]; bi_[4 * j + 1] = b[1]; bi_[4 * j + 2] = b[2]; bi_[4 * j + 3] = b[3]; }
#pragma unroll
            for (int tt = 0; tt < 16; ++tt) {
                if (SAMPLE && (tt & 7) == 0) { const int b = b0 + (r0 + 16 * hf + tt) / 8; hre = F.in[I_SSRE][((size_t)b * NG + g) * NP + lane]; him = F.in[I_SSIM][((size_t)b * NG + g) * NP + lane]; }
                const float nre = are * hre - aim * him + br_[tt], nim = are * him + aim * hre + bi_[tt]; hre = nre; him = nim;
                Hs[tt * 68 + lane] = pk2(hre, him);
                if (SAMPLE && (tt & 7) == 7) { const int b = b0 + (r0 + 16 * hf + tt) / 8; F.out[O_SRES + ((size_t)b * NG + g) * NP + lane] = hre; F.out[O_SIMS + ((size_t)b * NG + g) * NP + lane] = him; }
            }
            WAVE_LDS_SYNC();
            f32x4 y = {0.f, 0.f, 0.f, 0.f};
#pragma unroll
            for (int s = 0; s < 4; ++s) { const bf16x8 a = *(const LAS bf16x8*)(Hs + c16 * 68 + 16 * s + 4 * q); y = __builtin_amdgcn_mfma_f32_16x16x32_bf16(a, ccf[s], y, 0, 0, 0); }
#pragma unroll
            for (int r = 0; r < 4; ++r) { const size_t row = (size_t)(row0 + r0 + 16 * hf + 4 * q + r); const float u = bf2f(ub[row * MIX_B + g * 16 + c16]);
                y5[row * MIX_B + g * 16 + c16] = (bf16)f2bf(geluf_(y[r] + dsk * u)); }
        }
    }
    if (!SAMPLE) { F.out[O_SREP + ((size_t)b0 * NG + g) * NP + lane] = hre; F.out[O_SIMP + ((size_t)b0 * NG + g) * NP + lane] = him; }
}

DEVI void p5_mix(Frame& F) {
    using OL = PrepLds<16>;
    constexpr int FRAG_OFF = (OL::END + 255) & ~255;
    static_assert(FRAG_OFF + CHUNK_BYTES <= RING_BYTES, "lds");
    for (int u = F.vcu; u < DEC_BATCH * NH; u += F.G) {
        const int b = u / NH, h = u % NH;
        unsigned char* fr = (unsigned char*)(F.lds + FRAG_OFF);
        delta_prep<16, 8>(F, F.lds, MP + b * DEC_SEQ, 0, h, F.in[I_SCONV] + (size_t)b * 3 * QKV, fr);
        delta_apply<16, 8>(fr, 0, 1, F.in[I_SDELTA] + ((size_t)b * NH + h) * HD * HD, F.out + O_DELS + ((size_t)b * NH + h) * HD * HD,
                           (bf16*)(F.ws + WS_H12) + (size_t)(MP + b * DEC_SEQ) * D + h * HD, F.wave, F.lane);
        __syncthreads();
    }
    constexpr int NJ_D = BATCH * NH * 8, NJ_SP = BATCH * NG, NJ_SS = (DEC_BATCH / 4) * NG, NJ = NJ_D + NJ_SP + NJ_SS;
    const int gw = F.wave * F.G + F.vcu, NGW = F.G * NWAVES;
    LAS unsigned char* wl = F.lds + F.wave * 16384;
    for (int j = gw; j < NJ; j += NGW) {
        if (j < NJ_D) { const int vs = j % 8, bh = j / 8, h = bh % NH, b = bh / NH;
            delta_apply<CHUNK, CHUNK>(F.ws + WS_FRAG + (size_t)bh * (SEQ / CHUNK) * CHUNK_BYTES, CHUNK_BYTES, SEQ / CHUNK, nullptr, F.out + O_DELP + (size_t)bh * HD * HD,
                                      (bf16*)(F.ws + WS_H12) + (size_t)(b * SEQ) * D + h * HD, vs, F.lane); }
        else if (j < NJ_D + NJ_SP) { const int jj = j - NJ_D, b = jj / NG, g = jj % NG; s5_job<false>(F, wl, b * SEQ, SEQ, g, b); }
        else { const int jj = j - NJ_D - NJ_SP, bq = jj / NG, g = jj % NG; s5_job<true>(F, wl, MP + bq * 32, 32, g, bq * 4); }
    }
}

constexpr int NPHASE = 12;
#ifndef MK_COOP
#define MK_COOP 1
#endif
__global__ void __launch_bounds__(NTHREADS, 2) fwd_kernel(Args args) {
#ifdef HOST_EMU
    unsigned char* lds = emu_lds();
#else
    extern __shared__ __attribute__((aligned(16))) unsigned char lds[];
#endif
    Frame F; F.lds = (LAS unsigned char*)lds; F.in = args.in; F.out = args.out; F.ws = args.ws;
    F.tid = threadIdx.x; F.lane = F.tid & 63; F.wave = __builtin_amdgcn_readfirstlane(F.tid >> 6);
    F.G = gridDim.x; { const int bx = blockIdx.x; F.vcu = (F.G % 8 == 0) ? (bx % 8) * (F.G / 8) + bx / 8 : bx; }
    const int lo = args.ph_lo, hi = args.ph_hi;
#ifdef HOST_EMU
#define GRID_SYNC() emu_grid_sync()
#elif MK_COOP
    cg::grid_group grid = cg::this_grid();
#define GRID_SYNC() grid.sync()
#else
#define GRID_SYNC() do {} while (0)
#endif
#ifndef PHASE_MASK
#define PHASE_MASK 0xFFFF
#endif
#define IN(k) ((((PHASE_MASK) >> (k)) & 1) && lo <= (k) && (k) < hi)
#define SEAM(k) do { if (IN(k) && IN((k) + 1)) GRID_SYNC(); } while (0)
    using namespace pg8;
    if (IN(0)) { p0_prologue(F); } SEAM(0);
    if (IN(1)) { p1_ada(F); } SEAM(1);
    if (IN(2)) { p2_h1(F); } SEAM(2);
    if (IN(3)) {
        Gemm g{(const bf16*)(F.ws + WS_H12), (const bf16*)(F.ws + WS_WIN), M, NIN, D}; StaticOrder S; S.init(M, NIN, F.G, (int)blockIdx.x);
        EpiInProj E{0, (bf16*)(F.ws + WS_QKVB), (bf16*)(F.ws + WS_ZB), (bf16*)(F.ws + WS_UB), (float*)(F.ws + WS_AB), F.out + O_CONVP, F.out + O_CONVS};
        gemm_phase<EpiInProj, true, true>(F.lds, g, S, E);
    } SEAM(3);
    if (IN(4)) { p4_prep(F); } SEAM(4);
    if (IN(5)) { p5_mix(F); } SEAM(5);
    if (IN(6)) {
        p6_onorm(F);
        Gemm g{(const bf16*)(F.ws + WS_Y5), (const bf16*)(F.ws + WS_WGLU), M, 2 * MIX_B, MIX_B}; StaticOrder S; S.init(M, 2 * MIX_B, F.G, (int)blockIdx.x);
        EpiGlu E{0, (bf16*)(F.ws + WS_ACAT), (unsigned long long*)(F.ws + WS_CTL + CTL_RS5)};
        gemm_phase<EpiGlu, true, true>(F.lds, g, S, E);
    } SEAM(6);
    if (IN(7)) {
        Gemm g{(const bf16*)(F.ws + WS_ACAT), (const bf16*)(F.ws + WS_WOUT), M, D, D}; StaticOrder S; S.init(M, D, F.G, (int)blockIdx.x);
        EpiF32Rs<true> E{MIX_B / 64, (float*)(F.ws + WS_MIX), (const unsigned long long*)(F.ws + WS_CTL + CTL_RS5)};
        gemm_phase<EpiF32Rs<true>, true, true>(F.lds, g, S, E);
    } SEAM(7);
    if (IN(8)) { p8_x1h2(F); } SEAM(8);
    if (IN(9)) {
        Gemm g{(const bf16*)(F.ws + WS_H12), (const bf16*)(F.ws + WS_WGU), M, 2 * D_FF, D}; StaticOrder S; S.init(M, 2 * D_FF, F.G, (int)blockIdx.x);
        EpiSwiglu E{0, (bf16*)(F.ws + WS_HMID)};
        gemm_phase<EpiSwiglu, true, true>(F.lds, g, S, E);
    } SEAM(9);
    if (IN(10)) {
        Gemm g{(const bf16*)(F.ws + WS_HMID), (const bf16*)(F.ws + WS_WDN), M, D, D_FF}; StaticOrder S; S.init(M, D, F.G, (int)blockIdx.x);
        EpiF32Rs<false> E{0, (float*)(F.ws + WS_F), nullptr};
        gemm_phase<EpiF32Rs<false>, true, true>(F.lds, g, S, E);
    } SEAM(10);
    if (IN(11)) { p11_out(F); }
#undef IN
#undef SEAM
}

#ifndef HOST_EMU
extern "C" void kernel_launch(void* const* d_in, const int* in_sizes, int n_in, void* d_out, int out_size, void* d_ws, size_t ws_size, hipStream_t stream) {
    static int grid = 0;
    if (grid == 0) {
        if (n_in != N_IN || (size_t)out_size != O_END || ws_size < WS_END) { fprintf(stderr, "kernel_launch: unexpected sizes n_in %d out %d ws %zu (need %zu)\n", n_in, out_size, ws_size, (size_t)WS_END); grid = -1; return; }
        int dev = 0, cus = 0, per_cu = 0;
        hipGetDevice(&dev); hipDeviceGetAttribute(&cus, hipDeviceAttributeMultiprocessorCount, dev);
        hipFuncSetAttribute((const void*)fwd_kernel, hipFuncAttributeMaxDynamicSharedMemorySize, LDS_BYTES);
        hipOccupancyMaxActiveBlocksPerMultiprocessor(&per_cu, (const void*)fwd_kernel, NTHREADS, LDS_BYTES);
        if (per_cu < 1) { fprintf(stderr, "kernel_launch: occupancy query says %d blocks per CU\n", per_cu); per_cu = 1; }
        grid = cus * 1;
        (void)hipGetLastError();
    }
    if (grid < 0) return;
    hipMemsetAsync((char*)d_ws + WS_CTL, 0, CTL_BYTES, stream);
    Args a{};
    for (int i = 0; i < N_IN; ++i) a.in[i] = (const float*)d_in[i];
    a.out = (float*)d_out; a.ws = (unsigned char*)d_ws;
#if MK_COOP
    a.ph_lo = 0; a.ph_hi = NPHASE;
    void* params[] = {&a};
    hipError_t e = hipLaunchCooperativeKernel((const void*)fwd_kernel, dim3(grid), dim3(NTHREADS), params, LDS_BYTES, stream);
    if (e != hipSuccess) fprintf(stderr, "cooperative launch failed: %s\n", hipGetErrorString(e));
#else
    for (int p = 0; p < NPHASE; ++p) { a.ph_lo = p; a.ph_hi = p + 1; hipLaunchKernelGGL(fwd_kernel, dim3(grid), dim3(NTHREADS), LDS_BYTES, stream, a); }
#endif
}
#endif
```

```cpp
#ifndef HOST_EMU
#include <hip/hip_runtime.h>
#include <hip/hip_cooperative_groups.h>
#endif
#include <cstdio>
#include <cstdint>
#include <cmath>

#ifdef HOST_EMU
constexpr int D_MODEL = 512, BATCH = 2, SEQ = 128, DEC_BATCH = 32, DEC_SEQ = 8;
#else
constexpr int D_MODEL = 2048, BATCH = 4, SEQ = 2048, DEC_BATCH = 128, DEC_SEQ = 8;
#endif
constexpr int D = D_MODEL, MIX_A = D / 2, MIX_B = D - MIX_A, HD = 128, NH = MIX_A / HD, CHUNK = 64, NG = MIX_B / 16, NP = 64;
constexpr int QKV = 3 * MIX_A, PROJ = QKV + MIX_A + 2 * NH + MIX_B;
constexpr int D_FF = ((8 * D + 767) / 768) * 256;
constexpr int MP = BATCH * SEQ, MS = DEC_BATCH * DEC_SEQ, M = MP + MS, NB = BATCH + DEC_BATCH;
constexpr int NIN = QKV + MIX_A + MIX_B + 256;
constexpr int NT_QKV = QKV / 256, NT_Z = MIX_A / 256, NT_U = MIX_B / 256;
constexpr float EPS = 1e-6f;
static_assert(MP % 256 == 0 && MS % 256 == 0 && D % 256 == 0 && QKV % 256 == 0 && MIX_A % 256 == 0 && D_FF % 128 == 0 && 2 * NH <= 16, "shape");
static_assert(MIX_A == MIX_B && SEQ % CHUNK == 0 && DEC_SEQ == 8 && DEC_BATCH % 4 == 0, "shape");

#ifdef HOST_EMU
#define LAS
#define GAS
#define DEVI inline
#define WAIT_VM(n)
#define WAIT_LGKM(n)
#define CFENCE()
#define WAVE_LDS_SYNC() emu_wave_sync()
DEVI float f_exp(float x) { return expf(x); }
DEVI float f_rsqrt(float x) { return 1.0f / sqrtf(x); }
DEVI float f_sin(float x) { return sinf(x); }
DEVI float f_cos(float x) { return cosf(x); }
DEVI float f_rcp(float x) { return 1.0f / x; }
#else
#define LAS __attribute__((address_space(3)))
#define GAS __attribute__((address_space(1)))
#define DEVI __device__ __forceinline__
#define WAIT_VM(n) asm volatile("s_waitcnt vmcnt(" #n ")" ::: "memory")
#define WAIT_LGKM(n) asm volatile("s_waitcnt lgkmcnt(" #n ")" ::: "memory")
#define CFENCE() asm volatile("" ::: "memory")
#define WAVE_LDS_SYNC() asm volatile("s_waitcnt lgkmcnt(0)" ::: "memory")
DEVI float f_exp(float x) { return __expf(x); }
DEVI float f_rsqrt(float x) { return rsqrtf(x); }
DEVI float f_sin(float x) { return sinf(x); }
DEVI float f_cos(float x) { return cosf(x); }
DEVI float f_rcp(float x) { return __builtin_amdgcn_rcpf(x); }
namespace cg = cooperative_groups;
#endif

typedef unsigned short bf16;
typedef short bf16x8 __attribute__((ext_vector_type(8)));
typedef float f32x4 __attribute__((ext_vector_type(4)));
typedef float f32x16 __attribute__((ext_vector_type(16)));
typedef unsigned u32x4 __attribute__((ext_vector_type(4)));
typedef unsigned u32x2 __attribute__((ext_vector_type(2)));

DEVI unsigned f2bf(float f) { unsigned u = __builtin_bit_cast(unsigned, f); return (u + 0x7fffu + ((u >> 16) & 1u)) >> 16; }
DEVI float bf2f(unsigned h) { return __builtin_bit_cast(float, (h & 0xffffu) << 16); }
#ifndef HOST_EMU
typedef float f32x2_ __attribute__((ext_vector_type(2)));
typedef __bf16 bf16x2_ __attribute__((ext_vector_type(2)));
#endif
DEVI unsigned pk2(float lo, float hi) {
#ifdef HOST_EMU
    return f2bf(lo) | (f2bf(hi) << 16);
#else
    const f32x2_ v = {lo, hi}; return __builtin_bit_cast(unsigned, __builtin_convertvector(v, bf16x2_));
#endif
}
DEVI float sigmoidf_(float x) { return f_rcp(1.0f + f_exp(-x)); }
DEVI float siluf_(float x) { return x * sigmoidf_(x); }
DEVI float geluf_(float x) { const float u = 0.7978845608028654f * (x + 0.044715f * x * x * x); const float e = f_exp(2.0f * u); return 0.5f * x * (2.0f - 2.0f * f_rcp(e + 1.0f)); }
DEVI float wave_sum(float v) {
#pragma unroll
    for (int o = 1; o < 64; o <<= 1) v += __shfl_xor(v, o);
    return v;
}

namespace pg8 {
constexpr int BM = 256, BK = 64, HALF = 128, HTB = HALF * BK * 2, STAGE_BYTES = 8 * HTB, NXCD = 8, WGM = 8;
DEVI int lds_byte(int r, int c) { const int st = (r >> 4) * 2 + (c >> 5), rr = r & 15, cc = c & 31, ob = rr * 64 + cc * 2; return st * 1024 + (ob ^ (((ob >> 9) & 1) << 5)); }
DEVI void stage_rc(int b, int& R, int& C) { const int st = b / 1024, sb = b % 1024, swz = sb ^ (((sb >> 9) & 1) << 5); R = (st >> 1) * 16 + swz / 64; C = (st & 1) * 32 + (swz % 64) / 2; }
DEVI int perm32(int rho) { const int n = rho >> 4, i = rho & 15; return 8 * (i >> 2) + 4 * n + (i & 3); }
struct Unit { int pm, pn; };
struct Gemm { const bf16* A; const bf16* Bt; int M, N, K; };
struct StaticOrder {
    int nM, nN, nwg, G, c;
    DEVI void init(int M_, int N_, int G_, int c_) { nM = M_ / BM; nN = N_ / BM; nwg = nM * nN; G = G_; c = c_; }
    DEVI bool next(int i, Unit& u) const {
        const long L = (long)i * G + c; if (L >= nwg) return false;
        int wgid = (int)L; { const int q = nwg / NXCD, r = nwg % NXCD, xcd = wgid % NXCD, off = wgid / NXCD; wgid = (xcd < r ? xcd * (q + 1) : r * (q + 1) + (xcd - r) * q) + off; }
        const int nig = WGM * nN, gid = wgid / nig, fm = gid * WGM, gsz = (nM - fm) < WGM ? (nM - fm) : WGM;
        u.pm = fm + ((wgid % nig) % gsz); u.pn = (wgid % nig) / gsz; return true;
    }
};
template <class Epi, bool ALIGN_EPI, bool SP2>
DEVI void gemm_phase(LAS unsigned char* lds, const Gemm g, const StaticOrder& S, const Epi& E) {
    const int tid = threadIdx.x, wid = __builtin_amdgcn_readfirstlane(tid >> 6), lane = tid & 63, wr = wid >> 2, wc = wid & 3, fr = lane & 15, fq = lane >> 4;
    const int K = g.K, nt = K / BK;
    unsigned voffA[2], voffB[2];
#pragma unroll
    for (int i = 0; i < 2; ++i) { int R, C; stage_rc(tid * 16 + i * 8192, R, C); const int Rb = Epi::PERM ? ((R & ~31) + perm32(R & 31)) : R;
        voffA[i] = (unsigned)(R * K + C) * 2u; voffB[i] = (unsigned)(Rb * K + C) * 2u; }
    const size_t kstep = (size_t)(BK * 2);
    const size_t hstep = (size_t)HALF * K * 2;
    const size_t tstep = 2 * hstep;
    const unsigned ldsw = (unsigned)wid * 1024u;
    const int aoff = lds_byte(wr * 64 + fr, fq * 8), boff = lds_byte(wc * 32 + fr, fq * 8);
#define PG8_SA(b, h) (((b) * 2 + (h)) * HTB)
#define PG8_SB(b, h) ((4 + (b) * 2 + (h)) * HTB)
#define PG8_STAGE(bufoff, gbase, voff) do { _Pragma("unroll") for (int _i = 0; _i < 2; ++_i) \
        __builtin_amdgcn_global_load_lds((const unsigned*)((const char*)(gbase) + (voff)[_i]), (LAS unsigned*)(lds + (bufoff) + ldsw + _i * 8192), 16, 0, 0); } while (0)
#define PG8_LDA(dst, b, h) do { _Pragma("unroll") for (int m = 0; m < 4; ++m) _Pragma("unroll") for (int k = 0; k < 2; ++k) dst[m][k] = *(const LAS bf16x8*)(lds + PG8_SA(b, h) + aoff + m * 2048 + k * 1024); } while (0)
#define PG8_LDB(dst, b, h) do { _Pragma("unroll") for (int n = 0; n < 2; ++n) _Pragma("unroll") for (int k = 0; k < 2; ++k) dst[n][k] = *(const LAS bf16x8*)(lds + PG8_SB(b, h) + boff + n * 2048 + k * 1024); } while (0)
#define PG8_MMA(ai, bj, At, Bt) do { __builtin_amdgcn_s_setprio(1); _Pragma("unroll") for (int m = 0; m < 4; ++m) _Pragma("unroll") for (int n = 0; n < 2; ++n) _Pragma("unroll") for (int k = 0; k < 2; ++k) \
        acc[ai][bj][m][n] = __builtin_amdgcn_mfma_f32_16x16x32_bf16(Bt[n][k], At[m][k], acc[ai][bj][m][n], 0, 0, 0); __builtin_amdgcn_s_setprio(0); } while (0)
#define PG8_WAIT_V(n) WAIT_VM(n)
#define PG8_WAIT_L(n) WAIT_LGKM(n)
#define PG8_BAR __builtin_amdgcn_s_barrier()
#define PG8_SCHED __builtin_amdgcn_sched_barrier(0)
    Unit cur, nxt; int ui = 0;
    if (!S.next(0, cur)) return;
    f32x4 acc[2][2][4][2];
#pragma unroll
    for (int a = 0; a < 2; ++a)
#pragma unroll
        for (int b = 0; b < 2; ++b)
#pragma unroll
            for (int m = 0; m < 4; ++m)
#pragma unroll
                for (int n = 0; n < 2; ++n) acc[a][b][m][n] = (f32x4){0.f, 0.f, 0.f, 0.f};
    bf16x8 At[4][2], B0[2][2], B1[2][2];
    const char* cA = (const char*)g.A + (size_t)cur.pm * tstep; const char* cB = (const char*)g.Bt + (size_t)cur.pn * tstep;
    if constexpr (SP2) {
        PG8_STAGE(PG8_SB(0, 0), cB, voffB); PG8_STAGE(PG8_SB(0, 1), cB + hstep, voffB); PG8_STAGE(PG8_SA(0, 0), cA, voffA); PG8_STAGE(PG8_SA(0, 1), cA + hstep, voffA);
        if (wr == 1) PG8_BAR;
        PG8_WAIT_V(2); PG8_BAR;
        PG8_STAGE(PG8_SB(1, 0), cB + kstep, voffB); PG8_STAGE(PG8_SA(1, 0), cA + kstep, voffA); PG8_STAGE(PG8_SB(1, 1), cB + hstep + kstep, voffB);
        PG8_WAIT_V(6); PG8_BAR;
    } else {
        PG8_STAGE(PG8_SB(0, 0), cB, voffB); PG8_STAGE(PG8_SA(0, 0), cA, voffA); PG8_STAGE(PG8_SB(0, 1), cB + hstep, voffB); PG8_STAGE(PG8_SA(0, 1), cA + hstep, voffA);
        if (wr == 1) PG8_BAR;
        PG8_WAIT_V(4); PG8_BAR;
        PG8_STAGE(PG8_SB(1, 0), cB + kstep, voffB); PG8_STAGE(PG8_SA(1, 0), cA + kstep, voffA); PG8_STAGE(PG8_SB(1, 1), cB + hstep + kstep, voffB);
        PG8_WAIT_V(6); PG8_BAR;
    }
    for (;;) {
        const bool has_next = S.next(ui + 1, nxt);
        const char* nA = has_next ? (const char*)g.A + (size_t)nxt.pm * tstep : cA; const char* nB = has_next ? (const char*)g.Bt + (size_t)nxt.pn * tstep : cB;
#define PG8_KBODY \
            const bool last = (t == nt - 2); \
            const char* a1 = cA + (size_t)(t + 1) * kstep; \
            const char* a2 = last ? nA : cA + (size_t)(t + 2) * kstep; const char* b2 = last ? nB : cB + (size_t)(t + 2) * kstep; \
            const char* a3 = a2 + kstep; const char* b3 = b2 + kstep; \
            if constexpr (SP2) { \
            PG8_LDB(B0, 0, 0); PG8_LDB(B1, 0, 1); PG8_SCHED; PG8_LDA(At, 0, 0); PG8_STAGE(PG8_SA(1, 1), a1 + hstep, voffA); \
            PG8_WAIT_V(8); PG8_WAIT_L(0); PG8_BAR; PG8_MMA(0, 0, At, B0); PG8_MMA(0, 1, At, B1); PG8_BAR; PG8_SCHED; \
            PG8_LDA(At, 0, 1); PG8_STAGE(PG8_SB(0, 0), b2, voffB); PG8_STAGE(PG8_SB(0, 1), b2 + hstep, voffB); PG8_STAGE(PG8_SA(0, 0), a2, voffA); \
            PG8_WAIT_V(8); PG8_WAIT_L(0); PG8_BAR; PG8_MMA(1, 0, At, B0); PG8_MMA(1, 1, At, B1); PG8_BAR; PG8_SCHED; \
            PG8_LDB(B0, 1, 0); PG8_LDB(B1, 1, 1); PG8_SCHED; PG8_LDA(At, 1, 0); PG8_STAGE(PG8_SA(0, 1), a2 + hstep, voffA); \
            PG8_WAIT_V(8); PG8_WAIT_L(0); PG8_BAR; PG8_MMA(0, 0, At, B0); PG8_MMA(0, 1, At, B1); PG8_BAR; PG8_SCHED; \
            PG8_LDA(At, 1, 1); PG8_STAGE(PG8_SB(1, 0), b3, voffB); PG8_STAGE(PG8_SB(1, 1), b3 + hstep, voffB); PG8_STAGE(PG8_SA(1, 0), a3, voffA); \
            PG8_WAIT_V(8); PG8_WAIT_L(0); PG8_BAR; PG8_MMA(1, 0, At, B0); PG8_MMA(1, 1, At, B1); PG8_BAR; PG8_SCHED; \
            } else { \
            PG8_LDB(B0, 0, 0); PG8_SCHED; PG8_LDA(At, 0, 0); PG8_STAGE(PG8_SA(1, 1), a1 + hstep, voffA); \
            PG8_WAIT_L(8); PG8_BAR; PG8_WAIT_L(0); PG8_MMA(0, 0, At, B0); PG8_BAR; PG8_SCHED; \
            PG8_LDB(B1, 0, 1); PG8_STAGE(PG8_SB(0, 0), b2, voffB); \
            PG8_BAR; PG8_WAIT_L(0); PG8_MMA(0, 1, At, B1); PG8_BAR; \
            PG8_LDA(At, 0, 1); PG8_STAGE(PG8_SA(0, 0), a2, voffA); \
            PG8_BAR; PG8_WAIT_L(0); PG8_MMA(1, 0, At, B0); PG8_BAR; PG8_SCHED; \
            PG8_STAGE(PG8_SB(0, 1), b2 + hstep, voffB); \
            PG8_WAIT_V(6); PG8_BAR; PG8_MMA(1, 1, At, B1); PG8_BAR; \
            PG8_LDB(B0, 1, 0); PG8_SCHED; PG8_LDA(At, 1, 0); PG8_STAGE(PG8_SA(0, 1), a2 + hstep, voffA); \
            PG8_WAIT_L(8); PG8_BAR; PG8_WAIT_L(0); PG8_MMA(0, 0, At, B0); PG8_BAR; PG8_SCHED; \
            PG8_LDB(B1, 1, 1); PG8_STAGE(PG8_SB(1, 0), b3, voffB); \
            PG8_BAR; PG8_WAIT_L(0); PG8_MMA(0, 1, At, B1); PG8_BAR; \
            PG8_LDA(At, 1, 1); PG8_STAGE(PG8_SA(1, 0), a3, voffA); \
            PG8_BAR; PG8_WAIT_L(0); PG8_MMA(1, 0, At, B0); PG8_BAR; PG8_SCHED; \
            PG8_STAGE(PG8_SB(1, 1), b3 + hstep, voffB); \
            PG8_WAIT_V(6); PG8_BAR; PG8_MMA(1, 1, At, B1); PG8_BAR; \
            } \
         \

        if constexpr (Epi::HAS_MID) {
            for (int t = 0; t < E.tmid; t += 2) { PG8_KBODY }
            E.mid(acc, cur, wr, fr);
            for (int t = E.tmid; t < nt; t += 2) { PG8_KBODY }
        } else {
            for (int t = 0; t < nt; t += 2) { PG8_KBODY }
        }
#undef PG8_KBODY
        if constexpr (ALIGN_EPI) { if (wr == 0) PG8_BAR; }
        E(acc, cur, wr, wc, fr, fq);
        if (!has_next) break;
#pragma unroll
        for (int a = 0; a < 2; ++a)
#pragma unroll
            for (int b = 0; b < 2; ++b)
#pragma unroll
                for (int m = 0; m < 4; ++m)
#pragma unroll
                    for (int n = 0; n < 2; ++n) acc[a][b][m][n] = (f32x4){0.f, 0.f, 0.f, 0.f};
        cur = nxt; cA = nA; cB = nB; ++ui;
        if constexpr (ALIGN_EPI) { if (wr == 1) PG8_BAR; }
    }
    PG8_WAIT_V(0);
    if constexpr (!ALIGN_EPI) { if (wr == 0) PG8_BAR; }
    PG8_BAR;
#undef PG8_SA
#undef PG8_SB
#undef PG8_STAGE
#undef PG8_LDA
#undef PG8_LDB
#undef PG8_MMA
#undef PG8_WAIT_V
#undef PG8_WAIT_L
#undef PG8_BAR
#undef PG8_SCHED
}
}

constexpr size_t al256(size_t x) { return (x + 255) & ~(size_t)255; }
constexpr size_t WS_CTL = 0, CTL_BYTES = 1u << 20;
constexpr size_t CTL_RS5 = 65536;
static_assert(CTL_RS5 + (size_t)M * 8 <= CTL_BYTES, "ctl");
constexpr float FX_SCALE = 4294967296.0f, FX_INV = 1.0f / 4294967296.0f;
constexpr size_t WS_WIN = WS_CTL + CTL_BYTES;
constexpr size_t WS_WGLU = WS_WIN + al256((size_t)NIN * D * 2);
constexpr size_t WS_WOUT = WS_WGLU + al256((size_t)2 * MIX_B * MIX_B * 2);
constexpr size_t WS_WGU = WS_WOUT + al256((size_t)D * D * 2);
constexpr size_t WS_WDN = WS_WGU + al256((size_t)2 * D_FF * D * 2);
constexpr size_t WS_ASILU = WS_WDN + al256((size_t)D * D_FF * 2);
constexpr size_t WS_MOD = WS_ASILU + al256((size_t)256 * D * 2);
constexpr size_t WS_AB = WS_MOD + al256((size_t)NB * 6 * D * 4);
constexpr size_t WS_H12 = WS_AB + al256((size_t)M * 16 * 4);
constexpr size_t WS_ACAT = WS_H12 + al256((size_t)M * D * 2);
constexpr size_t WS_F = WS_H12;
constexpr size_t WS_QKVB = WS_ACAT + al256((size_t)M * D * 2);
constexpr size_t WS_ZB = WS_QKVB + al256((size_t)M * QKV * 2);
constexpr size_t WS_UB = WS_ZB + al256((size_t)M * MIX_A * 2);
constexpr size_t WS_Y5 = WS_UB + al256((size_t)M * MIX_B * 2);
constexpr size_t WS_HMID = WS_QKVB;
constexpr size_t WS_MIX = WS_Y5 + al256((size_t)M * MIX_B * 2);
static_assert(WS_ACAT == WS_H12 + (size_t)M * D * 2 && WS_MIX - WS_QKVB >= (size_t)M * D_FF * 2, "overlay");
constexpr int FR_U = 0, FR_W = 32768, FR_Q = FR_W + 16384, FR_A = FR_Q + 16384, FR_K = FR_A + 8192, FR_SC = FR_K + 16384, CHUNK_BYTES = FR_SC + 256;
constexpr int NCHUNK_P = BATCH * NH * (SEQ / CHUNK);
constexpr size_t WS_FRAG = WS_MIX;
constexpr size_t FRAG_TOTAL = (size_t)NCHUNK_P * CHUNK_BYTES;
constexpr size_t WS_END = WS_MIX + (FRAG_TOTAL > (size_t)M * D * 4 ? FRAG_TOTAL : (size_t)M * D * 4);

constexpr size_t O_YP = 0, O_YS = O_YP + (size_t)MP * D, O_CONVP = O_YS + (size_t)MS * D, O_DELP = O_CONVP + (size_t)BATCH * 3 * QKV,
                 O_SREP = O_DELP + (size_t)BATCH * NH * HD * HD, O_SIMP = O_SREP + (size_t)BATCH * NG * NP, O_CONVS = O_SIMP + (size_t)BATCH * NG * NP,
                 O_DELS = O_CONVS + (size_t)DEC_BATCH * 3 * QKV, O_SRES = O_DELS + (size_t)DEC_BATCH * NH * HD * HD, O_SIMS = O_SRES + (size_t)DEC_BATCH * NG * NP,
                 O_END = O_SIMS + (size_t)DEC_BATCH * NG * NP;

constexpr int RING_BYTES = 131072, LDS_BYTES = 147456;
constexpr int NWAVES = 8, NTHREADS = 512;

enum InIdx { I_XP = 0, I_XS, I_CP, I_CS, I_SCONV, I_SDELTA, I_SSRE, I_SSIM, I_WADA, I_BADA, I_GPREMIX, I_GPOSTMIX, I_GPREFFN, I_GPOSTFFN, I_WIN, I_WCONV, I_ALOG, I_DTBIAS,
             I_GDN, I_LAMRE, I_LAMIM, I_LOGSTEP, I_BRE, I_BIM, I_CRE, I_CIM, I_DSKIP, I_WGLU, I_GS5, I_WOUT, I_WGATE, I_WUP, I_WDOWN, N_IN };
struct Args { const float* in[N_IN]; float* out; unsigned char* ws; int ph_lo, ph_hi; };

struct Frame {
    LAS unsigned char* lds;
    const float* const* in; float* out; unsigned char* ws;
    int tid, lane, wave, vcu, G;
};
DEVI const float* xrow(const Frame& F, int m) { return m < MP ? F.in[I_XP] + (size_t)m * D : F.in[I_XS] + (size_t)(m - MP) * D; }
DEVI int modrow(int m) { return m < MP ? m / SEQ : BATCH + (m - MP) / DEC_SEQ; }

DEVI void tr_item(const float* W, int ldw, int srccol, int k0, const float* kscale, bf16* WT, int dstK, int drow, int dk0, LAS float* scr, int lane) {
#pragma unroll 8
    for (int i = 0; i < 32; ++i) { const int kk = 2 * i + (lane >> 5); float v = W[(size_t)(k0 + kk) * ldw + srccol + (lane & 31)]; if (kscale) v *= kscale[k0 + kk]; scr[kk * 33 + (lane & 31)] = v; }
    WAVE_LDS_SYNC();
    const int c = lane & 7;
#pragma unroll
    for (int j = 0; j < 4; ++j) { const int n = (lane >> 3) + 8 * j; const LAS float* s = scr + (8 * c) * 33 + n;
        u32x4 o; o.x = pk2(s[0 * 33], s[1 * 33]); o.y = pk2(s[2 * 33], s[3 * 33]); o.z = pk2(s[4 * 33], s[5 * 33]); o.w = pk2(s[6 * 33], s[7 * 33]);
        *(u32x4*)(WT + (size_t)(drow + n) * dstK + dk0 + 8 * c) = o; }
    WAVE_LDS_SYNC();
}
DEVI void p0_prologue(Frame& F) {
    LAS float* scr = (LAS float*)(F.lds + F.wave * 16384);
    const int gw = F.vcu * NWAVES + F.wave, NGW = F.G * NWAVES;
    bf16* Win = (bf16*)(F.ws + WS_WIN); bf16* Wglu = (bf16*)(F.ws + WS_WGLU); bf16* Wout = (bf16*)(F.ws + WS_WOUT); bf16* Wgu = (bf16*)(F.ws + WS_WGU); bf16* Wdn = (bf16*)(F.ws + WS_WDN);
    constexpr int NB_IN = (QKV + MIX_A + MIX_B) / 32, I_IN = (D / 64) * NB_IN;
    constexpr int NB_GLU = 2 * MIX_B / 32, I_GLU = (MIX_B / 64) * NB_GLU;
    constexpr int NB_OUT = D / 32, I_OUT = (D / 64) * NB_OUT;
    constexpr int NB_GU = 2 * D_FF / 32, I_GU = (D / 64) * NB_GU;
    constexpr int NB_DN = D / 32, I_DN = (D_FF / 64) * NB_DN;
    constexpr int NITEMS = I_IN + I_GLU + I_OUT + I_GU + I_DN;
    for (int it = gw; it < NITEMS; it += NGW) {
        int r = it;
        if (r < I_IN) { const int kb = r / NB_IN, drow = 32 * (r % NB_IN); const int src = drow + (drow >= QKV + MIX_A ? 2 * NH : 0);
            tr_item(F.in[I_WIN], PROJ, src, 64 * kb, nullptr, Win, D, drow, 64 * kb, scr, F.lane); continue; } r -= I_IN;
        if (r < I_GLU) { const int kb = r / NB_GLU, drow = 32 * (r % NB_GLU); const int src = ((drow >> 7) & 1) * MIX_B + 128 * (drow >> 8) + (drow & 127);
            tr_item(F.in[I_WGLU], 2 * MIX_B, src, 64 * kb, nullptr, Wglu, MIX_B, drow, 64 * kb, scr, F.lane); continue; } r -= I_GLU;
        if (r < I_OUT) { const int kb = r / NB_OUT, drow = 32 * (r % NB_OUT); const int k0 = 64 * kb;
            tr_item(F.in[I_WOUT], D, drow, k0, k0 >= MIX_A ? F.in[I_GS5] - MIX_A : nullptr, Wout, D, drow, (k0 + MIX_B) % D, scr, F.lane); continue; } r -= I_OUT;
        if (r < I_GU) { const int kb = r / NB_GU, drow = 32 * (r % NB_GU); const int src = 128 * (drow >> 8) + (drow & 127);
            tr_item(((drow >> 7) & 1) ? F.in[I_WUP] : F.in[I_WGATE], D_FF, src, 64 * kb, nullptr, Wgu, D, drow, 64 * kb, scr, F.lane); continue; } r -= I_GU;
        { const int kb = r / NB_DN, drow = 32 * (r % NB_DN); tr_item(F.in[I_WDOWN], D, drow, 64 * kb, nullptr, Wdn, D_FF, drow, 64 * kb, scr, F.lane); }
    }
    const int gt = F.vcu * NTHREADS + F.tid, NGT = F.G * NTHREADS;
    for (int i = gt; i < 256 * D; i += NGT) { const int r = i / D, k = i % D;
        Win[(size_t)(QKV + MIX_A + MIX_B + r) * D + k] = (bf16)(r < 2 * NH ? f2bf(F.in[I_WIN][(size_t)k * PROJ + QKV + MIX_A + r]) : 0u); }
    bf16* As = (bf16*)(F.ws + WS_ASILU);
    for (int i = gt; i < 256 * D; i += NGT) { const int r = i / D, k = i % D; float v = 0.f;
        if (r < NB) v = siluf_(r < BATCH ? F.in[I_CP][(size_t)r * D + k] : F.in[I_CS][(size_t)(r - BATCH) * D + k]);
        As[i] = (bf16)f2bf(v); }
}

DEVI void p1_ada(Frame& F) {
    constexpr int MT = (NB + 15) / 16, NCOL = 48, UNITS = 6 * D / NCOL, KW = D / NWAVES, KS = KW / 32, SLOT = MT * 3 * 256;
    static_assert(6 * D % NCOL == 0 && KW % 32 == 0 && 4 * SLOT * 4 <= RING_BYTES, "ada");
    const bf16* As = (const bf16*)(F.ws + WS_ASILU); const float* W = F.in[I_WADA]; float* mod = (float*)(F.ws + WS_MOD);
    const int lane = F.lane, q = lane >> 4, c16 = lane & 15, wid = F.wave;
    LAS float* red = (LAS float*)F.lds;
    for (int unit = F.vcu; unit < UNITS; unit += F.G) {
        const int n0 = unit * NCOL;
        f32x4 acc[MT][3];
#pragma unroll
        for (int mt = 0; mt < MT; ++mt)
#pragma unroll
            for (int nt = 0; nt < 3; ++nt) acc[mt][nt] = (f32x4){0.f, 0.f, 0.f, 0.f};
        for (int ks = 0; ks < KS; ++ks) {
            const int k0 = wid * KW + 32 * ks;
            bf16x8 b[3];
#pragma unroll
            for (int nt = 0; nt < 3; ++nt) { float w[8];
#pragma unroll
                for (int j = 0; j < 8; ++j) w[j] = W[(size_t)(k0 + 8 * q + j) * (6 * D) + n0 + 16 * nt + c16];
                u32x4 p; p.x = pk2(w[0], w[1]); p.y = pk2(w[2], w[3]); p.z = pk2(w[4], w[5]); p.w = pk2(w[6], w[7]); b[nt] = __builtin_bit_cast(bf16x8, p); }
#pragma unroll
            for (int mt = 0; mt < MT; ++mt) { const bf16x8 a = *(const bf16x8*)(As + (size_t)(16 * mt + c16) * D + k0 + 8 * q);
#pragma unroll
                for (int nt = 0; nt < 3; ++nt) acc[mt][nt] = __builtin_amdgcn_mfma_f32_16x16x32_bf16(a, b[nt], acc[mt][nt], 0, 0, 0); }
        }
        for (int s = 4; s >= 1; s >>= 1) {
            if (wid >= s && wid < 2 * s) {
#pragma unroll
                for (int mt = 0; mt < MT; ++mt)
#pragma unroll
                    for (int nt = 0; nt < 3; ++nt) *(LAS f32x4*)(red + (wid - s) * SLOT + (mt * 3 + nt) * 256 + lane * 4) = acc[mt][nt];
            }
            __syncthreads();
            if (wid < s) {
#pragma unroll
                for (int mt = 0; mt < MT; ++mt)
#pragma unroll
                    for (int nt = 0; nt < 3; ++nt) acc[mt][nt] += *(const LAS f32x4*)(red + wid * SLOT + (mt * 3 + nt) * 256 + lane * 4);
            }
            __syncthreads();
        }
        if (wid == 0) {
#pragma unroll
            for (int mt = 0; mt < MT; ++mt)
#pragma unroll
                for (int nt = 0; nt < 3; ++nt) { const int col = n0 + 16 * nt + c16; const float bias = F.in[I_BADA][col];
#pragma unroll
                    for (int r = 0; r < 4; ++r) { const int row = 16 * mt + 4 * q + r; if (row < NB) mod[(size_t)row * (6 * D) + col] = acc[mt][nt][r] + bias; } }
        }
    }
}

constexpr int NV = D / 256;
DEVI void p2_h1(Frame& F) {
    const int gw = F.wave * F.G + F.vcu, NGW = F.G * NWAVES; const float* mod = (const float*)(F.ws + WS_MOD); bf16* H = (bf16*)(F.ws + WS_H12);
    for (int m = gw; m < M; m += NGW) {
        const f32x4* xr = (const f32x4*)xrow(F, m) + F.lane; const float* md = mod + (size_t)modrow(m) * 6 * D;
        f32x4 v[NV]; float s = 0.f;
#pragma unroll
        for (int j = 0; j < NV; ++j) { v[j] = xr[64 * j]; s += (v[j].x * v[j].x + v[j].y * v[j].y) + (v[j].z * v[j].z + v[j].w * v[j].w); }
        const float rstd = f_rsqrt(wave_sum(s) * (1.f / D) + EPS);
#pragma unroll
        for (int j = 0; j < NV; ++j) { const int idx = 4 * (F.lane + 64 * j);
            const f32x4 g = *(const f32x4*)(F.in[I_GPREMIX] + idx), sh = *(const f32x4*)(md + idx), sc = *(const f32x4*)(md + D + idx);
            const f32x4 h = v[j] * rstd * g * (sc + 1.0f) + sh; u32x2 o; o.x = pk2(h.x, h.y); o.y = pk2(h.z, h.w);
            *(u32x2*)(H + (size_t)m * D + idx) = o; }
    }
}
DEVI void p8_x1h2(Frame& F) {
    const int gw = F.wave * F.G + F.vcu, NGW = F.G * NWAVES; const float* mod = (const float*)(F.ws + WS_MOD); bf16* H = (bf16*)(F.ws + WS_H12);
    float* mix = (float*)(F.ws + WS_MIX);
    for (int m = gw; m < M; m += NGW) {
        const f32x4* xr = (const f32x4*)xrow(F, m) + F.lane; const float* md = mod + (size_t)modrow(m) * 6 * D; f32x4* mr = (f32x4*)(mix + (size_t)m * D) + F.lane;
        f32x4 v[NV]; float sm = 0.f;
#pragma unroll
        for (int j = 0; j < NV; ++j) { v[j] = mr[64 * j]; sm += (v[j].x * v[j].x + v[j].y * v[j].y) + (v[j].z * v[j].z + v[j].w * v[j].w); }
        const float rm = f_rsqrt(wave_sum(sm) * (1.f / D) + EPS);
        float s = 0.f;
#pragma unroll
        for (int j = 0; j < NV; ++j) { const int idx = 4 * (F.lane + 64 * j);
            const f32x4 g = *(const f32x4*)(F.in[I_GPOSTMIX] + idx), gt = *(const f32x4*)(md + 2 * D + idx);
            v[j] = xr[64 * j] + gt * (v[j] * rm * g); mr[64 * j] = v[j];
            s += (v[j].x * v[j].x + v[j].y * v[j].y) + (v[j].z * v[j].z + v[j].w * v[j].w); }
        const float rstd = f_rsqrt(wave_sum(s) * (1.f / D) + EPS);
#pragma unroll
        for (int j = 0; j < NV; ++j) { const int idx = 4 * (F.lane + 64 * j);
            const f32x4 g = *(const f32x4*)(F.in[I_GPREFFN] + idx), sh = *(const f32x4*)(md + 3 * D + idx), sc = *(const f32x4*)(md + 4 * D + idx);
            const f32x4 h = v[j] * rstd * g * (sc + 1.0f) + sh; u32x2 o; o.x = pk2(h.x, h.y); o.y = pk2(h.z, h.w);
            *(u32x2*)(H + (size_t)m * D + idx) = o; }
    }
}
DEVI void p11_out(Frame& F) {
    const int gw = F.wave * F.G + F.vcu, NGW = F.G * NWAVES; const float* mod = (const float*)(F.ws + WS_MOD);
    const float* x1 = (const float*)(F.ws + WS_MIX); const float* f = (const float*)(F.ws + WS_F);
    for (int m = gw; m < M; m += NGW) {
        const float* md = mod + (size_t)modrow(m) * 6 * D;
        const f32x4* xr = (const f32x4*)(x1 + (size_t)m * D) + F.lane; const f32x4* fr = (const f32x4*)(f + (size_t)m * D) + F.lane; f32x4* o = (f32x4*)(F.out + O_YP + (size_t)m * D) + F.lane;
        f32x4 v[NV]; float s = 0.f;
#pragma unroll
        for (int j = 0; j < NV; ++j) { v[j] = fr[64 * j]; s += (v[j].x * v[j].x + v[j].y * v[j].y) + (v[j].z * v[j].z + v[j].w * v[j].w); }
        const float rf = f_rsqrt(wave_sum(s) * (1.f / D) + EPS);
#pragma unroll
        for (int j = 0; j < NV; ++j) { const int idx = 4 * (F.lane + 64 * j);
            const f32x4 g = *(const f32x4*)(F.in[I_GPOSTFFN] + idx), gt = *(const f32x4*)(md + 5 * D + idx);
            o[64 * j] = xr[64 * j] + gt * (v[j] * rf * g); }
    }
}
template <int VW> DEVI void ld_bf(const bf16* p, float* o) {
    if constexpr (VW == 8) { const u32x4 w = *(const u32x4*)p; const unsigned ww[4] = {w.x, w.y, w.z, w.w};
#pragma unroll
        for (int e = 0; e < 4; ++e) { o[2 * e] = bf2f(ww[e]); o[2 * e + 1] = bf2f(ww[e] >> 16); } }
    else { const u32x2 w = *(const u32x2*)p; o[0] = bf2f(w.x); o[1] = bf2f(w.x >> 16); o[2] = bf2f(w.y); o[3] = bf2f(w.y >> 16); }
}
DEVI void p6_onorm(Frame& F) {
    constexpr int PL = MIX_A / 64, LPH = HD / PL, VW = PL >= 8 ? 8 : 4;
    static_assert(PL % VW == 0 && (LPH & (LPH - 1)) == 0, "onorm");
    const int gw = F.wave * F.G + F.vcu, NGW = F.G * NWAVES;
    const bf16* oraw = (const bf16*)(F.ws + WS_H12); const bf16* zb = (const bf16*)(F.ws + WS_ZB); bf16* acat = (bf16*)(F.ws + WS_ACAT);
    for (int m = gw; m < M; m += NGW) {
        float o[PL], z[PL]; float s = 0.f; const int c0 = F.lane * PL;
#pragma unroll
        for (int j = 0; j < PL / VW; ++j) { ld_bf<VW>(oraw + (size_t)m * D + c0 + VW * j, o + VW * j); ld_bf<VW>(zb + (size_t)m * MIX_A + c0 + VW * j, z + VW * j); }
#pragma unroll
        for (int j = 0; j < PL; ++j) s += o[j] * o[j];
#pragma unroll
        for (int d = 1; d < LPH; d <<= 1) s += __shfl_xor(s, d);
        const float rstd = f_rsqrt(s * (1.f / HD) + EPS);
#pragma unroll
        for (int j = 0; j < PL; j += 2) { const int d0 = (c0 + j) % HD;
            const float a = o[j] * rstd * F.in[I_GDN][d0] * siluf_(z[j]), b = o[j + 1] * rstd * F.in[I_GDN][d0 + 1] * siluf_(z[j + 1]);
            *(unsigned*)(acat + (size_t)m * D + MIX_B + c0 + j) = pk2(a, b); }
    }
}

using pg8::Unit;
DEVI void st8bf(bf16* p, const f32x4 v0, const f32x4 v1) { u32x4 w; w.x = pk2(v0[0], v0[1]); w.y = pk2(v0[2], v0[3]); w.z = pk2(v1[0], v1[1]); w.w = pk2(v1[2], v1[3]); *(u32x4*)p = w; }
struct EpiInProj {
    static constexpr bool PERM = true, HAS_MID = false; int tmid;
    bf16 *qkv, *z, *u; float *ab, *convp, *convs;
    DEVI void mid(f32x4 (&)[2][2][4][2], const Unit&, int, int) const {}
    DEVI void operator()(const f32x4 (&acc)[2][2][4][2], const Unit& un, int wr, int wc, int fr, int fq) const {
        const int row0 = un.pm * 256 + wr * 64 + fr, pn = un.pn;
#pragma unroll
        for (int ai = 0; ai < 2; ++ai)
#pragma unroll
            for (int m = 0; m < 4; ++m) { const int row = row0 + ai * 128 + m * 16;
                float* ct = nullptr;
                if (pn < NT_QKV) { if (row < MP) { const int t = row % SEQ; if (t >= SEQ - 3) ct = convp + ((size_t)(row / SEQ) * 3 + (t - (SEQ - 3))) * QKV; }
                                   else { const int r2 = row - MP, t = r2 % DEC_SEQ; if (t >= DEC_SEQ - 3) ct = convs + ((size_t)(r2 / DEC_SEQ) * 3 + (t - (DEC_SEQ - 3))) * QKV; } }
#pragma unroll
                for (int bj = 0; bj < 2; ++bj) { const int c0 = 128 * bj + 32 * wc + 8 * fq; const f32x4 v0 = acc[ai][bj][m][0], v1 = acc[ai][bj][m][1];
                    if (pn < NT_QKV) { const int col = pn * 256 + c0; st8bf(qkv + (size_t)row * QKV + col, v0, v1); if (ct) { *(f32x4*)(ct + col) = v0; *(f32x4*)(ct + col + 4) = v1; } }
                    else if (pn < NT_QKV + NT_Z) st8bf(z + (size_t)row * MIX_A + (pn - NT_QKV) * 256 + c0, v0, v1);
                    else if (pn < NT_QKV + NT_Z + NT_U) st8bf(u + (size_t)row * MIX_B + (pn - NT_QKV - NT_Z) * 256 + c0, v0, v1);
                    else if (c0 < 16) { *(f32x4*)(ab + (size_t)row * 16 + c0) = v0; *(f32x4*)(ab + (size_t)row * 16 + c0 + 4) = v1; } } }
    }
};
struct EpiGlu {
    static constexpr bool PERM = true, HAS_MID = false; int tmid;
    bf16* acat; unsigned long long* rs;
    DEVI void mid(f32x4 (&)[2][2][4][2], const Unit&, int, int) const {}
    DEVI void operator()(const f32x4 (&acc)[2][2][4][2], const Unit& un, int wr, int wc, int fr, int fq) const {
        const int row0 = un.pm * 256 + wr * 64 + fr, col = un.pn * 128 + 32 * wc + 8 * fq;
#pragma unroll
        for (int ai = 0; ai < 2; ++ai)
#pragma unroll
            for (int m = 0; m < 4; ++m) { const int row = row0 + ai * 128 + m * 16; f32x4 y[2]; float s = 0.f;
#pragma unroll
                for (int n = 0; n < 2; ++n)
#pragma unroll
                    for (int i = 0; i < 4; ++i) { const float v = acc[ai][0][m][n][i] * sigmoidf_(acc[ai][1][m][n][i]); y[n][i] = v; s += v * v; }
                st8bf(acat + (size_t)row * D + col, y[0], y[1]);
                s += __shfl_xor(s, 16); s += __shfl_xor(s, 32);
                if (fq == 0) atomicAdd(rs + row, (unsigned long long)(s * FX_SCALE)); }
    }
};
struct EpiSwiglu {
    static constexpr bool PERM = true, HAS_MID = false; int tmid;
    bf16* hm;
    DEVI void mid(f32x4 (&)[2][2][4][2], const Unit&, int, int) const {}
    DEVI void operator()(const f32x4 (&acc)[2][2][4][2], const Unit& un, int wr, int wc, int fr, int fq) const {
        const int row0 = un.pm * 256 + wr * 64 + fr, col = un.pn * 128 + 32 * wc + 8 * fq;
#pragma unroll
        for (int ai = 0; ai < 2; ++ai)
#pragma unroll
            for (int m = 0; m < 4; ++m) { const int row = row0 + ai * 128 + m * 16; f32x4 y[2];
#pragma unroll
                for (int n = 0; n < 2; ++n)
#pragma unroll
                    for (int i = 0; i < 4; ++i) y[n][i] = siluf_(acc[ai][0][m][n][i]) * acc[ai][1][m][n][i];
                st8bf(hm + (size_t)row * D_FF + col, y[0], y[1]); }
    }
};
template <bool MID> struct EpiF32Rs {
    static constexpr bool PERM = false, HAS_MID = MID; int tmid;
    float* C; const unsigned long long* rs_in;
    DEVI void mid(f32x4 (&acc)[2][2][4][2], const Unit& un, int wr, int fr) const {
#pragma unroll
        for (int ai = 0; ai < 2; ++ai)
#pragma unroll
            for (int m = 0; m < 4; ++m) { const int row = un.pm * 256 + wr * 64 + fr + ai * 128 + m * 16; const float sc = f_rsqrt((float)rs_in[row] * (FX_INV / MIX_B) + EPS);
#pragma unroll
                for (int bj = 0; bj < 2; ++bj)
#pragma unroll
                    for (int n = 0; n < 2; ++n) acc[ai][bj][m][n] *= sc; }
    }
    DEVI void operator()(const f32x4 (&acc)[2][2][4][2], const Unit& un, int wr, int wc, int fr, int fq) const {
        const int row0 = un.pm * 256 + wr * 64 + fr, col0 = un.pn * 256 + wc * 32 + 4 * fq;
#pragma unroll
        for (int ai = 0; ai < 2; ++ai)
#pragma unroll
            for (int m = 0; m < 4; ++m) { const int row = row0 + ai * 128 + m * 16; float* rp = C + (size_t)row * D + col0;
#pragma unroll
                for (int bj = 0; bj < 2; ++bj)
#pragma unroll
                    for (int n = 0; n < 2; ++n) *(f32x4*)(rp + bj * 128 + n * 16) = acc[ai][bj][m][n]; }
    }
};

template <int C> struct PrepCfg { static constexpr int CP = C < 32 ? 32 : C, MT = C / 16, SC = CP / 32, LDQ = 136, LDT = CP + 8; };
template <int C> struct PrepLds {
    using P = PrepCfg<C>;
    static constexpr int QS = 0, KS = QS + C * P::LDQ * 2, KBS = KS + C * P::LDQ * 2, VBT = KBS + C * P::LDQ * 2, KGT = VBT + 128 * P::LDT * 2,
                         LS = KGT + 128 * P::LDT * 2, TS = LS + C * (C + 4) * 4, AS = TS + C * P::LDT * 2, SCAL = (AS + C * P::LDT * 2 + 15) & ~15, END = SCAL + 3 * C * 4 + 16;
};
template <int C, int NVALID>
DEVI void delta_prep(Frame& F, LAS unsigned char* L, int seq_row0, int t0, int h, const float* conv_state, unsigned char* frag) {
    using P = PrepCfg<C>; using O = PrepLds<C>;
    constexpr int LDQ = P::LDQ, LDT = P::LDT, CP = P::CP, MT = P::MT, SC = P::SC;
    LAS bf16* Qs = (LAS bf16*)(L + O::QS); LAS bf16* Ks = (LAS bf16*)(L + O::KS); LAS bf16* Kbs = (LAS bf16*)(L + O::KBS); LAS bf16* VbT = (LAS bf16*)(L + O::VBT); LAS bf16* KgT = (LAS bf16*)(L + O::KGT);
    LAS float* Ls = (LAS float*)(L + O::LS); LAS bf16* Ts = (LAS bf16*)(L + O::TS); LAS bf16* As = (LAS bf16*)(L + O::AS); LAS float* gcs = (LAS float*)(L + O::SCAL); LAS float* bts = gcs + C; LAS float* egs = bts + C;
    const bf16* qkv = (const bf16*)(F.ws + WS_QKVB); const float* ab = (const float*)(F.ws + WS_AB);
    const int lane = F.lane, wid = F.wave, tid = F.tid, q4 = lane >> 4, c16 = lane & 15;
    if (wid == 0) {
        float g = 0.f, bt = 0.f;
        if (lane < NVALID) { const float* abr = ab + (size_t)(seq_row0 + t0 + lane) * 16; const float x = abr[h] + F.in[I_DTBIAS][h];
            const float sp = x > 20.f ? x : log1pf(f_exp(x)); g = -f_exp(F.in[I_ALOG][h]) * sp; bt = sigmoidf_(abr[NH + h]); }
        float gc = g;
#pragma unroll
        for (int d = 1; d < 64; d <<= 1) { const float o = __shfl_up(gc, d); if (lane >= d) gc += o; }
        if (lane < C) { gcs[lane] = gc; bts[lane] = bt; egs[lane] = f_exp(gc); }
    }
    if constexpr (CP > C) {
        for (int i = tid; i < 128 * (CP - C); i += NTHREADS) { const int r = i / (CP - C), c = C + i % (CP - C); VbT[r * LDT + c] = 0; KgT[r * LDT + c] = 0; }
        for (int i = tid; i < C * (CP - C); i += NTHREADS) { const int r = i / (CP - C), c = C + i % (CP - C); Ts[r * LDT + c] = 0; As[r * LDT + c] = 0; }
    }
    __syncthreads();
    {
        constexpr int RW = C / 8; const float* wc_ = F.in[I_WCONV];
        float w4[6][4]; int gcol[6];
#pragma unroll
        for (int s = 0; s < 6; ++s) { gcol[s] = (s >> 1) * MIX_A + h * HD + (s & 1) * 64 + lane;
#pragma unroll
            for (int j = 0; j < 4; ++j) w4[s][j] = wc_[(size_t)j * QKV + gcol[s]]; }
        const int tb = wid * RW;
        float win[6][3];
#pragma unroll
        for (int s = 0; s < 6; ++s)
#pragma unroll
            for (int j = 0; j < 3; ++j) { const int i = t0 + tb + j;
                float v = 0.f; if (i < 3) { if (conv_state) v = conv_state[(size_t)i * QKV + gcol[s]]; } else v = bf2f(qkv[(size_t)(seq_row0 + i - 3) * QKV + gcol[s]]);
                win[s][j] = v; }
        const float gl = gcs[C - 1];
#pragma unroll
        for (int r = 0; r < RW; ++r) { const int t = tb + r; const bool valid = t < NVALID;
            float val[6];
#pragma unroll
            for (int s = 0; s < 6; ++s) { float cur = 0.f; if (valid) cur = bf2f(qkv[(size_t)(seq_row0 + t0 + t) * QKV + gcol[s]]);
                const float cv = w4[s][0] * win[s][0] + w4[s][1] * win[s][1] + w4[s][2] * win[s][2] + w4[s][3] * cur;
                win[s][0] = win[s][1]; win[s][1] = win[s][2]; win[s][2] = cur; val[s] = valid ? siluf_(cv) : 0.f; }
            const float sq = wave_sum(val[0] * val[0] + val[1] * val[1]), sk = wave_sum(val[2] * val[2] + val[3] * val[3]);
            const float rq = f_rsqrt(sq + 1e-6f) * 0.08838834764831845f, rk = f_rsqrt(sk + 1e-6f);
            const float bt = bts[t], eg = egs[t];
#pragma unroll
            for (int e = 0; e < 2; ++e) { const int c = e * 64 + lane; const float qn = val[e] * rq, kn = val[2 + e] * rk, vv = val[4 + e];
                Qs[t * LDQ + c] = (bf16)f2bf(qn); Ks[t * LDQ + c] = (bf16)f2bf(kn); Kbs[t * LDQ + c] = (bf16)f2bf(kn * bt);
                VbT[c * LDT + t] = (bf16)f2bf(vv * bt); KgT[c * LDT + t] = (bf16)f2bf(kn * bt * eg); }
            (void)gl;
        }
    }
    __syncthreads();
    for (int tix = wid; tix < 2 * MT * MT; tix += NWAVES) {
        const int which = tix / (MT * MT), mi = (tix % (MT * MT)) / MT, nj = tix % MT;
        if (nj > mi) {
            if (which == 0) { for (int r = 0; r < 4; ++r) Ls[(16 * mi + 4 * q4 + r) * (C + 4) + 16 * nj + c16] = 0.f; }
            else { for (int r = 0; r < 4; ++r) As[(16 * mi + 4 * q4 + r) * LDT + 16 * nj + c16] = 0; }
            continue; }
        const LAS bf16* A = which == 0 ? Kbs : Qs; f32x4 acc = {0.f, 0.f, 0.f, 0.f};
#pragma unroll
        for (int s = 0; s < 4; ++s) { const bf16x8 a = *(const LAS bf16x8*)(A + (16 * mi + c16) * LDQ + 32 * s + 8 * q4), b = *(const LAS bf16x8*)(Ks + (16 * nj + c16) * LDQ + 32 * s + 8 * q4);
            acc = __builtin_amdgcn_mfma_f32_16x16x32_bf16(a, b, acc, 0, 0, 0); }
        const int j = 16 * nj + c16; const float gj = gcs[j];
#pragma unroll
        for (int r = 0; r < 4; ++r) { const int i = 16 * mi + 4 * q4 + r; const float dec = f_exp(gcs[i] - gj);
            if (which == 0) Ls[i * (C + 4) + j] = (i > j) ? acc[r] * dec : 0.f;
            else As[i * LDT + j] = (bf16)((i >= j) ? f2bf(acc[r] * dec) : 0u); }
    }
    __syncthreads();
    if (wid == 0) {
        if (lane < C) {
            float x[C];
#pragma unroll
            for (int i = 0; i < C; ++i) { float s = (i == lane) ? 1.f : 0.f;
#pragma unroll
                for (int j = 0; j < i; ++j) s -= Ls[i * (C + 4) + j] * x[j];
                x[i] = s; Ts[i * LDT + lane] = (bf16)f2bf(s); }
        }
    } else {
        const float gl = gcs[C - 1];
        for (int i = tid - 64; i < C * 128; i += NTHREADS - 64) { const int t = i >> 7, c = i & 127;
            Qs[t * LDQ + c] = (bf16)f2bf(bf2f(Qs[t * LDQ + c]) * egs[t]); Ks[t * LDQ + c] = (bf16)f2bf(bf2f(Ks[t * LDQ + c]) * f_exp(gl - gcs[t])); }
    }
    __syncthreads();
    for (int tix = wid; tix < 2 * MT * 8; tix += NWAVES) {
        const int which = tix / (MT * 8), m = (tix % (MT * 8)) / 8, nv = tix % 8; const LAS bf16* Bt = which == 0 ? VbT : KgT; f32x4 acc = {0.f, 0.f, 0.f, 0.f};
#pragma unroll
        for (int s = 0; s < SC; ++s) { const bf16x8 a = *(const LAS bf16x8*)(Ts + (16 * m + c16) * LDT + 32 * s + 8 * q4), b = *(const LAS bf16x8*)(Bt + (16 * nv + c16) * LDT + 32 * s + 8 * q4);
            acc = __builtin_amdgcn_mfma_f32_16x16x32_bf16(a, b, acc, 0, 0, 0); }
        if (which == 0) *(f32x4*)(frag + FR_U + ((size_t)(nv * MT + m) * 64 + lane) * 16) = acc;
        else { for (int r = 0; r < 4; ++r) Kbs[(16 * m + 4 * q4 + r) * LDQ + 16 * nv + c16] = (bf16)f2bf(-acc[r]); }
    }
    __syncthreads();
    constexpr int NFW = MT * 4, NFA = MT * SC, NFK = 8 * SC, NF = 2 * NFW + NFA + NFK;
    for (int it = tid; it < NF * 64; it += NTHREADS) {
        const int f = it >> 6, l = it & 63, i16 = l & 15, q = l >> 4; u32x4 o;
        if (f < 2 * NFW) { const int which = f / NFW, ff = f % NFW, m = ff / 4, s = ff % 4; const LAS bf16* src = (which == 0 ? Kbs : Qs) + (16 * m + i16) * LDQ + 32 * s + 4 * q;
            const u32x2 lo = *(const LAS u32x2*)src, hi = *(const LAS u32x2*)(src + 16); o = (u32x4){lo.x, lo.y, hi.x, hi.y};
            *(u32x4*)(frag + (which == 0 ? FR_W : FR_Q) + ((size_t)ff * 64 + l) * 16) = o; }
        else if (f < 2 * NFW + NFA) { const int ff = f - 2 * NFW, m = ff / SC, s = ff % SC; const LAS bf16* src = As + (16 * m + i16) * LDT + 32 * s + 4 * q;
            const u32x2 lo = *(const LAS u32x2*)src, hi = *(const LAS u32x2*)(src + 16); o = (u32x4){lo.x, lo.y, hi.x, hi.y};
            *(u32x4*)(frag + FR_A + ((size_t)ff * 64 + l) * 16) = o; }
        else { const int ff = f - 2 * NFW - NFA, T = ff / SC, s = ff % SC; unsigned e[8];
#pragma unroll
            for (int j = 0; j < 8; ++j) { const int c = 32 * s + 16 * (j >> 2) + 4 * q + (j & 3); e[j] = (c < C) ? (unsigned)Ks[c * LDQ + 16 * T + i16] : 0u; }
            o = (u32x4){e[0] | (e[1] << 16), e[2] | (e[3] << 16), e[4] | (e[5] << 16), e[6] | (e[7] << 16)};
            *(u32x4*)(frag + FR_K + ((size_t)ff * 64 + l) * 16) = o; }
    }
    if (tid == 0) *(float*)(frag + FR_SC) = egs[C - 1];
    __syncthreads();
}

template <int C, int NVALID>
DEVI void delta_apply(const unsigned char* frag, size_t fstride, int nchunks, const float* S0, float* Sout, bf16* oraw_base  , int vs, int lane) {
    using P = PrepCfg<C>; constexpr int MT = P::MT, SC = P::SC;
    const int q = lane >> 4, c16 = lane & 15;
    f32x4 S[8];
#pragma unroll
    for (int T = 0; T < 8; ++T) { S[T] = (f32x4){0.f, 0.f, 0.f, 0.f}; if (S0) { const float* sp = S0 + (size_t)(16 * T + 4 * q) * HD + 16 * vs + c16; S[T] = (f32x4){sp[0], sp[HD], sp[2 * HD], sp[3 * HD]}; } }
    for (int n = 0; n < nchunks; ++n, frag += fstride) {
        const float egl = *(const float*)(frag + FR_SC);
        bf16x8 Sb[4];
#pragma unroll
        for (int s = 0; s < 4; ++s) { u32x4 p; p.x = pk2(S[2 * s][0], S[2 * s][1]); p.y = pk2(S[2 * s][2], S[2 * s][3]); p.z = pk2(S[2 * s + 1][0], S[2 * s + 1][1]); p.w = pk2(S[2 * s + 1][2], S[2 * s + 1][3]); Sb[s] = __builtin_bit_cast(bf16x8, p); }
        f32x4 vn[MT], o[MT];
#pragma unroll
        for (int m = 0; m < MT; ++m) { vn[m] = *(const f32x4*)(frag + FR_U + ((size_t)(vs * MT + m) * 64 + lane) * 16); o[m] = (f32x4){0.f, 0.f, 0.f, 0.f};
#pragma unroll
            for (int s = 0; s < 4; ++s) { const bf16x8 w = *(const bf16x8*)(frag + FR_W + ((size_t)(m * 4 + s) * 64 + lane) * 16), qf = *(const bf16x8*)(frag + FR_Q + ((size_t)(m * 4 + s) * 64 + lane) * 16);
                vn[m] = __builtin_amdgcn_mfma_f32_16x16x32_bf16(w, Sb[s], vn[m], 0, 0, 0); o[m] = __builtin_amdgcn_mfma_f32_16x16x32_bf16(qf, Sb[s], o[m], 0, 0, 0); } }
        bf16x8 vb[SC];
#pragma unroll
        for (int s = 0; s < SC; ++s) { u32x4 p; p.x = pk2(vn[2 * s < MT ? 2 * s : 0][0], vn[2 * s < MT ? 2 * s : 0][1]); p.y = pk2(vn[2 * s < MT ? 2 * s : 0][2], vn[2 * s < MT ? 2 * s : 0][3]);
            if (2 * s + 1 < MT) { p.z = pk2(vn[2 * s + 1 < MT ? 2 * s + 1 : 0][0], vn[2 * s + 1 < MT ? 2 * s + 1 : 0][1]); p.w = pk2(vn[2 * s + 1 < MT ? 2 * s + 1 : 0][2], vn[2 * s + 1 < MT ? 2 * s + 1 : 0][3]); } else { p.z = 0u; p.w = 0u; }
            vb[s] = __builtin_bit_cast(bf16x8, p); }
#pragma unroll
        for (int m = 0; m < MT; ++m)
#pragma unroll
            for (int s = 0; s < SC; ++s) { const bf16x8 a = *(const bf16x8*)(frag + FR_A + ((size_t)(m * SC + s) * 64 + lane) * 16); o[m] = __builtin_amdgcn_mfma_f32_16x16x32_bf16(a, vb[s], o[m], 0, 0, 0); }
#pragma unroll
        for (int T = 0; T < 8; ++T) { S[T] *= egl;
#pragma unroll
            for (int s = 0; s < SC; ++s) { const bf16x8 kf = *(const bf16x8*)(frag + FR_K + ((size_t)(T * SC + s) * 64 + lane) * 16); S[T] = __builtin_amdgcn_mfma_f32_16x16x32_bf16(kf, vb[s], S[T], 0, 0, 0); } }
#pragma unroll
        for (int m = 0; m < MT; ++m)
#pragma unroll
            for (int r = 0; r < 4; ++r) { const int c = 16 * m + 4 * q + r; if (c < NVALID) oraw_base[(size_t)(n * C + c) * D + 16 * vs + c16] = (bf16)f2bf(o[m][r]); }
    }
#pragma unroll
    for (int T = 0; T < 8; ++T) { float* sp = Sout + (size_t)(16 * T + 4 * q) * HD + 16 * vs + c16; sp[0] = S[T][0]; sp[HD] = S[T][1]; sp[2 * HD] = S[T][2]; sp[3 * HD] = S[T][3]; }
}

DEVI void p4_prep(Frame& F) {
    constexpr int NC = SEQ / CHUNK;
    for (int u = F.vcu; u < NCHUNK_P; u += F.G) {
        const int n = u % NC, bh = u / NC, h = bh % NH, b = bh / NH;
        delta_prep<CHUNK, CHUNK>(F, F.lds, b * SEQ, n * CHUNK, h, nullptr, F.ws + WS_FRAG + (size_t)u * CHUNK_BYTES);
    }
}

template <bool SAMPLE>
DEVI void s5_job(Frame& F, LAS unsigned char* L  , int row0, int nrows, int g, int b0) {
    const int lane = F.lane, hi = lane >> 5, l31 = lane & 31, q = lane >> 4, c16 = lane & 15;
    LAS float* BUT = (LAS float*)L;
    LAS unsigned* Hs = (LAS unsigned*)(L + 10240);
    const bf16* ub = (const bf16*)(F.ws + WS_UB); bf16* y5 = (bf16*)(F.ws + WS_Y5);
    float are, aim;
    {
        const float lre = fminf(F.in[I_LAMRE][g * NP + lane], -1e-4f), lim = F.in[I_LAMIM][g * NP + lane], dt = f_exp(F.in[I_LOGSTEP][g]);
        const float mag = f_exp(lre * dt), ang = lim * dt; are = mag * f_cos(ang); aim = mag * f_sin(ang);
    }
    bf16x8 bbf[4];
#pragma unroll
    for (int nt = 0; nt < 4; ++nt) { const int pp = 32 * nt + l31, p = pp & 63;
        const float lre = fminf(F.in[I_LAMRE][g * NP + p], -1e-4f), lim = F.in[I_LAMIM][g * NP + p], dt = f_exp(F.in[I_LOGSTEP][g]);
        const float mag = f_exp(lre * dt), ang = lim * dt, nr = mag * f_cos(ang) - 1.f, ni = mag * f_sin(ang), den = lre * lre + lim * lim;
        const float cre = (nr * lre + ni * lim) / den, cim = (ni * lre - nr * lim) / den;
        const float* br = F.in[I_BRE] + ((size_t)g * NP + p) * 16 + 8 * hi; const float* bi = F.in[I_BIM] + ((size_t)g * NP + p) * 16 + 8 * hi; float e[8];
#pragma unroll
        for (int j = 0; j < 8; ++j) e[j] = pp < 64 ? cre * br[j] - cim * bi[j] : cre * bi[j] + cim * br[j];
        u32x4 pk; pk.x = pk2(e[0], e[1]); pk.y = pk2(e[2], e[3]); pk.z = pk2(e[4], e[5]); pk.w = pk2(e[6], e[7]); bbf[nt] = __builtin_bit_cast(bf16x8, pk); }
    bf16x8 ccf[4];
#pragma unroll
    for (int s = 0; s < 4; ++s) { float e[8];
#pragma unroll
        for (int j = 0; j < 8; ++j) { const int p = 16 * s + 4 * q + (j >> 1); e[j] = (j & 1) ? -F.in[I_CIM][((size_t)g * 16 + c16) * NP + p] : F.in[I_CRE][((size_t)g * 16 + c16) * NP + p]; }
        u32x4 pk; pk.x = pk2(e[0], e[1]); pk.y = pk2(e[2], e[3]); pk.z = pk2(e[4], e[5]); pk.w = pk2(e[6], e[7]); ccf[s] = __builtin_bit_cast(bf16x8, pk); }
    const float dsk = F.in[I_DSKIP][g * 16 + c16];
    float hre = 0.f, him = 0.f;
    for (int r0 = 0; r0 < nrows; r0 += 32) {
        const bf16x8 uf = *(const bf16x8*)(ub + (size_t)(row0 + r0 + l31) * MIX_B + g * 16 + 8 * hi);
        f32x16 bu[4];
#pragma unroll
        for (int nt = 0; nt < 4; ++nt) { const f32x16 z = {0.f, 0.f, 0.f, 0.f, 0.f, 0.f, 0.f, 0.f, 0.f, 0.f, 0.f, 0.f, 0.f, 0.f, 0.f, 0.f}; bu[nt] = __builtin_amdgcn_mfma_f32_32x32x16_bf16(uf, bbf[nt], z, 0, 0, 0); }
#pragma unroll
        for (int hf = 0; hf < 2; ++hf) {
            WAVE_LDS_SYNC();
#pragma unroll
            for (int nt = 0; nt < 4; ++nt)
#pragma unroll
                for (int i2 = 0; i2 < 2; ++i2) { const int i = 2 * hf + i2; *(LAS f32x4*)(BUT + (32 * nt + l31) * 20 + 8 * i2 + 4 * hi) = (f32x4){bu[nt][4 * i], bu[nt][4 * i + 1], bu[nt][4 * i + 2], bu[nt][4 * i + 3]}; }
            WAVE_LDS_SYNC();
            float br_[16], bi_[16];
#pragma unroll
            for (int j = 0; j < 4; ++j) { const f32x4 a = *(const LAS f32x4*)(BUT + lane * 20 + 4 * j), b = *(const LAS f32x4*)(BUT + (64 + lane) * 20 + 4 * j);
                br_[4 * j] = a[0]; br_[4 * j + 1] = a[1]; br_[4 * j + 2] = a[2]; br_[4 * j + 3] = a[3]; bi_[4 * j] = b[0]; bi_[4 * j + 1] = b[1]; bi_[4 * j + 2] = b[2]; bi_[4 * j + 3] = b[3]; }
#pragma unroll
            for (int tt = 0; tt < 16; ++tt) {
                if (SAMPLE && (tt & 7) == 0) { const int b = b0 + (r0 + 16 * hf + tt) / 8; hre = F.in[I_SSRE][((size_t)b * NG + g) * NP + lane]; him = F.in[I_SSIM][((size_t)b * NG + g) * NP + lane]; }
                const float nre = are * hre - aim * him + br_[tt], nim = are * him + aim * hre + bi_[tt]; hre = nre; him = nim;
                Hs[tt * 68 + lane] = pk2(hre, him);
                if (SAMPLE && (tt & 7) == 7) { const int b = b0 + (r0 + 16 * hf + tt) / 8; F.out[O_SRES + ((size_t)b * NG + g) * NP + lane] = hre; F.out[O_SIMS + ((size_t)b * NG + g) * NP + lane] = him; }
            }
            WAVE_LDS_SYNC();
            f32x4 y = {0.f, 0.f, 0.f, 0.f};
#pragma unroll
            for (int s = 0; s < 4; ++s) { const bf16x8 a = *(const LAS bf16x8*)(Hs + c16 * 68 + 16 * s + 4 * q); y = __builtin_amdgcn_mfma_f32_16x16x32_bf16(a, ccf[s], y, 0, 0, 0); }
#pragma unroll
            for (int r = 0; r < 4; ++r) { const size_t row = (size_t)(row0 + r0 + 16 * hf + 4 * q + r); const float u = bf2f(ub[row * MIX_B + g * 16 + c16]);
                y5[row * MIX_B + g * 16 + c16] = (bf16)f2bf(geluf_(y[r] + dsk * u)); }
        }
    }
    if (!SAMPLE) { F.out[O_SREP + ((size_t)b0 * NG + g) * NP + lane] = hre; F.out[O_SIMP + ((size_t)b0 * NG + g) * NP + lane] = him; }
}

DEVI void p5_mix(Frame& F) {
    using OL = PrepLds<16>;
    constexpr int FRAG_OFF = (OL::END + 255) & ~255;
    static_assert(FRAG_OFF + CHUNK_BYTES <= RING_BYTES, "lds");
    for (int u = F.vcu; u < DEC_BATCH * NH; u += F.G) {
        const int b = u / NH, h = u % NH;
        unsigned char* fr = (unsigned char*)(F.lds + FRAG_OFF);
        delta_prep<16, 8>(F, F.lds, MP + b * DEC_SEQ, 0, h, F.in[I_SCONV] + (size_t)b * 3 * QKV, fr);
        delta_apply<16, 8>(fr, 0, 1, F.in[I_SDELTA] + ((size_t)b * NH + h) * HD * HD, F.out + O_DELS + ((size_t)b * NH + h) * HD * HD,
                           (bf16*)(F.ws + WS_H12) + (size_t)(MP + b * DEC_SEQ) * D + h * HD, F.wave, F.lane);
        __syncthreads();
    }
    constexpr int NJ_D = BATCH * NH * 8, NJ_SP = BATCH * NG, NJ_SS = (DEC_BATCH / 4) * NG, NJ = NJ_D + NJ_SP + NJ_SS;
    const int gw = F.wave * F.G + F.vcu, NGW = F.G * NWAVES;
    LAS unsigned char* wl = F.lds + F.wave * 16384;
    for (int j = gw; j < NJ; j += NGW) {
        if (j < NJ_D) { const int vs = j % 8, bh = j / 8, h = bh % NH, b = bh / NH;
            delta_apply<CHUNK, CHUNK>(F.ws + WS_FRAG + (size_t)bh * (SEQ / CHUNK) * CHUNK_BYTES, CHUNK_BYTES, SEQ / CHUNK, nullptr, F.out + O_DELP + (size_t)bh * HD * HD,
                                      (bf16*)(F.ws + WS_H12) + (size_t)(b * SEQ) * D + h * HD, vs, F.lane); }
        else if (j < NJ_D + NJ_SP) { const int jj = j - NJ_D, b = jj / NG, g = jj % NG; s5_job<false>(F, wl, b * SEQ, SEQ, g, b); }
        else { const int jj = j - NJ_D - NJ_SP, bq = jj / NG, g = jj % NG; s5_job<true>(F, wl, MP + bq * 32, 32, g, bq * 4); }
    }
}

#ifndef HOST_EMU
#define XB_TMO      128
#define XB_XCNT(j)  (256  + 64 * (j))
#define XB_XSUB(j)  (1280 + 64 * (j))
#define XB_XGEN(j)  (2304 + 64 * (j))
#define XB_TOP      3328
#define XB_TOPGEN   3392
#define XCD_BAR_WORDS 3456
#define XB_SPIN_CAP (1u << 18)
__device__ __forceinline__ unsigned xb_ld(unsigned* p)              { return __hip_atomic_load(p, __ATOMIC_RELAXED, __HIP_MEMORY_SCOPE_AGENT); }
__device__ __forceinline__ unsigned xb_add(unsigned* p, unsigned v) { return __hip_atomic_fetch_add(p, v, __ATOMIC_RELAXED, __HIP_MEMORY_SCOPE_AGENT); }
__device__ __forceinline__ unsigned xb_xcc_id() { return (unsigned)__builtin_amdgcn_s_getreg((3 << 11) | 20) & 0xFu; }
#define XB_SPIN(cond, bar) do { unsigned _sp = 0; while (cond) { __builtin_amdgcn_s_sleep(1); \
    if ((++_sp & 255u) == 0u) { if (xb_ld(&(bar)[XB_TMO])) break; if (_sp > XB_SPIN_CAP) { atomicAdd(&(bar)[XB_TMO], 1u); break; } } } } while (0)
struct XcdBarrier { unsigned* bar; unsigned x; volatile LAS unsigned* st; };
__device__ __forceinline__ XcdBarrier xcd_barrier_post(unsigned* bar, volatile LAS unsigned* st) {
    XcdBarrier b; b.bar = bar; b.x = xb_xcc_id(); b.st = st;
    if (threadIdx.x == 0) (void)xb_add(&bar[XB_XCNT(b.x)], 1u);
    return b;
}
__device__ __forceinline__ void xcd_barrier_complete(unsigned* bar, unsigned x, unsigned& nloc, unsigned& nx) {
    const unsigned G = gridDim.x * gridDim.y * gridDim.z;
    unsigned sum, cnt, mine, sp = 0u;
    for (;;) {
        sum = 0u; cnt = 0u; mine = 0u;
#pragma unroll
        for (unsigned j = 0; j < 16; ++j) { const unsigned c = xb_ld(&bar[XB_XCNT(j)]); sum += c; cnt += (c > 0u) ? 1u : 0u; mine = (j == x) ? c : mine; }
        if (sum == G) break;
        __builtin_amdgcn_s_sleep(1);
        if ((++sp & 255u) == 0u) { if (xb_ld(&bar[XB_TMO])) break; if (sp > XB_SPIN_CAP) { atomicAdd(&bar[XB_TMO], 1u); break; } }
    }
    nloc = mine > 0u ? mine : 1u; nx = cnt > 0u ? cnt : 1u;
}
__device__ __forceinline__ void xcd_barrier(const XcdBarrier& b) {
    asm volatile("s_waitcnt vmcnt(0)" ::: "memory");
    __syncthreads();
    if (threadIdx.x == 0) {
        unsigned* bar = b.bar;
        __builtin_amdgcn_s_waitcnt(0);
        unsigned nloc = b.st[0], nx = b.st[1];
        if (nloc == 0u) { xcd_barrier_complete(bar, b.x, nloc, nx); b.st[0] = nloc; b.st[1] = nx; }
        const unsigned old = xb_add(&bar[XB_XSUB(b.x)], 1u);
        const unsigned gen = old / nloc;
        if (old + 1u == (gen + 1u) * nloc) {
            __builtin_amdgcn_fence(__ATOMIC_RELEASE, "agent");
            asm volatile("s_waitcnt vmcnt(0)" ::: "memory");
            const unsigned og = xb_add(&bar[XB_TOP], 1u);
            const unsigned tg = og / nx;
            if (og + 1u == (tg + 1u) * nx) xb_add(&bar[XB_TOPGEN], 1u);
            else XB_SPIN(xb_ld(&bar[XB_TOPGEN]) == tg, bar);
            __builtin_amdgcn_fence(__ATOMIC_ACQUIRE, "agent");
            xb_add(&bar[XB_XGEN(b.x)], 1u);
            asm volatile("s_waitcnt vmcnt(0)" ::: "memory");
        } else {
            XB_SPIN(xb_ld(&bar[XB_XGEN(b.x)]) == gen, bar);
            __builtin_amdgcn_fence(__ATOMIC_ACQUIRE, "agent");
            asm volatile("s_waitcnt vmcnt(0)" ::: "memory");
        }
    }
    __syncthreads();
}
#endif

constexpr int NPHASE = 12;
#ifndef MK_COOP
#define MK_COOP 1
#endif
#ifndef MK_XCDBAR
#define MK_XCDBAR 1
#endif
constexpr int CTL_BAR_WORD = 1024;
constexpr int LDS_ST_OFF = RING_BYTES;
__global__ void __launch_bounds__(NTHREADS, 2) fwd_kernel(Args args) {
#ifdef HOST_EMU
    unsigned char* lds = emu_lds();
#else
    extern __shared__ __attribute__((aligned(16))) unsigned char lds[];
#endif
    Frame F; F.lds = (LAS unsigned char*)lds; F.in = args.in; F.out = args.out; F.ws = args.ws;
    F.tid = threadIdx.x; F.lane = F.tid & 63; F.wave = __builtin_amdgcn_readfirstlane(F.tid >> 6);
    F.G = gridDim.x; { const int bx = blockIdx.x; F.vcu = (F.G % 8 == 0) ? (bx % 8) * (F.G / 8) + bx / 8 : bx; }
    const int lo = args.ph_lo, hi = args.ph_hi;
#ifdef HOST_EMU
#define GRID_SYNC() emu_grid_sync()
#elif MK_COOP && MK_XCDBAR
    cg::grid_group grid = cg::this_grid();
    if (F.tid < 2) ((LAS unsigned*)(F.lds + LDS_ST_OFF))[F.tid] = 0u;
    __syncthreads();
    const XcdBarrier xbar = xcd_barrier_post((unsigned*)(F.ws + WS_CTL) + CTL_BAR_WORD, (volatile LAS unsigned*)(F.lds + LDS_ST_OFF));
    if (args.ph_lo < 0) grid.sync();
#define GRID_SYNC() xcd_barrier(xbar)
#elif MK_COOP
    cg::grid_group grid = cg::this_grid();
#define GRID_SYNC() grid.sync()
#else
#define GRID_SYNC() do {} while (0)
#endif
#ifndef PHASE_MASK
#define PHASE_MASK 0xFFFF
#endif
#define IN(k) ((((PHASE_MASK) >> (k)) & 1) && lo <= (k) && (k) < hi)
#ifndef REPEAT_MASK
#define REPEAT_MASK 0x0
#endif
#define REP(k) ((((REPEAT_MASK) >> (k)) & 1) ? 2 : 1)
#define SEAM(k) do { if (IN(k) && IN((k) + 1)) GRID_SYNC(); } while (0)
    using namespace pg8;
    if (IN(0)) { for (int rep = 0; rep < REP(0); ++rep) { p0_prologue(F); if (rep + 1 < REP(0)) GRID_SYNC(); } } SEAM(0);
    if (IN(1)) { for (int rep = 0; rep < REP(1); ++rep) { p1_ada(F); if (rep + 1 < REP(1)) GRID_SYNC(); } } SEAM(1);
    if (IN(2)) { for (int rep = 0; rep < REP(2); ++rep) { p2_h1(F); if (rep + 1 < REP(2)) GRID_SYNC(); } } SEAM(2);
    if (IN(3)) {
        Gemm g{(const bf16*)(F.ws + WS_H12), (const bf16*)(F.ws + WS_WIN), M, NIN, D}; StaticOrder S; S.init(M, NIN, F.G, (int)blockIdx.x);
        EpiInProj E{0, (bf16*)(F.ws + WS_QKVB), (bf16*)(F.ws + WS_ZB), (bf16*)(F.ws + WS_UB), (float*)(F.ws + WS_AB), F.out + O_CONVP, F.out + O_CONVS};
        gemm_phase<EpiInProj, true, true>(F.lds, g, S, E);
    } SEAM(3);
    if (IN(4)) { for (int rep = 0; rep < REP(4); ++rep) { p4_prep(F); if (rep + 1 < REP(4)) GRID_SYNC(); } } SEAM(4);
    if (IN(5)) { for (int rep = 0; rep < REP(5); ++rep) { p5_mix(F); if (rep + 1 < REP(5)) GRID_SYNC(); } } SEAM(5);
    if (IN(6)) {
        p6_onorm(F);
        Gemm g{(const bf16*)(F.ws + WS_Y5), (const bf16*)(F.ws + WS_WGLU), M, 2 * MIX_B, MIX_B}; StaticOrder S; S.init(M, 2 * MIX_B, F.G, (int)blockIdx.x);
        EpiGlu E{0, (bf16*)(F.ws + WS_ACAT), (unsigned long long*)(F.ws + WS_CTL + CTL_RS5)};
        gemm_phase<EpiGlu, true, true>(F.lds, g, S, E);
    } SEAM(6);
    if (IN(7)) {
        Gemm g{(const bf16*)(F.ws + WS_ACAT), (const bf16*)(F.ws + WS_WOUT), M, D, D}; StaticOrder S; S.init(M, D, F.G, (int)blockIdx.x);
        EpiF32Rs<true> E{MIX_B / 64, (float*)(F.ws + WS_MIX), (const unsigned long long*)(F.ws + WS_CTL + CTL_RS5)};
        gemm_phase<EpiF32Rs<true>, true, true>(F.lds, g, S, E);
    } SEAM(7);
    if (IN(8)) { p8_x1h2(F); } SEAM(8);
    if (IN(9)) {
        Gemm g{(const bf16*)(F.ws + WS_H12), (const bf16*)(F.ws + WS_WGU), M, 2 * D_FF, D}; StaticOrder S; S.init(M, 2 * D_FF, F.G, (int)blockIdx.x);
        EpiSwiglu E{0, (bf16*)(F.ws + WS_HMID)};
        gemm_phase<EpiSwiglu, true, true>(F.lds, g, S, E);
    } SEAM(9);
    if (IN(10)) {
        Gemm g{(const bf16*)(F.ws + WS_HMID), (const bf16*)(F.ws + WS_WDN), M, D, D_FF}; StaticOrder S; S.init(M, D, F.G, (int)blockIdx.x);
        EpiF32Rs<false> E{0, (float*)(F.ws + WS_F), nullptr};
        gemm_phase<EpiF32Rs<false>, true, true>(F.lds, g, S, E);
    } SEAM(10);
    if (IN(11)) { for (int rep = 0; rep < REP(11); ++rep) { p11_out(F); if (rep + 1 < REP(11)) GRID_SYNC(); } }
#undef IN
#undef SEAM
}

#ifndef HOST_EMU
extern "C" void kernel_launch(void* const* d_in, const int* in_sizes, int n_in, void* d_out, int out_size, void* d_ws, size_t ws_size, hipStream_t stream) {
    static int grid = 0;
    if (grid == 0) {
        if (n_in != N_IN || (size_t)out_size != O_END || ws_size < WS_END) { fprintf(stderr, "kernel_launch: unexpected sizes n_in %d out %d ws %zu (need %zu)\n", n_in, out_size, ws_size, (size_t)WS_END); grid = -1; return; }
        int dev = 0, cus = 0, per_cu = 0;
        hipGetDevice(&dev); hipDeviceGetAttribute(&cus, hipDeviceAttributeMultiprocessorCount, dev);
        hipFuncSetAttribute((const void*)fwd_kernel, hipFuncAttributeMaxDynamicSharedMemorySize, LDS_BYTES);
        hipOccupancyMaxActiveBlocksPerMultiprocessor(&per_cu, (const void*)fwd_kernel, NTHREADS, LDS_BYTES);
        if (per_cu < 1) { fprintf(stderr, "kernel_launch: occupancy query says %d blocks per CU\n", per_cu); per_cu = 1; }
        grid = cus * 1;
        (void)hipGetLastError();
    }
    if (grid < 0) return;
    hipMemsetAsync((char*)d_ws + WS_CTL, 0, CTL_BYTES, stream);
    Args a{};
    for (int i = 0; i < N_IN; ++i) a.in[i] = (const float*)d_in[i];
    a.out = (float*)d_out; a.ws = (unsigned char*)d_ws;
#if MK_COOP
    a.ph_lo = 0; a.ph_hi = NPHASE;
    void* params[] = {&a};
    hipError_t e = hipLaunchCooperativeKernel((const void*)fwd_kernel, dim3(grid), dim3(NTHREADS), params, LDS_BYTES, stream);
    if (e != hipSuccess) fprintf(stderr, "cooperative launch failed: %s\n", hipGetErrorString(e));
#else
    for (int p = 0; p < NPHASE; ++p) { a.ph_lo = p; a.ph_hi = p + 1; hipLaunchKernelGGL(fwd_kernel, dim3(grid), dim3(NTHREADS), LDS_BYTES, stream, a); }
#endif
}
#endif
```

```cpp
#ifndef HOST_EMU
#include <hip/hip_runtime.h>
#include <hip/hip_cooperative_groups.h>
#endif
#include <cstdio>
#include <cstdint>
#include <cmath>

#ifdef HOST_EMU
#ifndef EMU_BATCH
#define EMU_BATCH 2
#define EMU_SEQ 128
#endif
constexpr int D_MODEL = 512, BATCH = EMU_BATCH, SEQ = EMU_SEQ, DEC_BATCH = 32, DEC_SEQ = 8;
#else
constexpr int D_MODEL = 2048, BATCH = 4, SEQ = 2048, DEC_BATCH = 128, DEC_SEQ = 8;
#endif
constexpr int D = D_MODEL, MIX_A = D / 2, MIX_B = D - MIX_A, HD = 128, NH = MIX_A / HD, CHUNK = 64, NG = MIX_B / 16, NP = 64;
constexpr int QKV = 3 * MIX_A, PROJ = QKV + MIX_A + 2 * NH + MIX_B;
constexpr int D_FF = ((8 * D + 767) / 768) * 256;
constexpr int MP = BATCH * SEQ, MS = DEC_BATCH * DEC_SEQ, M = MP + MS, NB = BATCH + DEC_BATCH;
constexpr int NIN = QKV + MIX_A + MIX_B + 256;
constexpr int NT_QKV = QKV / 256, NT_Z = MIX_A / 256, NT_U = MIX_B / 256;
constexpr float EPS = 1e-6f;
static_assert(MP % 256 == 0 && MS % 256 == 0 && D % 256 == 0 && QKV % 256 == 0 && MIX_A % 256 == 0 && D_FF % 128 == 0 && 2 * NH <= 16, "shape");
static_assert(MIX_A == MIX_B && SEQ % CHUNK == 0 && DEC_SEQ == 8 && DEC_BATCH % 4 == 0, "shape");

#ifdef HOST_EMU
#define LAS
#define GAS
#define DEVI inline
#define WAIT_VM(n)
#define WAIT_LGKM(n)
#define CFENCE()
#define WAVE_LDS_SYNC() emu_wave_sync()
DEVI float f_exp(float x) { return expf(x); }
DEVI float f_rsqrt(float x) { return 1.0f / sqrtf(x); }
DEVI float f_sin(float x) { return sinf(x); }
DEVI float f_cos(float x) { return cosf(x); }
DEVI float f_rcp(float x) { return 1.0f / x; }
#else
#define LAS __attribute__((address_space(3)))
#define GAS __attribute__((address_space(1)))
#define DEVI __device__ __forceinline__
#define WAIT_VM(n) asm volatile("s_waitcnt vmcnt(" #n ")" ::: "memory")
#define WAIT_LGKM(n) asm volatile("s_waitcnt lgkmcnt(" #n ")" ::: "memory")
#define CFENCE() asm volatile("" ::: "memory")
#define WAVE_LDS_SYNC() asm volatile("s_waitcnt lgkmcnt(0)" ::: "memory")
DEVI float f_exp(float x) { return __expf(x); }
DEVI float f_rsqrt(float x) { return rsqrtf(x); }
DEVI float f_sin(float x) { return sinf(x); }
DEVI float f_cos(float x) { return cosf(x); }
DEVI float f_rcp(float x) { return __builtin_amdgcn_rcpf(x); }
namespace cg = cooperative_groups;
#endif

typedef unsigned short bf16;
typedef short bf16x8 __attribute__((ext_vector_type(8)));
typedef float f32x4 __attribute__((ext_vector_type(4)));
typedef float f32x16 __attribute__((ext_vector_type(16)));
typedef unsigned u32x4 __attribute__((ext_vector_type(4)));
typedef unsigned u32x2 __attribute__((ext_vector_type(2)));

DEVI unsigned f2bf(float f) { unsigned u = __builtin_bit_cast(unsigned, f); return (u + 0x7fffu + ((u >> 16) & 1u)) >> 16; }
DEVI float bf2f(unsigned h) { return __builtin_bit_cast(float, (h & 0xffffu) << 16); }
#ifndef HOST_EMU
typedef float f32x2_ __attribute__((ext_vector_type(2)));
typedef __bf16 bf16x2_ __attribute__((ext_vector_type(2)));
#endif
DEVI unsigned pk2(float lo, float hi) {
#ifdef HOST_EMU
    return f2bf(lo) | (f2bf(hi) << 16);
#else
    const f32x2_ v = {lo, hi}; return __builtin_bit_cast(unsigned, __builtin_convertvector(v, bf16x2_));
#endif
}
DEVI float sigmoidf_(float x) { return f_rcp(1.0f + f_exp(-x)); }
DEVI float siluf_(float x) { return x * sigmoidf_(x); }
DEVI float geluf_(float x) { const float u = 0.7978845608028654f * (x + 0.044715f * x * x * x); const float e = f_exp(2.0f * u); return 0.5f * x * (2.0f - 2.0f * f_rcp(e + 1.0f)); }
DEVI float wave_sum(float v) {
#pragma unroll
    for (int o = 1; o < 64; o <<= 1) v += __shfl_xor(v, o);
    return v;
}

namespace pg8 {
constexpr int BM = 256, BK = 64, HALF = 128, HTB = HALF * BK * 2, STAGE_BYTES = 8 * HTB, NXCD = 8, WGM = 8;
DEVI int lds_byte(int r, int c) { const int st = (r >> 4) * 2 + (c >> 5), rr = r & 15, cc = c & 31, ob = rr * 64 + cc * 2; return st * 1024 + (ob ^ (((ob >> 9) & 1) << 5)); }
DEVI void stage_rc(int b, int& R, int& C) { const int st = b / 1024, sb = b % 1024, swz = sb ^ (((sb >> 9) & 1) << 5); R = (st >> 1) * 16 + swz / 64; C = (st & 1) * 32 + (swz % 64) / 2; }
DEVI int perm32(int rho) { const int n = rho >> 4, i = rho & 15; return 8 * (i >> 2) + 4 * n + (i & 3); }
struct Unit { int pm, pn; };
struct Gemm { const bf16* A; const bf16* Bt; int M, N, K; };
struct StaticOrder {
    int nM, nN, nwg, G, c;
    DEVI void init(int M_, int N_, int G_, int c_) { nM = M_ / BM; nN = N_ / BM; nwg = nM * nN; G = G_; c = c_; }
    DEVI bool next(int i, Unit& u) const {
        const long L = (long)i * G + c; if (L >= nwg) return false;
        int wgid = (int)L; { const int q = nwg / NXCD, r = nwg % NXCD, xcd = wgid % NXCD, off = wgid / NXCD; wgid = (xcd < r ? xcd * (q + 1) : r * (q + 1) + (xcd - r) * q) + off; }
        const int nig = WGM * nN, gid = wgid / nig, fm = gid * WGM, gsz = (nM - fm) < WGM ? (nM - fm) : WGM;
        u.pm = fm + ((wgid % nig) % gsz); u.pn = (wgid % nig) / gsz; return true;
    }
};
template <class Epi, bool ALIGN_EPI, bool SP2>
DEVI void gemm_phase(LAS unsigned char* lds, const Gemm g, const StaticOrder& S, const Epi& E) {
    const int tid = threadIdx.x, wid = __builtin_amdgcn_readfirstlane(tid >> 6), lane = tid & 63, wr = wid >> 2, wc = wid & 3, fr = lane & 15, fq = lane >> 4;
    const int K = g.K, nt = K / BK;
    unsigned voffA[2], voffB[2];
#pragma unroll
    for (int i = 0; i < 2; ++i) { int R, C; stage_rc(tid * 16 + i * 8192, R, C); const int Rb = Epi::PERM ? ((R & ~31) + perm32(R & 31)) : R;
        voffA[i] = (unsigned)(R * K + C) * 2u; voffB[i] = (unsigned)(Rb * K + C) * 2u; }
    const size_t kstep = (size_t)(BK * 2);
    const size_t hstep = (size_t)HALF * K * 2;
    const size_t tstep = 2 * hstep;
    const unsigned ldsw = (unsigned)wid * 1024u;
    const int aoff = lds_byte(wr * 64 + fr, fq * 8), boff = lds_byte(wc * 32 + fr, fq * 8);
#define PG8_SA(b, h) (((b) * 2 + (h)) * HTB)
#define PG8_SB(b, h) ((4 + (b) * 2 + (h)) * HTB)
#define PG8_STAGE(bufoff, gbase, voff) do { _Pragma("unroll") for (int _i = 0; _i < 2; ++_i) \
        __builtin_amdgcn_global_load_lds((const unsigned*)((const char*)(gbase) + (voff)[_i]), (LAS unsigned*)(lds + (bufoff) + ldsw + _i * 8192), 16, 0, 0); } while (0)
#define PG8_LDA(dst, b, h) do { _Pragma("unroll") for (int m = 0; m < 4; ++m) _Pragma("unroll") for (int k = 0; k < 2; ++k) dst[m][k] = *(const LAS bf16x8*)(lds + PG8_SA(b, h) + aoff + m * 2048 + k * 1024); } while (0)
#define PG8_LDB(dst, b, h) do { _Pragma("unroll") for (int n = 0; n < 2; ++n) _Pragma("unroll") for (int k = 0; k < 2; ++k) dst[n][k] = *(const LAS bf16x8*)(lds + PG8_SB(b, h) + boff + n * 2048 + k * 1024); } while (0)
#define PG8_MMA(ai, bj, At, Bt) do { __builtin_amdgcn_s_setprio(1); _Pragma("unroll") for (int m = 0; m < 4; ++m) _Pragma("unroll") for (int n = 0; n < 2; ++n) _Pragma("unroll") for (int k = 0; k < 2; ++k) \
        acc[ai][bj][m][n] = __builtin_amdgcn_mfma_f32_16x16x32_bf16(Bt[n][k], At[m][k], acc[ai][bj][m][n], 0, 0, 0); __builtin_amdgcn_s_setprio(0); } while (0)
#define PG8_WAIT_V(n) WAIT_VM(n)
#define PG8_WAIT_L(n) WAIT_LGKM(n)
#define PG8_BAR __builtin_amdgcn_s_barrier()
#define PG8_SCHED __builtin_amdgcn_sched_barrier(0)
    Unit cur, nxt; int ui = 0;
    if (!S.next(0, cur)) return;
    f32x4 acc[2][2][4][2];
#pragma unroll
    for (int a = 0; a < 2; ++a)
#pragma unroll
        for (int b = 0; b < 2; ++b)
#pragma unroll
            for (int m = 0; m < 4; ++m)
#pragma unroll
                for (int n = 0; n < 2; ++n) acc[a][b][m][n] = (f32x4){0.f, 0.f, 0.f, 0.f};
    bf16x8 At[4][2], B0[2][2], B1[2][2];
    const char* cA = (const char*)g.A + (size_t)cur.pm * tstep; const char* cB = (const char*)g.Bt + (size_t)cur.pn * tstep;
    if constexpr (SP2) {
        PG8_STAGE(PG8_SB(0, 0), cB, voffB); PG8_STAGE(PG8_SB(0, 1), cB + hstep, voffB); PG8_STAGE(PG8_SA(0, 0), cA, voffA); PG8_STAGE(PG8_SA(0, 1), cA + hstep, voffA);
        if (wr == 1) PG8_BAR;
        PG8_WAIT_V(2); PG8_BAR;
        PG8_STAGE(PG8_SB(1, 0), cB + kstep, voffB); PG8_STAGE(PG8_SA(1, 0), cA + kstep, voffA); PG8_STAGE(PG8_SB(1, 1), cB + hstep + kstep, voffB);
        PG8_WAIT_V(6); PG8_BAR;
    } else {
        PG8_STAGE(PG8_SB(0, 0), cB, voffB); PG8_STAGE(PG8_SA(0, 0), cA, voffA); PG8_STAGE(PG8_SB(0, 1), cB + hstep, voffB); PG8_STAGE(PG8_SA(0, 1), cA + hstep, voffA);
        if (wr == 1) PG8_BAR;
        PG8_WAIT_V(4); PG8_BAR;
        PG8_STAGE(PG8_SB(1, 0), cB + kstep, voffB); PG8_STAGE(PG8_SA(1, 0), cA + kstep, voffA); PG8_STAGE(PG8_SB(1, 1), cB + hstep + kstep, voffB);
        PG8_WAIT_V(6); PG8_BAR;
    }
    for (;;) {
        const bool has_next = S.next(ui + 1, nxt);
        const char* nA = has_next ? (const char*)g.A + (size_t)nxt.pm * tstep : cA; const char* nB = has_next ? (const char*)g.Bt + (size_t)nxt.pn * tstep : cB;
#define PG8_KBODY \
            const bool last = (t == nt - 2); \
            const char* a1 = cA + (size_t)(t + 1) * kstep; \
            const char* a2 = last ? nA : cA + (size_t)(t + 2) * kstep; const char* b2 = last ? nB : cB + (size_t)(t + 2) * kstep; \
            const char* a3 = a2 + kstep; const char* b3 = b2 + kstep; \
            if constexpr (SP2) { \
            PG8_LDB(B0, 0, 0); PG8_LDB(B1, 0, 1); PG8_SCHED; PG8_LDA(At, 0, 0); PG8_STAGE(PG8_SA(1, 1), a1 + hstep, voffA); \
            PG8_WAIT_V(8); PG8_WAIT_L(0); PG8_BAR; PG8_MMA(0, 0, At, B0); PG8_MMA(0, 1, At, B1); PG8_BAR; PG8_SCHED; \
            PG8_LDA(At, 0, 1); PG8_STAGE(PG8_SB(0, 0), b2, voffB); PG8_STAGE(PG8_SB(0, 1), b2 + hstep, voffB); PG8_STAGE(PG8_SA(0, 0), a2, voffA); \
            PG8_WAIT_V(8); PG8_WAIT_L(0); PG8_BAR; PG8_MMA(1, 0, At, B0); PG8_MMA(1, 1, At, B1); PG8_BAR; PG8_SCHED; \
            PG8_LDB(B0, 1, 0); PG8_LDB(B1, 1, 1); PG8_SCHED; PG8_LDA(At, 1, 0); PG8_STAGE(PG8_SA(0, 1), a2 + hstep, voffA); \
            PG8_WAIT_V(8); PG8_WAIT_L(0); PG8_BAR; PG8_MMA(0, 0, At, B0); PG8_MMA(0, 1, At, B1); PG8_BAR; PG8_SCHED; \
            PG8_LDA(At, 1, 1); PG8_STAGE(PG8_SB(1, 0), b3, voffB); PG8_STAGE(PG8_SB(1, 1), b3 + hstep, voffB); PG8_STAGE(PG8_SA(1, 0), a3, voffA); \
            PG8_WAIT_V(8); PG8_WAIT_L(0); PG8_BAR; PG8_MMA(1, 0, At, B0); PG8_MMA(1, 1, At, B1); PG8_BAR; PG8_SCHED; \
            } else { \
            PG8_LDB(B0, 0, 0); PG8_SCHED; PG8_LDA(At, 0, 0); PG8_STAGE(PG8_SA(1, 1), a1 + hstep, voffA); \
            PG8_WAIT_L(8); PG8_BAR; PG8_WAIT_L(0); PG8_MMA(0, 0, At, B0); PG8_BAR; PG8_SCHED; \
            PG8_LDB(B1, 0, 1); PG8_STAGE(PG8_SB(0, 0), b2, voffB); \
            PG8_BAR; PG8_WAIT_L(0); PG8_MMA(0, 1, At, B1); PG8_BAR; \
            PG8_LDA(At, 0, 1); PG8_STAGE(PG8_SA(0, 0), a2, voffA); \
            PG8_BAR; PG8_WAIT_L(0); PG8_MMA(1, 0, At, B0); PG8_BAR; PG8_SCHED; \
            PG8_STAGE(PG8_SB(0, 1), b2 + hstep, voffB); \
            PG8_WAIT_V(6); PG8_BAR; PG8_MMA(1, 1, At, B1); PG8_BAR; \
            PG8_LDB(B0, 1, 0); PG8_SCHED; PG8_LDA(At, 1, 0); PG8_STAGE(PG8_SA(0, 1), a2 + hstep, voffA); \
            PG8_WAIT_L(8); PG8_BAR; PG8_WAIT_L(0); PG8_MMA(0, 0, At, B0); PG8_BAR; PG8_SCHED; \
            PG8_LDB(B1, 1, 1); PG8_STAGE(PG8_SB(1, 0), b3, voffB); \
            PG8_BAR; PG8_WAIT_L(0); PG8_MMA(0, 1, At, B1); PG8_BAR; \
            PG8_LDA(At, 1, 1); PG8_STAGE(PG8_SA(1, 0), a3, voffA); \
            PG8_BAR; PG8_WAIT_L(0); PG8_MMA(1, 0, At, B0); PG8_BAR; PG8_SCHED; \
            PG8_STAGE(PG8_SB(1, 1), b3 + hstep, voffB); \
            PG8_WAIT_V(6); PG8_BAR; PG8_MMA(1, 1, At, B1); PG8_BAR; \
            } \
         \

        if constexpr (Epi::HAS_MID) {
            for (int t = 0; t < E.tmid; t += 2) { PG8_KBODY }
            E.mid(acc, cur, wr, fr);
            for (int t = E.tmid; t < nt; t += 2) { PG8_KBODY }
        } else {
            for (int t = 0; t < nt; t += 2) { PG8_KBODY }
        }
#undef PG8_KBODY
        if constexpr (ALIGN_EPI) { if (wr == 0) PG8_BAR; }
        E(acc, cur, wr, wc, fr, fq);
        if (!has_next) break;
#pragma unroll
        for (int a = 0; a < 2; ++a)
#pragma unroll
            for (int b = 0; b < 2; ++b)
#pragma unroll
                for (int m = 0; m < 4; ++m)
#pragma unroll
                    for (int n = 0; n < 2; ++n) acc[a][b][m][n] = (f32x4){0.f, 0.f, 0.f, 0.f};
        cur = nxt; cA = nA; cB = nB; ++ui;
        if constexpr (ALIGN_EPI) { if (wr == 1) PG8_BAR; }
    }
    PG8_WAIT_V(0);
    if constexpr (!ALIGN_EPI) { if (wr == 0) PG8_BAR; }
    PG8_BAR;
#undef PG8_SA
#undef PG8_SB
#undef PG8_STAGE
#undef PG8_LDA
#undef PG8_LDB
#undef PG8_MMA
#undef PG8_WAIT_V
#undef PG8_WAIT_L
#undef PG8_BAR
#undef PG8_SCHED
}
}

constexpr size_t al256(size_t x) { return (x + 255) & ~(size_t)255; }
constexpr size_t WS_CTL = 0, CTL_BYTES = 1u << 20;
constexpr size_t CTL_RS5 = 65536;
static_assert(CTL_RS5 + (size_t)M * 8 <= CTL_BYTES, "ctl");
constexpr float FX_SCALE = 4294967296.0f, FX_INV = 1.0f / 4294967296.0f;
constexpr size_t WS_WIN = WS_CTL + CTL_BYTES;
constexpr size_t WS_WGLU = WS_WIN + al256((size_t)NIN * D * 2);
constexpr size_t WS_WOUT = WS_WGLU + al256((size_t)2 * MIX_B * MIX_B * 2);
constexpr size_t WS_WGU = WS_WOUT + al256((size_t)D * D * 2);
constexpr size_t WS_WDN = WS_WGU + al256((size_t)2 * D_FF * D * 2);
constexpr size_t WS_ASILU = WS_WDN + al256((size_t)D * D_FF * 2);
constexpr size_t WS_MOD = WS_ASILU + al256((size_t)256 * D * 2);
constexpr size_t WS_AB = WS_MOD + al256((size_t)NB * 6 * D * 4);
constexpr size_t WS_H12 = WS_AB + al256((size_t)M * 16 * 4);
constexpr size_t WS_ACAT = WS_H12 + al256((size_t)M * D * 2);
constexpr size_t WS_F = WS_H12;
constexpr size_t WS_QKVB = WS_ACAT + al256((size_t)M * D * 2);
constexpr size_t WS_ZB = WS_QKVB + al256((size_t)M * QKV * 2);
constexpr size_t WS_UB = WS_ZB + al256((size_t)M * MIX_A * 2);
constexpr size_t WS_Y5 = WS_UB + al256((size_t)M * MIX_B * 2);
constexpr size_t WS_HMID = WS_QKVB;
constexpr size_t WS_MIX = WS_Y5 + al256((size_t)M * MIX_B * 2);
static_assert(WS_ACAT == WS_H12 + (size_t)M * D * 2 && WS_MIX - WS_QKVB >= (size_t)M * D_FF * 2, "overlay");
constexpr int FR_U = 0, FR_W = 32768, FR_Q = FR_W + 16384, FR_A = FR_Q + 16384, FR_K = FR_A + 8192, FR_SC = FR_K + 16384, CHUNK_BYTES = FR_SC + 256;
constexpr int NCHUNK_P = BATCH * NH * (SEQ / CHUNK);
constexpr size_t WS_FRAG = WS_MIX;
constexpr size_t FRAG_TOTAL = (size_t)NCHUNK_P * CHUNK_BYTES;
constexpr size_t WS_END = WS_MIX + (FRAG_TOTAL > (size_t)M * D * 4 ? FRAG_TOTAL : (size_t)M * D * 4);

constexpr size_t O_YP = 0, O_YS = O_YP + (size_t)MP * D, O_CONVP = O_YS + (size_t)MS * D, O_DELP = O_CONVP + (size_t)BATCH * 3 * QKV,
                 O_SREP = O_DELP + (size_t)BATCH * NH * HD * HD, O_SIMP = O_SREP + (size_t)BATCH * NG * NP, O_CONVS = O_SIMP + (size_t)BATCH * NG * NP,
                 O_DELS = O_CONVS + (size_t)DEC_BATCH * 3 * QKV, O_SRES = O_DELS + (size_t)DEC_BATCH * NH * HD * HD, O_SIMS = O_SRES + (size_t)DEC_BATCH * NG * NP,
                 O_END = O_SIMS + (size_t)DEC_BATCH * NG * NP;

constexpr int RING_BYTES = 131072, LDS_BYTES = 147456;
constexpr int NWAVES = 8, NTHREADS = 512;

enum InIdx { I_XP = 0, I_XS, I_CP, I_CS, I_SCONV, I_SDELTA, I_SSRE, I_SSIM, I_WADA, I_BADA, I_GPREMIX, I_GPOSTMIX, I_GPREFFN, I_GPOSTFFN, I_WIN, I_WCONV, I_ALOG, I_DTBIAS,
             I_GDN, I_LAMRE, I_LAMIM, I_LOGSTEP, I_BRE, I_BIM, I_CRE, I_CIM, I_DSKIP, I_WGLU, I_GS5, I_WOUT, I_WGATE, I_WUP, I_WDOWN, N_IN };
struct Args { const float* in[N_IN]; float* out; unsigned char* ws; int ph_lo, ph_hi; };

struct Frame {
    LAS unsigned char* lds;
    const float* const* in; float* out; unsigned char* ws;
    int tid, lane, wave, vcu, G;
};
DEVI const float* xrow(const Frame& F, int m) { return m < MP ? F.in[I_XP] + (size_t)m * D : F.in[I_XS] + (size_t)(m - MP) * D; }
DEVI int modrow(int m) { return m < MP ? m / SEQ : BATCH + (m - MP) / DEC_SEQ; }

DEVI void tr_item(const float* W, int ldw, int srccol, int k0, const float* kscale, bf16* WT, int dstK, int drow, int dk0, LAS float* scr, int lane) {
#pragma unroll 8
    for (int i = 0; i < 32; ++i) { const int kk = 2 * i + (lane >> 5); float v = W[(size_t)(k0 + kk) * ldw + srccol + (lane & 31)]; if (kscale) v *= kscale[k0 + kk]; scr[kk * 33 + (lane & 31)] = v; }
    WAVE_LDS_SYNC();
    const int c = lane & 7;
#pragma unroll
    for (int j = 0; j < 4; ++j) { const int n = (lane >> 3) + 8 * j; const LAS float* s = scr + (8 * c) * 33 + n;
        u32x4 o; o.x = pk2(s[0 * 33], s[1 * 33]); o.y = pk2(s[2 * 33], s[3 * 33]); o.z = pk2(s[4 * 33], s[5 * 33]); o.w = pk2(s[6 * 33], s[7 * 33]);
        *(u32x4*)(WT + (size_t)(drow + n) * dstK + dk0 + 8 * c) = o; }
    WAVE_LDS_SYNC();
}
DEVI void p0_prologue(Frame& F) {
    LAS float* scr = (LAS float*)(F.lds + F.wave * 16384);
    const int gw = F.vcu * NWAVES + F.wave, NGW = F.G * NWAVES;
    bf16* Win = (bf16*)(F.ws + WS_WIN); bf16* Wglu = (bf16*)(F.ws + WS_WGLU); bf16* Wout = (bf16*)(F.ws + WS_WOUT); bf16* Wgu = (bf16*)(F.ws + WS_WGU); bf16* Wdn = (bf16*)(F.ws + WS_WDN);
    constexpr int NB_IN = (QKV + MIX_A + MIX_B) / 32, I_IN = (D / 64) * NB_IN;
    constexpr int NB_GLU = 2 * MIX_B / 32, I_GLU = (MIX_B / 64) * NB_GLU;
    constexpr int NB_OUT = D / 32, I_OUT = (D / 64) * NB_OUT;
    constexpr int NB_GU = 2 * D_FF / 32, I_GU = (D / 64) * NB_GU;
    constexpr int NB_DN = D / 32, I_DN = (D_FF / 64) * NB_DN;
    constexpr int NITEMS = I_IN + I_GLU + I_OUT + I_GU + I_DN;
    for (int it = gw; it < NITEMS; it += NGW) {
        int r = it;
        if (r < I_IN) { const int kb = r / NB_IN, drow = 32 * (r % NB_IN); const int src = drow + (drow >= QKV + MIX_A ? 2 * NH : 0);
            tr_item(F.in[I_WIN], PROJ, src, 64 * kb, nullptr, Win, D, drow, 64 * kb, scr, F.lane); continue; } r -= I_IN;
        if (r < I_GLU) { const int kb = r / NB_GLU, drow = 32 * (r % NB_GLU); const int src = ((drow >> 7) & 1) * MIX_B + 128 * (drow >> 8) + (drow & 127);
            tr_item(F.in[I_WGLU], 2 * MIX_B, src, 64 * kb, nullptr, Wglu, MIX_B, drow, 64 * kb, scr, F.lane); continue; } r -= I_GLU;
        if (r < I_OUT) { const int kb = r / NB_OUT, drow = 32 * (r % NB_OUT); const int k0 = 64 * kb;
            tr_item(F.in[I_WOUT], D, drow, k0, k0 >= MIX_A ? F.in[I_GS5] - MIX_A : nullptr, Wout, D, drow, (k0 + MIX_B) % D, scr, F.lane); continue; } r -= I_OUT;
        if (r < I_GU) { const int kb = r / NB_GU, drow = 32 * (r % NB_GU); const int src = 128 * (drow >> 8) + (drow & 127);
            tr_item(((drow >> 7) & 1) ? F.in[I_WUP] : F.in[I_WGATE], D_FF, src, 64 * kb, nullptr, Wgu, D, drow, 64 * kb, scr, F.lane); continue; } r -= I_GU;
        { const int kb = r / NB_DN, drow = 32 * (r % NB_DN); tr_item(F.in[I_WDOWN], D, drow, 64 * kb, nullptr, Wdn, D_FF, drow, 64 * kb, scr, F.lane); }
    }
    const int gt = F.vcu * NTHREADS + F.tid, NGT = F.G * NTHREADS;
    for (int i = gt; i < 256 * D; i += NGT) { const int r = i / D, k = i % D;
        Win[(size_t)(QKV + MIX_A + MIX_B + r) * D + k] = (bf16)(r < 2 * NH ? f2bf(F.in[I_WIN][(size_t)k * PROJ + QKV + MIX_A + r]) : 0u); }
    bf16* As = (bf16*)(F.ws + WS_ASILU);
    for (int i = gt; i < 256 * D; i += NGT) { const int r = i / D, k = i % D; float v = 0.f;
        if (r < NB) v = siluf_(r < BATCH ? F.in[I_CP][(size_t)r * D + k] : F.in[I_CS][(size_t)(r - BATCH) * D + k]);
        As[i] = (bf16)f2bf(v); }
}

DEVI void p1_ada(Frame& F) {
    constexpr int MT = (NB + 15) / 16, NCOL = 48, UNITS = 6 * D / NCOL, KW = D / NWAVES, KS = KW / 32, SLOT = MT * 3 * 256;
    static_assert(6 * D % NCOL == 0 && KW % 32 == 0 && 4 * SLOT * 4 <= RING_BYTES, "ada");
    const bf16* As = (const bf16*)(F.ws + WS_ASILU); const float* W = F.in[I_WADA]; float* mod = (float*)(F.ws + WS_MOD);
    const int lane = F.lane, q = lane >> 4, c16 = lane & 15, wid = F.wave;
    LAS float* red = (LAS float*)F.lds;
    for (int unit = F.vcu; unit < UNITS; unit += F.G) {
        const int n0 = unit * NCOL;
        f32x4 acc[MT][3];
#pragma unroll
        for (int mt = 0; mt < MT; ++mt)
#pragma unroll
            for (int nt = 0; nt < 3; ++nt) acc[mt][nt] = (f32x4){0.f, 0.f, 0.f, 0.f};
        for (int ks = 0; ks < KS; ++ks) {
            const int k0 = wid * KW + 32 * ks;
            bf16x8 b[3];
#pragma unroll
            for (int nt = 0; nt < 3; ++nt) { float w[8];
#pragma unroll
                for (int j = 0; j < 8; ++j) w[j] = W[(size_t)(k0 + 8 * q + j) * (6 * D) + n0 + 16 * nt + c16];
                u32x4 p; p.x = pk2(w[0], w[1]); p.y = pk2(w[2], w[3]); p.z = pk2(w[4], w[5]); p.w = pk2(w[6], w[7]); b[nt] = __builtin_bit_cast(bf16x8, p); }
#pragma unroll
            for (int mt = 0; mt < MT; ++mt) { const bf16x8 a = *(const bf16x8*)(As + (size_t)(16 * mt + c16) * D + k0 + 8 * q);
#pragma unroll
                for (int nt = 0; nt < 3; ++nt) acc[mt][nt] = __builtin_amdgcn_mfma_f32_16x16x32_bf16(a, b[nt], acc[mt][nt], 0, 0, 0); }
        }
        for (int s = 4; s >= 1; s >>= 1) {
            if (wid >= s && wid < 2 * s) {
#pragma unroll
                for (int mt = 0; mt < MT; ++mt)
#pragma unroll
                    for (int nt = 0; nt < 3; ++nt) *(LAS f32x4*)(red + (wid - s) * SLOT + (mt * 3 + nt) * 256 + lane * 4) = acc[mt][nt];
            }
            __syncthreads();
            if (wid < s) {
#pragma unroll
                for (int mt = 0; mt < MT; ++mt)
#pragma unroll
                    for (int nt = 0; nt < 3; ++nt) acc[mt][nt] += *(const LAS f32x4*)(red + wid * SLOT + (mt * 3 + nt) * 256 + lane * 4);
            }
            __syncthreads();
        }
        if (wid == 0) {
#pragma unroll
            for (int mt = 0; mt < MT; ++mt)
#pragma unroll
                for (int nt = 0; nt < 3; ++nt) { const int col = n0 + 16 * nt + c16; const float bias = F.in[I_BADA][col];
#pragma unroll
                    for (int r = 0; r < 4; ++r) { const int row = 16 * mt + 4 * q + r; if (row < NB) mod[(size_t)row * (6 * D) + col] = acc[mt][nt][r] + bias; } }
        }
    }
}

constexpr int NV = D / 256;
DEVI void p2_h1(Frame& F) {
    const int gw = F.wave * F.G + F.vcu, NGW = F.G * NWAVES; const float* mod = (const float*)(F.ws + WS_MOD); bf16* H = (bf16*)(F.ws + WS_H12);
    for (int m = gw; m < M; m += NGW) {
        const f32x4* xr = (const f32x4*)xrow(F, m) + F.lane; const float* md = mod + (size_t)modrow(m) * 6 * D;
        f32x4 v[NV]; float s = 0.f;
#pragma unroll
        for (int j = 0; j < NV; ++j) { v[j] = xr[64 * j]; s += (v[j].x * v[j].x + v[j].y * v[j].y) + (v[j].z * v[j].z + v[j].w * v[j].w); }
        const float rstd = f_rsqrt(wave_sum(s) * (1.f / D) + EPS);
#pragma unroll
        for (int j = 0; j < NV; ++j) { const int idx = 4 * (F.lane + 64 * j);
            const f32x4 g = *(const f32x4*)(F.in[I_GPREMIX] + idx), sh = *(const f32x4*)(md + idx), sc = *(const f32x4*)(md + D + idx);
            const f32x4 h = v[j] * rstd * g * (sc + 1.0f) + sh; u32x2 o; o.x = pk2(h.x, h.y); o.y = pk2(h.z, h.w);
            *(u32x2*)(H + (size_t)m * D + idx) = o; }
    }
}
DEVI void p8_x1h2(Frame& F) {
    const int gw = F.wave * F.G + F.vcu, NGW = F.G * NWAVES; const float* mod = (const float*)(F.ws + WS_MOD); bf16* H = (bf16*)(F.ws + WS_H12);
    float* mix = (float*)(F.ws + WS_MIX);
    for (int m = gw; m < M; m += NGW) {
        const f32x4* xr = (const f32x4*)xrow(F, m) + F.lane; const float* md = mod + (size_t)modrow(m) * 6 * D; f32x4* mr = (f32x4*)(mix + (size_t)m * D) + F.lane;
        f32x4 v[NV]; float sm = 0.f;
#pragma unroll
        for (int j = 0; j < NV; ++j) { v[j] = mr[64 * j]; sm += (v[j].x * v[j].x + v[j].y * v[j].y) + (v[j].z * v[j].z + v[j].w * v[j].w); }
        const float rm = f_rsqrt(wave_sum(sm) * (1.f / D) + EPS);
        float s = 0.f;
#pragma unroll
        for (int j = 0; j < NV; ++j) { const int idx = 4 * (F.lane + 64 * j);
            const f32x4 g = *(const f32x4*)(F.in[I_GPOSTMIX] + idx), gt = *(const f32x4*)(md + 2 * D + idx);
            v[j] = xr[64 * j] + gt * (v[j] * rm * g); mr[64 * j] = v[j];
            s += (v[j].x * v[j].x + v[j].y * v[j].y) + (v[j].z * v[j].z + v[j].w * v[j].w); }
        const float rstd = f_rsqrt(wave_sum(s) * (1.f / D) + EPS);
#pragma unroll
        for (int j = 0; j < NV; ++j) { const int idx = 4 * (F.lane + 64 * j);
            const f32x4 g = *(const f32x4*)(F.in[I_GPREFFN] + idx), sh = *(const f32x4*)(md + 3 * D + idx), sc = *(const f32x4*)(md + 4 * D + idx);
            const f32x4 h = v[j] * rstd * g * (sc + 1.0f) + sh; u32x2 o; o.x = pk2(h.x, h.y); o.y = pk2(h.z, h.w);
            *(u32x2*)(H + (size_t)m * D + idx) = o; }
    }
}
DEVI void p11_out(Frame& F) {
    const int gw = F.wave * F.G + F.vcu, NGW = F.G * NWAVES; const float* mod = (const float*)(F.ws + WS_MOD);
    const float* x1 = (const float*)(F.ws + WS_MIX); const float* f = (const float*)(F.ws + WS_F);
    for (int m = gw; m < M; m += NGW) {
        const float* md = mod + (size_t)modrow(m) * 6 * D;
        const f32x4* xr = (const f32x4*)(x1 + (size_t)m * D) + F.lane; const f32x4* fr = (const f32x4*)(f + (size_t)m * D) + F.lane; f32x4* o = (f32x4*)(F.out + O_YP + (size_t)m * D) + F.lane;
        f32x4 v[NV]; float s = 0.f;
#pragma unroll
        for (int j = 0; j < NV; ++j) { v[j] = fr[64 * j]; s += (v[j].x * v[j].x + v[j].y * v[j].y) + (v[j].z * v[j].z + v[j].w * v[j].w); }
        const float rf = f_rsqrt(wave_sum(s) * (1.f / D) + EPS);
#pragma unroll
        for (int j = 0; j < NV; ++j) { const int idx = 4 * (F.lane + 64 * j);
            const f32x4 g = *(const f32x4*)(F.in[I_GPOSTFFN] + idx), gt = *(const f32x4*)(md + 5 * D + idx);
            o[64 * j] = xr[64 * j] + gt * (v[j] * rf * g); }
    }
}
template <int VW> DEVI void ld_bf(const bf16* p, float* o) {
    if constexpr (VW == 8) { const u32x4 w = *(const u32x4*)p; const unsigned ww[4] = {w.x, w.y, w.z, w.w};
#pragma unroll
        for (int e = 0; e < 4; ++e) { o[2 * e] = bf2f(ww[e]); o[2 * e + 1] = bf2f(ww[e] >> 16); } }
    else { const u32x2 w = *(const u32x2*)p; o[0] = bf2f(w.x); o[1] = bf2f(w.x >> 16); o[2] = bf2f(w.y); o[3] = bf2f(w.y >> 16); }
}
DEVI void p6_onorm(Frame& F) {
    constexpr int PL = MIX_A / 64, LPH = HD / PL, VW = PL >= 8 ? 8 : 4;
    static_assert(PL % VW == 0 && (LPH & (LPH - 1)) == 0, "onorm");
    const int gw = F.wave * F.G + F.vcu, NGW = F.G * NWAVES;
    const bf16* oraw = (const bf16*)(F.ws + WS_H12); const bf16* zb = (const bf16*)(F.ws + WS_ZB); bf16* acat = (bf16*)(F.ws + WS_ACAT);
    for (int m = gw; m < M; m += NGW) {
        float o[PL], z[PL]; float s = 0.f; const int c0 = F.lane * PL;
#pragma unroll
        for (int j = 0; j < PL / VW; ++j) { ld_bf<VW>(oraw + (size_t)m * D + c0 + VW * j, o + VW * j); ld_bf<VW>(zb + (size_t)m * MIX_A + c0 + VW * j, z + VW * j); }
#pragma unroll
        for (int j = 0; j < PL; ++j) s += o[j] * o[j];
#pragma unroll
        for (int d = 1; d < LPH; d <<= 1) s += __shfl_xor(s, d);
        const float rstd = f_rsqrt(s * (1.f / HD) + EPS);
#pragma unroll
        for (int j = 0; j < PL; j += 2) { const int d0 = (c0 + j) % HD;
            const float a = o[j] * rstd * F.in[I_GDN][d0] * siluf_(z[j]), b = o[j + 1] * rstd * F.in[I_GDN][d0 + 1] * siluf_(z[j + 1]);
            *(unsigned*)(acat + (size_t)m * D + MIX_B + c0 + j) = pk2(a, b); }
    }
}

using pg8::Unit;
DEVI void st8bf(bf16* p, const f32x4 v0, const f32x4 v1) { u32x4 w; w.x = pk2(v0[0], v0[1]); w.y = pk2(v0[2], v0[3]); w.z = pk2(v1[0], v1[1]); w.w = pk2(v1[2], v1[3]); *(u32x4*)p = w; }
struct EpiInProj {
    static constexpr bool PERM = true, HAS_MID = false; int tmid;
    bf16 *qkv, *z, *u; float *ab, *convp, *convs;
    DEVI void mid(f32x4 (&)[2][2][4][2], const Unit&, int, int) const {}
    DEVI void operator()(const f32x4 (&acc)[2][2][4][2], const Unit& un, int wr, int wc, int fr, int fq) const {
        const int row0 = un.pm * 256 + wr * 64 + fr, pn = un.pn;
#pragma unroll
        for (int ai = 0; ai < 2; ++ai)
#pragma unroll
            for (int m = 0; m < 4; ++m) { const int row = row0 + ai * 128 + m * 16;
                float* ct = nullptr;
                if (pn < NT_QKV) { if (row < MP) { const int t = row % SEQ; if (t >= SEQ - 3) ct = convp + ((size_t)(row / SEQ) * 3 + (t - (SEQ - 3))) * QKV; }
                                   else { const int r2 = row - MP, t = r2 % DEC_SEQ; if (t >= DEC_SEQ - 3) ct = convs + ((size_t)(r2 / DEC_SEQ) * 3 + (t - (DEC_SEQ - 3))) * QKV; } }
#pragma unroll
                for (int bj = 0; bj < 2; ++bj) { const int c0 = 128 * bj + 32 * wc + 8 * fq; const f32x4 v0 = acc[ai][bj][m][0], v1 = acc[ai][bj][m][1];
                    if (pn < NT_QKV) { const int col = pn * 256 + c0; st8bf(qkv + (size_t)row * QKV + col, v0, v1); if (ct) { *(f32x4*)(ct + col) = v0; *(f32x4*)(ct + col + 4) = v1; } }
                    else if (pn < NT_QKV + NT_Z) st8bf(z + (size_t)row * MIX_A + (pn - NT_QKV) * 256 + c0, v0, v1);
                    else if (pn < NT_QKV + NT_Z + NT_U) st8bf(u + (size_t)row * MIX_B + (pn - NT_QKV - NT_Z) * 256 + c0, v0, v1);
                    else if (c0 < 16) { *(f32x4*)(ab + (size_t)row * 16 + c0) = v0; *(f32x4*)(ab + (size_t)row * 16 + c0 + 4) = v1; } } }
    }
};
struct EpiGlu {
    static constexpr bool PERM = true, HAS_MID = false; int tmid;
    bf16* acat; unsigned long long* rs;
    DEVI void mid(f32x4 (&)[2][2][4][2], const Unit&, int, int) const {}
    DEVI void operator()(const f32x4 (&acc)[2][2][4][2], const Unit& un, int wr, int wc, int fr, int fq) const {
        const int row0 = un.pm * 256 + wr * 64 + fr, col = un.pn * 128 + 32 * wc + 8 * fq;
#pragma unroll
        for (int ai = 0; ai < 2; ++ai)
#pragma unroll
            for (int m = 0; m < 4; ++m) { const int row = row0 + ai * 128 + m * 16; f32x4 y[2]; float s = 0.f;
#pragma unroll
                for (int n = 0; n < 2; ++n)
#pragma unroll
                    for (int i = 0; i < 4; ++i) { const float v = acc[ai][0][m][n][i] * sigmoidf_(acc[ai][1][m][n][i]); y[n][i] = v; s += v * v; }
                st8bf(acat + (size_t)row * D + col, y[0], y[1]);
                s += __shfl_xor(s, 16); s += __shfl_xor(s, 32);
                if (fq == 0) atomicAdd(rs + row, (unsigned long long)(s * FX_SCALE)); }
    }
};
struct EpiSwiglu {
    static constexpr bool PERM = true, HAS_MID = false; int tmid;
    bf16* hm;
    DEVI void mid(f32x4 (&)[2][2][4][2], const Unit&, int, int) const {}
    DEVI void operator()(const f32x4 (&acc)[2][2][4][2], const Unit& un, int wr, int wc, int fr, int fq) const {
        const int row0 = un.pm * 256 + wr * 64 + fr, col = un.pn * 128 + 32 * wc + 8 * fq;
#pragma unroll
        for (int ai = 0; ai < 2; ++ai)
#pragma unroll
            for (int m = 0; m < 4; ++m) { const int row = row0 + ai * 128 + m * 16; f32x4 y[2];
#pragma unroll
                for (int n = 0; n < 2; ++n)
#pragma unroll
                    for (int i = 0; i < 4; ++i) y[n][i] = siluf_(acc[ai][0][m][n][i]) * acc[ai][1][m][n][i];
                st8bf(hm + (size_t)row * D_FF + col, y[0], y[1]); }
    }
};
template <bool MID> struct EpiF32Rs {
    static constexpr bool PERM = false, HAS_MID = MID; int tmid;
    float* C; const unsigned long long* rs_in;
    DEVI void mid(f32x4 (&acc)[2][2][4][2], const Unit& un, int wr, int fr) const {
#pragma unroll
        for (int ai = 0; ai < 2; ++ai)
#pragma unroll
            for (int m = 0; m < 4; ++m) { const int row = un.pm * 256 + wr * 64 + fr + ai * 128 + m * 16; const float sc = f_rsqrt((float)rs_in[row] * (FX_INV / MIX_B) + EPS);
#pragma unroll
                for (int bj = 0; bj < 2; ++bj)
#pragma unroll
                    for (int n = 0; n < 2; ++n) acc[ai][bj][m][n] *= sc; }
    }
    DEVI void operator()(const f32x4 (&acc)[2][2][4][2], const Unit& un, int wr, int wc, int fr, int fq) const {
        const int row0 = un.pm * 256 + wr * 64 + fr, col0 = un.pn * 256 + wc * 32 + 4 * fq;
#pragma unroll
        for (int ai = 0; ai < 2; ++ai)
#pragma unroll
            for (int m = 0; m < 4; ++m) { const int row = row0 + ai * 128 + m * 16; float* rp = C + (size_t)row * D + col0;
#pragma unroll
                for (int bj = 0; bj < 2; ++bj)
#pragma unroll
                    for (int n = 0; n < 2; ++n) *(f32x4*)(rp + bj * 128 + n * 16) = acc[ai][bj][m][n]; }
    }
};

template <int C> struct PrepCfg { static constexpr int CP = C < 32 ? 32 : C, MT = C / 16, SC = CP / 32, LDQ = 136, LDT = CP + 8; };
template <int C> struct PrepLds {
    using P = PrepCfg<C>;
    static constexpr int QS = 0, KS = QS + C * P::LDQ * 2, KBS = KS + C * P::LDQ * 2, VBT = KBS + C * P::LDQ * 2, KGT = VBT + 128 * P::LDT * 2,
                         LS = KGT + 128 * P::LDT * 2, TS = LS + C * (C + 4) * 4, AS = TS + C * P::LDT * 2, SCAL = (AS + C * P::LDT * 2 + 15) & ~15, END = SCAL + 3 * C * 4 + 16;
};
template <int C, int NVALID>
DEVI void delta_prep(Frame& F, LAS unsigned char* L, int seq_row0, int t0, int h, const float* conv_state, unsigned char* frag) {
    using P = PrepCfg<C>; using O = PrepLds<C>;
    constexpr int LDQ = P::LDQ, LDT = P::LDT, CP = P::CP, MT = P::MT, SC = P::SC;
    LAS bf16* Qs = (LAS bf16*)(L + O::QS); LAS bf16* Ks = (LAS bf16*)(L + O::KS); LAS bf16* Kbs = (LAS bf16*)(L + O::KBS); LAS bf16* VbT = (LAS bf16*)(L + O::VBT); LAS bf16* KgT = (LAS bf16*)(L + O::KGT);
    LAS float* Ls = (LAS float*)(L + O::LS); LAS bf16* Ts = (LAS bf16*)(L + O::TS); LAS bf16* As = (LAS bf16*)(L + O::AS); LAS float* gcs = (LAS float*)(L + O::SCAL); LAS float* bts = gcs + C; LAS float* egs = bts + C;
    const bf16* qkv = (const bf16*)(F.ws + WS_QKVB); const float* ab = (const float*)(F.ws + WS_AB);
    const int lane = F.lane, wid = F.wave, tid = F.tid, q4 = lane >> 4, c16 = lane & 15;
    if (wid == 0) {
        float g = 0.f, bt = 0.f;
        if (lane < NVALID) { const float* abr = ab + (size_t)(seq_row0 + t0 + lane) * 16; const float x = abr[h] + F.in[I_DTBIAS][h];
            const float sp = x > 20.f ? x : log1pf(f_exp(x)); g = -f_exp(F.in[I_ALOG][h]) * sp; bt = sigmoidf_(abr[NH + h]); }
        float gc = g;
#pragma unroll
        for (int d = 1; d < 64; d <<= 1) { const float o = __shfl_up(gc, d); if (lane >= d) gc += o; }
        if (lane < C) { gcs[lane] = gc; bts[lane] = bt; egs[lane] = f_exp(gc); }
    }
    if constexpr (CP > C) {
        for (int i = tid; i < 128 * (CP - C); i += NTHREADS) { const int r = i / (CP - C), c = C + i % (CP - C); VbT[r * LDT + c] = 0; KgT[r * LDT + c] = 0; }
        for (int i = tid; i < C * (CP - C); i += NTHREADS) { const int r = i / (CP - C), c = C + i % (CP - C); Ts[r * LDT + c] = 0; As[r * LDT + c] = 0; }
    }
    __syncthreads();
    {
        constexpr int RW = C / 8; const float* wc_ = F.in[I_WCONV];
        float w4[6][4]; int gcol[6];
#pragma unroll
        for (int s = 0; s < 6; ++s) { gcol[s] = (s >> 1) * MIX_A + h * HD + (s & 1) * 64 + lane;
#pragma unroll
            for (int j = 0; j < 4; ++j) w4[s][j] = wc_[(size_t)j * QKV + gcol[s]]; }
        const int tb = wid * RW;
        float win[6][3];
#pragma unroll
        for (int s = 0; s < 6; ++s)
#pragma unroll
            for (int j = 0; j < 3; ++j) { const int i = t0 + tb + j;
                float v = 0.f; if (i < 3) { if (conv_state) v = conv_state[(size_t)i * QKV + gcol[s]]; } else v = bf2f(qkv[(size_t)(seq_row0 + i - 3) * QKV + gcol[s]]);
                win[s][j] = v; }
        const float gl = gcs[C - 1];
#pragma unroll
        for (int r = 0; r < RW; ++r) { const int t = tb + r; const bool valid = t < NVALID;
            float val[6];
#pragma unroll
            for (int s = 0; s < 6; ++s) { float cur = 0.f; if (valid) cur = bf2f(qkv[(size_t)(seq_row0 + t0 + t) * QKV + gcol[s]]);
                const float cv = w4[s][0] * win[s][0] + w4[s][1] * win[s][1] + w4[s][2] * win[s][2] + w4[s][3] * cur;
                win[s][0] = win[s][1]; win[s][1] = win[s][2]; win[s][2] = cur; val[s] = valid ? siluf_(cv) : 0.f; }
            const float sq = wave_sum(val[0] * val[0] + val[1] * val[1]), sk = wave_sum(val[2] * val[2] + val[3] * val[3]);
            const float rq = f_rsqrt(sq + 1e-6f) * 0.08838834764831845f, rk = f_rsqrt(sk + 1e-6f);
            const float bt = bts[t], eg = egs[t];
#pragma unroll
            for (int e = 0; e < 2; ++e) { const int c = e * 64 + lane; const float qn = val[e] * rq, kn = val[2 + e] * rk, vv = val[4 + e];
                Qs[t * LDQ + c] = (bf16)f2bf(qn); Ks[t * LDQ + c] = (bf16)f2bf(kn); Kbs[t * LDQ + c] = (bf16)f2bf(kn * bt);
                VbT[c * LDT + t] = (bf16)f2bf(vv * bt); KgT[c * LDT + t] = (bf16)f2bf(kn * bt * eg); }
            (void)gl;
        }
    }
    __syncthreads();
    for (int tix = wid; tix < 2 * MT * MT; tix += NWAVES) {
        const int which = tix / (MT * MT), mi = (tix % (MT * MT)) / MT, nj = tix % MT;
        if (nj > mi) {
            if (which == 0) { for (int r = 0; r < 4; ++r) Ls[(16 * mi + 4 * q4 + r) * (C + 4) + 16 * nj + c16] = 0.f; }
            else { for (int r = 0; r < 4; ++r) As[(16 * mi + 4 * q4 + r) * LDT + 16 * nj + c16] = 0; }
            continue; }
        const LAS bf16* A = which == 0 ? Kbs : Qs; f32x4 acc = {0.f, 0.f, 0.f, 0.f};
#pragma unroll
        for (int s = 0; s < 4; ++s) { const bf16x8 a = *(const LAS bf16x8*)(A + (16 * mi + c16) * LDQ + 32 * s + 8 * q4), b = *(const LAS bf16x8*)(Ks + (16 * nj + c16) * LDQ + 32 * s + 8 * q4);
            acc = __builtin_amdgcn_mfma_f32_16x16x32_bf16(a, b, acc, 0, 0, 0); }
        const int j = 16 * nj + c16; const float gj = gcs[j];
#pragma unroll
        for (int r = 0; r < 4; ++r) { const int i = 16 * mi + 4 * q4 + r; const float dec = f_exp(gcs[i] - gj);
            if (which == 0) Ls[i * (C + 4) + j] = (i > j) ? acc[r] * dec : 0.f;
            else As[i * LDT + j] = (bf16)((i >= j) ? f2bf(acc[r] * dec) : 0u); }
    }
    __syncthreads();
    if (wid == 0) {
        if (lane < C) {
            float x[C];
#pragma unroll
            for (int i = 0; i < C; ++i) { float s = (i == lane) ? 1.f : 0.f;
#pragma unroll
                for (int j = 0; j < i; ++j) s -= Ls[i * (C + 4) + j] * x[j];
                x[i] = s; Ts[i * LDT + lane] = (bf16)f2bf(s); }
        }
    } else {
        const float gl = gcs[C - 1];
        for (int i = tid - 64; i < C * 128; i += NTHREADS - 64) { const int t = i >> 7, c = i & 127;
            Qs[t * LDQ + c] = (bf16)f2bf(bf2f(Qs[t * LDQ + c]) * egs[t]); Ks[t * LDQ + c] = (bf16)f2bf(bf2f(Ks[t * LDQ + c]) * f_exp(gl - gcs[t])); }
    }
    __syncthreads();
    for (int tix = wid; tix < 2 * MT * 8; tix += NWAVES) {
        const int which = tix / (MT * 8), m = (tix % (MT * 8)) / 8, nv = tix % 8; const LAS bf16* Bt = which == 0 ? VbT : KgT; f32x4 acc = {0.f, 0.f, 0.f, 0.f};
#pragma unroll
        for (int s = 0; s < SC; ++s) { const bf16x8 a = *(const LAS bf16x8*)(Ts + (16 * m + c16) * LDT + 32 * s + 8 * q4), b = *(const LAS bf16x8*)(Bt + (16 * nv + c16) * LDT + 32 * s + 8 * q4);
            acc = __builtin_amdgcn_mfma_f32_16x16x32_bf16(a, b, acc, 0, 0, 0); }
        if (which == 0) *(f32x4*)(frag + FR_U + ((size_t)(nv * MT + m) * 64 + lane) * 16) = acc;
        else { for (int r = 0; r < 4; ++r) Kbs[(16 * m + 4 * q4 + r) * LDQ + 16 * nv + c16] = (bf16)f2bf(-acc[r]); }
    }
    __syncthreads();
    constexpr int NFW = MT * 4, NFA = MT * SC, NFK = 8 * SC, NF = 2 * NFW + NFA + NFK;
    for (int it = tid; it < NF * 64; it += NTHREADS) {
        const int f = it >> 6, l = it & 63, i16 = l & 15, q = l >> 4; u32x4 o;
        if (f < 2 * NFW) { const int which = f / NFW, ff = f % NFW, m = ff / 4, s = ff % 4; const LAS bf16* src = (which == 0 ? Kbs : Qs) + (16 * m + i16) * LDQ + 32 * s + 4 * q;
            const u32x2 lo = *(const LAS u32x2*)src, hi = *(const LAS u32x2*)(src + 16); o = (u32x4){lo.x, lo.y, hi.x, hi.y};
            *(u32x4*)(frag + (which == 0 ? FR_W : FR_Q) + ((size_t)ff * 64 + l) * 16) = o; }
        else if (f < 2 * NFW + NFA) { const int ff = f - 2 * NFW, m = ff / SC, s = ff % SC; const LAS bf16* src = As + (16 * m + i16) * LDT + 32 * s + 4 * q;
            const u32x2 lo = *(const LAS u32x2*)src, hi = *(const LAS u32x2*)(src + 16); o = (u32x4){lo.x, lo.y, hi.x, hi.y};
            *(u32x4*)(frag + FR_A + ((size_t)ff * 64 + l) * 16) = o; }
        else { const int ff = f - 2 * NFW - NFA, T = ff / SC, s = ff % SC; unsigned e[8];
#pragma unroll
            for (int j = 0; j < 8; ++j) { const int c = 32 * s + 16 * (j >> 2) + 4 * q + (j & 3); e[j] = (c < C) ? (unsigned)Ks[c * LDQ + 16 * T + i16] : 0u; }
            o = (u32x4){e[0] | (e[1] << 16), e[2] | (e[3] << 16), e[4] | (e[5] << 16), e[6] | (e[7] << 16)};
            *(u32x4*)(frag + FR_K + ((size_t)ff * 64 + l) * 16) = o; }
    }
    if (tid == 0) *(float*)(frag + FR_SC) = egs[C - 1];
    __syncthreads();
}

template <int C, int NVALID>
DEVI void delta_apply(const unsigned char* frag, size_t fstride, int nchunks, const float* S0, float* Sout, bf16* oraw_base  , int vs, int lane) {
    using P = PrepCfg<C>; constexpr int MT = P::MT, SC = P::SC;
    const int q = lane >> 4, c16 = lane & 15;
    f32x4 S[8];
#pragma unroll
    for (int T = 0; T < 8; ++T) { S[T] = (f32x4){0.f, 0.f, 0.f, 0.f}; if (S0) { const float* sp = S0 + (size_t)(16 * T + 4 * q) * HD + 16 * vs + c16; S[T] = (f32x4){sp[0], sp[HD], sp[2 * HD], sp[3 * HD]}; } }
    for (int n = 0; n < nchunks; ++n, frag += fstride) {
        const float egl = *(const float*)(frag + FR_SC);
        bf16x8 Sb[4];
#pragma unroll
        for (int s = 0; s < 4; ++s) { u32x4 p; p.x = pk2(S[2 * s][0], S[2 * s][1]); p.y = pk2(S[2 * s][2], S[2 * s][3]); p.z = pk2(S[2 * s + 1][0], S[2 * s + 1][1]); p.w = pk2(S[2 * s + 1][2], S[2 * s + 1][3]); Sb[s] = __builtin_bit_cast(bf16x8, p); }
        f32x4 vn[MT], o[MT];
#pragma unroll
        for (int m = 0; m < MT; ++m) { vn[m] = *(const f32x4*)(frag + FR_U + ((size_t)(vs * MT + m) * 64 + lane) * 16); o[m] = (f32x4){0.f, 0.f, 0.f, 0.f};
#pragma unroll
            for (int s = 0; s < 4; ++s) { const bf16x8 w = *(const bf16x8*)(frag + FR_W + ((size_t)(m * 4 + s) * 64 + lane) * 16), qf = *(const bf16x8*)(frag + FR_Q + ((size_t)(m * 4 + s) * 64 + lane) * 16);
                vn[m] = __builtin_amdgcn_mfma_f32_16x16x32_bf16(w, Sb[s], vn[m], 0, 0, 0); o[m] = __builtin_amdgcn_mfma_f32_16x16x32_bf16(qf, Sb[s], o[m], 0, 0, 0); } }
        bf16x8 vb[SC];
#pragma unroll
        for (int s = 0; s < SC; ++s) { u32x4 p; p.x = pk2(vn[2 * s < MT ? 2 * s : 0][0], vn[2 * s < MT ? 2 * s : 0][1]); p.y = pk2(vn[2 * s < MT ? 2 * s : 0][2], vn[2 * s < MT ? 2 * s : 0][3]);
            if (2 * s + 1 < MT) { p.z = pk2(vn[2 * s + 1 < MT ? 2 * s + 1 : 0][0], vn[2 * s + 1 < MT ? 2 * s + 1 : 0][1]); p.w = pk2(vn[2 * s + 1 < MT ? 2 * s + 1 : 0][2], vn[2 * s + 1 < MT ? 2 * s + 1 : 0][3]); } else { p.z = 0u; p.w = 0u; }
            vb[s] = __builtin_bit_cast(bf16x8, p); }
#pragma unroll
        for (int m = 0; m < MT; ++m)
#pragma unroll
            for (int s = 0; s < SC; ++s) { const bf16x8 a = *(const bf16x8*)(frag + FR_A + ((size_t)(m * SC + s) * 64 + lane) * 16); o[m] = __builtin_amdgcn_mfma_f32_16x16x32_bf16(a, vb[s], o[m], 0, 0, 0); }
#pragma unroll
        for (int T = 0; T < 8; ++T) { S[T] *= egl;
#pragma unroll
            for (int s = 0; s < SC; ++s) { const bf16x8 kf = *(const bf16x8*)(frag + FR_K + ((size_t)(T * SC + s) * 64 + lane) * 16); S[T] = __builtin_amdgcn_mfma_f32_16x16x32_bf16(kf, vb[s], S[T], 0, 0, 0); } }
#pragma unroll
        for (int m = 0; m < MT; ++m)
#pragma unroll
            for (int r = 0; r < 4; ++r) { const int c = 16 * m + 4 * q + r; if (c < NVALID) oraw_base[(size_t)(n * C + c) * D + 16 * vs + c16] = (bf16)f2bf(o[m][r]); }
    }
#pragma unroll
    for (int T = 0; T < 8; ++T) { float* sp = Sout + (size_t)(16 * T + 4 * q) * HD + 16 * vs + c16; sp[0] = S[T][0]; sp[HD] = S[T][1]; sp[2 * HD] = S[T][2]; sp[3 * HD] = S[T][3]; }
}

DEVI void p4_prep(Frame& F) {
    constexpr int NC = SEQ / CHUNK;
    for (int u = F.vcu; u < NCHUNK_P; u += F.G) {
        const int n = u % NC, bh = u / NC, h = bh % NH, b = bh / NH;
        delta_prep<CHUNK, CHUNK>(F, F.lds, b * SEQ, n * CHUNK, h, nullptr, F.ws + WS_FRAG + (size_t)u * CHUNK_BYTES);
    }
}

template <bool SAMPLE>
DEVI void s5_job(Frame& F, LAS unsigned char* L  , int row0, int nrows, int g, int b0) {
    const int lane = F.lane, hi = lane >> 5, l31 = lane & 31, q = lane >> 4, c16 = lane & 15;
    LAS float* BUT = (LAS float*)L;
    LAS unsigned* Hs = (LAS unsigned*)(L + 10240);
    const bf16* ub = (const bf16*)(F.ws + WS_UB); bf16* y5 = (bf16*)(F.ws + WS_Y5);
    float are, aim;
    {
        const float lre = fminf(F.in[I_LAMRE][g * NP + lane], -1e-4f), lim = F.in[I_LAMIM][g * NP + lane], dt = f_exp(F.in[I_LOGSTEP][g]);
        const float mag = f_exp(lre * dt), ang = lim * dt; are = mag * f_cos(ang); aim = mag * f_sin(ang);
    }
    bf16x8 bbf[4];
#pragma unroll
    for (int nt = 0; nt < 4; ++nt) { const int pp = 32 * nt + l31, p = pp & 63;
        const float lre = fminf(F.in[I_LAMRE][g * NP + p], -1e-4f), lim = F.in[I_LAMIM][g * NP + p], dt = f_exp(F.in[I_LOGSTEP][g]);
        const float mag = f_exp(lre * dt), ang = lim * dt, nr = mag * f_cos(ang) - 1.f, ni = mag * f_sin(ang), den = lre * lre + lim * lim;
        const float cre = (nr * lre + ni * lim) / den, cim = (ni * lre - nr * lim) / den;
        const float* br = F.in[I_BRE] + ((size_t)g * NP + p) * 16 + 8 * hi; const float* bi = F.in[I_BIM] + ((size_t)g * NP + p) * 16 + 8 * hi; float e[8];
#pragma unroll
        for (int j = 0; j < 8; ++j) e[j] = pp < 64 ? cre * br[j] - cim * bi[j] : cre * bi[j] + cim * br[j];
        u32x4 pk; pk.x = pk2(e[0], e[1]); pk.y = pk2(e[2], e[3]); pk.z = pk2(e[4], e[5]); pk.w = pk2(e[6], e[7]); bbf[nt] = __builtin_bit_cast(bf16x8, pk); }
    bf16x8 ccf[4];
#pragma unroll
    for (int s = 0; s < 4; ++s) { float e[8];
#pragma unroll
        for (int j = 0; j < 8; ++j) { const int p = 16 * s + 4 * q + (j >> 1); e[j] = (j & 1) ? -F.in[I_CIM][((size_t)g * 16 + c16) * NP + p] : F.in[I_CRE][((size_t)g * 16 + c16) * NP + p]; }
        u32x4 pk; pk.x = pk2(e[0], e[1]); pk.y = pk2(e[2], e[3]); pk.z = pk2(e[4], e[5]); pk.w = pk2(e[6], e[7]); ccf[s] = __builtin_bit_cast(bf16x8, pk); }
    const float dsk = F.in[I_DSKIP][g * 16 + c16];
    float hre = 0.f, him = 0.f;
    for (int r0 = 0; r0 < nrows; r0 += 32) {
        const bf16x8 uf = *(const bf16x8*)(ub + (size_t)(row0 + r0 + l31) * MIX_B + g * 16 + 8 * hi);
        f32x16 bu[4];
#pragma unroll
        for (int nt = 0; nt < 4; ++nt) { const f32x16 z = {0.f, 0.f, 0.f, 0.f, 0.f, 0.f, 0.f, 0.f, 0.f, 0.f, 0.f, 0.f, 0.f, 0.f, 0.f, 0.f}; bu[nt] = __builtin_amdgcn_mfma_f32_32x32x16_bf16(uf, bbf[nt], z, 0, 0, 0); }
#pragma unroll
        for (int hf = 0; hf < 2; ++hf) {
            WAVE_LDS_SYNC();
#pragma unroll
            for (int nt = 0; nt < 4; ++nt)
#pragma unroll
                for (int i2 = 0; i2 < 2; ++i2) { const int i = 2 * hf + i2; *(LAS f32x4*)(BUT + (32 * nt + l31) * 20 + 8 * i2 + 4 * hi) = (f32x4){bu[nt][4 * i], bu[nt][4 * i + 1], bu[nt][4 * i + 2], bu[nt][4 * i + 3]}; }
            WAVE_LDS_SYNC();
            float br_[16], bi_[16];
#pragma unroll
            for (int j = 0; j < 4; ++j) { const f32x4 a = *(const LAS f32x4*)(BUT + lane * 20 + 4 * j), b = *(const LAS f32x4*)(BUT + (64 + lane) * 20 + 4 * j);
                br_[4 * j] = a[0]; br_[4 * j + 1] = a[1]; br_[4 * j + 2] = a[2]; br_[4 * j + 3] = a[3]; bi_[4 * j] = b[0]; bi_[4 * j + 1] = b[1]; bi_[4 * j + 2] = b[2]; bi_[4 * j + 3] = b[3]; }
#pragma unroll
            for (int tt = 0; tt < 16; ++tt) {
                if (SAMPLE && (tt & 7) == 0) { const int b = b0 + (r0 + 16 * hf + tt) / 8; hre = F.in[I_SSRE][((size_t)b * NG + g) * NP + lane]; him = F.in[I_SSIM][((size_t)b * NG + g) * NP + lane]; }
                const float nre = are * hre - aim * him + br_[tt], nim = are * him + aim * hre + bi_[tt]; hre = nre; him = nim;
                Hs[tt * 68 + lane] = pk2(hre, him);
                if (SAMPLE && (tt & 7) == 7) { const int b = b0 + (r0 + 16 * hf + tt) / 8; F.out[O_SRES + ((size_t)b * NG + g) * NP + lane] = hre; F.out[O_SIMS + ((size_t)b * NG + g) * NP + lane] = him; }
            }
            WAVE_LDS_SYNC();
            f32x4 y = {0.f, 0.f, 0.f, 0.f};
#pragma unroll
            for (int s = 0; s < 4; ++s) { const bf16x8 a = *(const LAS bf16x8*)(Hs + c16 * 68 + 16 * s + 4 * q); y = __builtin_amdgcn_mfma_f32_16x16x32_bf16(a, ccf[s], y, 0, 0, 0); }
#pragma unroll
            for (int r = 0; r < 4; ++r) { const size_t row = (size_t)(row0 + r0 + 16 * hf + 4 * q + r); const float u = bf2f(ub[row * MIX_B + g * 16 + c16]);
                y5[row * MIX_B + g * 16 + c16] = (bf16)f2bf(geluf_(y[r] + dsk * u)); }
        }
    }
    if (!SAMPLE) { F.out[O_SREP + ((size_t)b0 * NG + g) * NP + lane] = hre; F.out[O_SIMP + ((size_t)b0 * NG + g) * NP + lane] = him; }
}

struct DaFr { f32x4 u; bf16x8 wq[4]; bf16x8 a[2]; bf16x8 k[2]; float egl; };
DEVI void da_load(DaFr& f, const unsigned char* frag, int vs, int m, int role, int T, int lane) {
    f.egl = *(const float*)(frag + FR_SC);
    f.u = (f32x4){0.f, 0.f, 0.f, 0.f};
    if (role == 0) f.u = *(const f32x4*)(frag + FR_U + ((size_t)(vs * 4 + m) * 64 + lane) * 16);
    const unsigned char* wq = frag + (role == 0 ? FR_W : FR_Q);
#pragma unroll
    for (int s = 0; s < 4; ++s) f.wq[s] = *(const bf16x8*)(wq + ((size_t)(m * 4 + s) * 64 + lane) * 16);
#pragma unroll
    for (int s = 0; s < 2; ++s) { f.a[s] = *(const bf16x8*)(frag + FR_A + ((size_t)(m * 2 + s) * 64 + lane) * 16); f.k[s] = *(const bf16x8*)(frag + FR_K + ((size_t)(T * 2 + s) * 64 + lane) * 16); }
}
DEVI void delta_apply8(Frame& F, LAS unsigned char* L, const unsigned char* frag, size_t fstride, int nchunks, float* Sout, bf16* oraw_base, int vs) {
    const int w = F.wave, lane = F.lane, q = lane >> 4, c16 = lane & 15, m = w & 3, role = w >> 2, T = w;
    LAS unsigned char* SbL = L; LAS unsigned char* vbL = L + 4096;
    f32x4 S = {0.f, 0.f, 0.f, 0.f};
    *(LAS u32x2*)(SbL + ((T >> 1) * 64 + lane) * 16 + 8 * (T & 1)) = (u32x2){0u, 0u};
    DaFr cur, nxt; da_load(cur, frag, vs, m, role, T, lane); nxt = cur;
    __syncthreads();
    for (int n = 0; n < nchunks; ++n) {
        if (n + 1 < nchunks) da_load(nxt, frag + (size_t)(n + 1) * fstride, vs, m, role, T, lane);
        f32x4 acc = cur.u;
#pragma unroll
        for (int s = 0; s < 4; ++s) { const bf16x8 sb = *(const LAS bf16x8*)(SbL + (s * 64 + lane) * 16); acc = __builtin_amdgcn_mfma_f32_16x16x32_bf16(cur.wq[s], sb, acc, 0, 0, 0); }
        if (role == 0) *(LAS u32x2*)(vbL + ((m >> 1) * 64 + lane) * 16 + 8 * (m & 1)) = (u32x2){pk2(acc[0], acc[1]), pk2(acc[2], acc[3])};
        __syncthreads();
        bf16x8 vb[2];
#pragma unroll
        for (int s = 0; s < 2; ++s) vb[s] = *(const LAS bf16x8*)(vbL + (s * 64 + lane) * 16);
        if (role == 1) {
#pragma unroll
            for (int s = 0; s < 2; ++s) acc = __builtin_amdgcn_mfma_f32_16x16x32_bf16(cur.a[s], vb[s], acc, 0, 0, 0);
            bf16* op = oraw_base + (size_t)(n * CHUNK + 16 * m + 4 * q) * D + 16 * vs + c16;
            op[0] = (bf16)f2bf(acc[0]); op[D] = (bf16)f2bf(acc[1]); op[2 * D] = (bf16)f2bf(acc[2]); op[3 * D] = (bf16)f2bf(acc[3]);
        }
        S *= cur.egl;
#pragma unroll
        for (int s = 0; s < 2; ++s) S = __builtin_amdgcn_mfma_f32_16x16x32_bf16(cur.k[s], vb[s], S, 0, 0, 0);
        *(LAS u32x2*)(SbL + ((T >> 1) * 64 + lane) * 16 + 8 * (T & 1)) = (u32x2){pk2(S[0], S[1]), pk2(S[2], S[3])};
        __syncthreads();
        cur = nxt;
    }
    float* sp = Sout + (size_t)(16 * T + 4 * q) * HD + 16 * vs + c16; sp[0] = S[0]; sp[HD] = S[1]; sp[2 * HD] = S[2]; sp[3 * HD] = S[3];
}

struct S5C { float are, aim; bf16x8 bbf[4], ccf[4]; float dsk; };
DEVI void s5_consts(S5C& c, const Frame& F, int g, int lane) {
    const int hi = lane >> 5, l31 = lane & 31, q = lane >> 4, c16 = lane & 15;
    { const float lre = fminf(F.in[I_LAMRE][g * NP + lane], -1e-4f), lim = F.in[I_LAMIM][g * NP + lane], dt = f_exp(F.in[I_LOGSTEP][g]);
      const float mag = f_exp(lre * dt), ang = lim * dt; c.are = mag * f_cos(ang); c.aim = mag * f_sin(ang); }
#pragma unroll
    for (int nt = 0; nt < 4; ++nt) { const int pp = 32 * nt + l31, p = pp & 63;
        const float lre = fminf(F.in[I_LAMRE][g * NP + p], -1e-4f), lim = F.in[I_LAMIM][g * NP + p], dt = f_exp(F.in[I_LOGSTEP][g]);
        const float mag = f_exp(lre * dt), ang = lim * dt, nr = mag * f_cos(ang) - 1.f, ni = mag * f_sin(ang), den = lre * lre + lim * lim;
        const float cre = (nr * lre + ni * lim) / den, cim = (ni * lre - nr * lim) / den;
        const float* br = F.in[I_BRE] + ((size_t)g * NP + p) * 16 + 8 * hi; const float* bi = F.in[I_BIM] + ((size_t)g * NP + p) * 16 + 8 * hi; float e[8];
#pragma unroll
        for (int j = 0; j < 8; ++j) e[j] = pp < 64 ? cre * br[j] - cim * bi[j] : cre * bi[j] + cim * br[j];
        u32x4 pk; pk.x = pk2(e[0], e[1]); pk.y = pk2(e[2], e[3]); pk.z = pk2(e[4], e[5]); pk.w = pk2(e[6], e[7]); c.bbf[nt] = __builtin_bit_cast(bf16x8, pk); }
#pragma unroll
    for (int s = 0; s < 4; ++s) { float e[8];
#pragma unroll
        for (int j = 0; j < 8; ++j) { const int p = 16 * s + 4 * q + (j >> 1); e[j] = (j & 1) ? -F.in[I_CIM][((size_t)g * 16 + c16) * NP + p] : F.in[I_CRE][((size_t)g * 16 + c16) * NP + p]; }
        u32x4 pk; pk.x = pk2(e[0], e[1]); pk.y = pk2(e[2], e[3]); pk.z = pk2(e[4], e[5]); pk.w = pk2(e[6], e[7]); c.ccf[s] = __builtin_bit_cast(bf16x8, pk); }
    c.dsk = F.in[I_DSKIP][g * 16 + c16];
}
DEVI void s5_block(Frame& F, LAS unsigned char* L, LAS unsigned char* X, int b, int g) {
    constexpr int NC = SEQ / 32, NSC = (NC + 7) / 8;
    const int lane = F.lane, w = F.wave, hi = lane >> 5, l31 = lane & 31, q = lane >> 4, c16 = lane & 15;
    LAS unsigned char* wl = L + w * 16384;
    LAS float* BUT = (LAS float*)wl; LAS unsigned* Hs = (LAS unsigned*)(wl + 10240); LAS bf16* Us = (LAS bf16*)(wl + 10240 + 4352);
    LAS float* Ex = (LAS float*)X;
    const bf16* ub = (const bf16*)(F.ws + WS_UB); bf16* y5 = (bf16*)(F.ws + WS_Y5);
    S5C c; s5_consts(c, F, g, lane);
    float a32r = c.are, a32i = c.aim;
#pragma unroll
    for (int i = 0; i < 5; ++i) { const float r = a32r * a32r - a32i * a32i, im = 2.f * a32r * a32i; a32r = r; a32i = im; }
    float Hre = 0.f, Him = 0.f;
    for (int sc = 0; sc < NSC; ++sc) {
        const int ch = 8 * sc + w; const bool act = ch < NC; const int row0 = b * SEQ + 32 * ch;
        float br_[32], bi_[32];
        float ere = 0.f, eim = 0.f;
        if (act) {
            const bf16x8 uf = *(const bf16x8*)(ub + (size_t)(row0 + l31) * MIX_B + g * 16 + 8 * hi);
            f32x16 bu[4];
#pragma unroll
            for (int nt = 0; nt < 4; ++nt) { const f32x16 z = {0.f, 0.f, 0.f, 0.f, 0.f, 0.f, 0.f, 0.f, 0.f, 0.f, 0.f, 0.f, 0.f, 0.f, 0.f, 0.f}; bu[nt] = __builtin_amdgcn_mfma_f32_32x32x16_bf16(uf, c.bbf[nt], z, 0, 0, 0); }
            WAVE_LDS_SYNC();
            *(LAS bf16x8*)(Us + l31 * 16 + 8 * hi) = uf;
#pragma unroll
            for (int hf = 0; hf < 2; ++hf) {
                WAVE_LDS_SYNC();
#pragma unroll
                for (int nt = 0; nt < 4; ++nt)
#pragma unroll
                    for (int i2 = 0; i2 < 2; ++i2) { const int i = 2 * hf + i2; *(LAS f32x4*)(BUT + (32 * nt + l31) * 20 + 8 * i2 + 4 * hi) = (f32x4){bu[nt][4 * i], bu[nt][4 * i + 1], bu[nt][4 * i + 2], bu[nt][4 * i + 3]}; }
                WAVE_LDS_SYNC();
#pragma unroll
                for (int j = 0; j < 4; ++j) { const f32x4 x = *(const LAS f32x4*)(BUT + lane * 20 + 4 * j), y = *(const LAS f32x4*)(BUT + (64 + lane) * 20 + 4 * j);
                    br_[16 * hf + 4 * j] = x[0]; br_[16 * hf + 4 * j + 1] = x[1]; br_[16 * hf + 4 * j + 2] = x[2]; br_[16 * hf + 4 * j + 3] = x[3];
                    bi_[16 * hf + 4 * j] = y[0]; bi_[16 * hf + 4 * j + 1] = y[1]; bi_[16 * hf + 4 * j + 2] = y[2]; bi_[16 * hf + 4 * j + 3] = y[3]; }
            }
#pragma unroll
            for (int t = 0; t < 32; ++t) { const float nr = c.are * ere - c.aim * eim + br_[t], ni = c.are * eim + c.aim * ere + bi_[t]; ere = nr; eim = ni; }
        }
        LAS float* Eb = Ex + (sc & 1) * (8 * 64 * 2);
        Eb[(w * 64 + lane) * 2] = ere; Eb[(w * 64 + lane) * 2 + 1] = eim;
        __syncthreads();
        float cre = Hre, cim = Him;
        float hre = 0.f, him = 0.f;
#pragma unroll
        for (int i = 0; i < 8; ++i) { if (i == w) { hre = cre; him = cim; }
            const float e0 = Eb[(i * 64 + lane) * 2], e1 = Eb[(i * 64 + lane) * 2 + 1];
            if (8 * sc + i < NC) { const float nr = a32r * cre - a32i * cim + e0, ni = a32r * cim + a32i * cre + e1; cre = nr; cim = ni; } }
        Hre = cre; Him = cim;
        if (act) {
#pragma unroll
            for (int hf = 0; hf < 2; ++hf) {
                WAVE_LDS_SYNC();
#pragma unroll
                for (int tt = 0; tt < 16; ++tt) { const int t = 16 * hf + tt; const float nr = c.are * hre - c.aim * him + br_[t], ni = c.are * him + c.aim * hre + bi_[t]; hre = nr; him = ni; Hs[tt * 68 + lane] = pk2(hre, him); }
                WAVE_LDS_SYNC();
                f32x4 y = {0.f, 0.f, 0.f, 0.f};
#pragma unroll
                for (int s = 0; s < 4; ++s) { const bf16x8 a = *(const LAS bf16x8*)(Hs + c16 * 68 + 16 * s + 4 * q); y = __builtin_amdgcn_mfma_f32_16x16x32_bf16(a, c.ccf[s], y, 0, 0, 0); }
#pragma unroll
                for (int r = 0; r < 4; ++r) { const int tl = 16 * hf + 4 * q + r; const float u = bf2f(Us[tl * 16 + c16]);
                    y5[(size_t)(row0 + tl) * MIX_B + g * 16 + c16] = (bf16)f2bf(geluf_(y[r] + c.dsk * u)); }
            }
        }
    }
    if (w == 0) { F.out[O_SREP + ((size_t)b * NG + g) * NP + lane] = Hre; F.out[O_SIMP + ((size_t)b * NG + g) * NP + lane] = Him; }
    __syncthreads();
}

constexpr int LDS_X_OFF = RING_BYTES + 256;
DEVI void p5_mix(Frame& F) {
    using OL = PrepLds<16>;
    constexpr int FRAG_OFF = (OL::END + 255) & ~255;
    static_assert(FRAG_OFF + CHUNK_BYTES <= RING_BYTES && LDS_X_OFF + 8192 <= LDS_BYTES, "lds");
    for (int u = F.vcu; u < DEC_BATCH * NH; u += F.G) {
        const int b = u / NH, h = u % NH;
        unsigned char* fr = (unsigned char*)(F.lds + FRAG_OFF);
        delta_prep<16, 8>(F, F.lds, MP + b * DEC_SEQ, 0, h, F.in[I_SCONV] + (size_t)b * 3 * QKV, fr);
        delta_apply<16, 8>(fr, 0, 1, F.in[I_SDELTA] + ((size_t)b * NH + h) * HD * HD, F.out + O_DELS + ((size_t)b * NH + h) * HD * HD,
                           (bf16*)(F.ws + WS_H12) + (size_t)(MP + b * DEC_SEQ) * D + h * HD, F.wave, F.lane);
        __syncthreads();
    }
    for (int j = F.vcu; j < BATCH * NH * 8; j += F.G) { const int vs = j % 8, bh = j / 8, h = bh % NH, b = bh / NH;
        delta_apply8(F, F.lds + LDS_X_OFF, F.ws + WS_FRAG + (size_t)bh * (SEQ / CHUNK) * CHUNK_BYTES, CHUNK_BYTES, SEQ / CHUNK, F.out + O_DELP + (size_t)bh * HD * HD,
                     (bf16*)(F.ws + WS_H12) + (size_t)(b * SEQ) * D + h * HD, vs); }
    for (int j = F.vcu; j < BATCH * NG; j += F.G) s5_block(F, F.lds, F.lds + LDS_X_OFF, j / NG, j % NG);
    constexpr int NJ_SS = (DEC_BATCH / 4) * NG;
    const int gw = F.wave * F.G + F.vcu, NGW = F.G * NWAVES;
    LAS unsigned char* wl = F.lds + F.wave * 16384;
    for (int j = gw; j < NJ_SS; j += NGW) { const int bq = j / NG, g = j % NG; s5_job<true>(F, wl, MP + bq * 32, 32, g, bq * 4); }
}

#ifndef HOST_EMU
#define XB_TMO      128
#define XB_XCNT(j)  (256  + 64 * (j))
#define XB_XSUB(j)  (1280 + 64 * (j))
#define XB_XGEN(j)  (2304 + 64 * (j))
#define XB_TOP      3328
#define XB_TOPGEN   3392
#define XCD_BAR_WORDS 3456
#define XB_SPIN_CAP (1u << 18)
__device__ __forceinline__ unsigned xb_ld(unsigned* p)              { return __hip_atomic_load(p, __ATOMIC_RELAXED, __HIP_MEMORY_SCOPE_AGENT); }
__device__ __forceinline__ unsigned xb_add(unsigned* p, unsigned v) { return __hip_atomic_fetch_add(p, v, __ATOMIC_RELAXED, __HIP_MEMORY_SCOPE_AGENT); }
__device__ __forceinline__ unsigned xb_xcc_id() { return (unsigned)__builtin_amdgcn_s_getreg((3 << 11) | 20) & 0xFu; }
#define XB_SPIN(cond, bar) do { unsigned _sp = 0; while (cond) { __builtin_amdgcn_s_sleep(1); \
    if ((++_sp & 255u) == 0u) { if (xb_ld(&(bar)[XB_TMO])) break; if (_sp > XB_SPIN_CAP) { atomicAdd(&(bar)[XB_TMO], 1u); break; } } } } while (0)
struct XcdBarrier { unsigned* bar; unsigned x; volatile LAS unsigned* st; };
__device__ __forceinline__ XcdBarrier xcd_barrier_post(unsigned* bar, volatile LAS unsigned* st) {
    XcdBarrier b; b.bar = bar; b.x = xb_xcc_id(); b.st = st;
    if (threadIdx.x == 0) (void)xb_add(&bar[XB_XCNT(b.x)], 1u);
    return b;
}
__device__ __forceinline__ void xcd_barrier_complete(unsigned* bar, unsigned x, unsigned& nloc, unsigned& nx) {
    const unsigned G = gridDim.x * gridDim.y * gridDim.z;
    unsigned sum, cnt, mine, sp = 0u;
    for (;;) {
        sum = 0u; cnt = 0u; mine = 0u;
#pragma unroll
        for (unsigned j = 0; j < 16; ++j) { const unsigned c = xb_ld(&bar[XB_XCNT(j)]); sum += c; cnt += (c > 0u) ? 1u : 0u; mine = (j == x) ? c : mine; }
        if (sum == G) break;
        __builtin_amdgcn_s_sleep(1);
        if ((++sp & 255u) == 0u) { if (xb_ld(&bar[XB_TMO])) break; if (sp > XB_SPIN_CAP) { atomicAdd(&bar[XB_TMO], 1u); break; } }
    }
    nloc = mine > 0u ? mine : 1u; nx = cnt > 0u ? cnt : 1u;
}
__device__ __forceinline__ void xcd_barrier(const XcdBarrier& b) {
    asm volatile("s_waitcnt vmcnt(0)" ::: "memory");
    __syncthreads();
    if (threadIdx.x == 0) {
        unsigned* bar = b.bar;
        __builtin_amdgcn_s_waitcnt(0);
        unsigned nloc = b.st[0], nx = b.st[1];
        if (nloc == 0u) { xcd_barrier_complete(bar, b.x, nloc, nx); b.st[0] = nloc; b.st[1] = nx; }
        const unsigned old = xb_add(&bar[XB_XSUB(b.x)], 1u);
        const unsigned gen = old / nloc;
        if (old + 1u == (gen + 1u) * nloc) {
            __builtin_amdgcn_fence(__ATOMIC_RELEASE, "agent");
            asm volatile("s_waitcnt vmcnt(0)" ::: "memory");
            const unsigned og = xb_add(&bar[XB_TOP], 1u);
            const unsigned tg = og / nx;
            if (og + 1u == (tg + 1u) * nx) xb_add(&bar[XB_TOPGEN], 1u);
            else XB_SPIN(xb_ld(&bar[XB_TOPGEN]) == tg, bar);
            __builtin_amdgcn_fence(__ATOMIC_ACQUIRE, "agent");
            xb_add(&bar[XB_XGEN(b.x)], 1u);
            asm volatile("s_waitcnt vmcnt(0)" ::: "memory");
        } else {
            XB_SPIN(xb_ld(&bar[XB_XGEN(b.x)]) == gen, bar);
            __builtin_amdgcn_fence(__ATOMIC_ACQUIRE, "agent");
            asm volatile("s_waitcnt vmcnt(0)" ::: "memory");
        }
    }
    __syncthreads();
}
#endif

constexpr int NPHASE = 12;
#ifndef MK_COOP
#define MK_COOP 1
#endif
#ifndef MK_XCDBAR
#define MK_XCDBAR 1
#endif
constexpr int CTL_BAR_WORD = 1024;
constexpr int LDS_ST_OFF = RING_BYTES;
__global__ void __launch_bounds__(NTHREADS, 2) fwd_kernel(Args args) {
#ifdef HOST_EMU
    unsigned char* lds = emu_lds();
#else
    extern __shared__ __attribute__((aligned(16))) unsigned char lds[];
#endif
    Frame F; F.lds = (LAS unsigned char*)lds; F.in = args.in; F.out = args.out; F.ws = args.ws;
    F.tid = threadIdx.x; F.lane = F.tid & 63; F.wave = __builtin_amdgcn_readfirstlane(F.tid >> 6);
    F.G = gridDim.x; { const int bx = blockIdx.x; F.vcu = (F.G % 8 == 0) ? (bx % 8) * (F.G / 8) + bx / 8 : bx; }
    const int lo = args.ph_lo, hi = args.ph_hi;
#ifdef HOST_EMU
#define GRID_SYNC() emu_grid_sync()
#elif MK_COOP && MK_XCDBAR
    cg::grid_group grid = cg::this_grid();
    if (F.tid < 2) ((LAS unsigned*)(F.lds + LDS_ST_OFF))[F.tid] = 0u;
    __syncthreads();
    const XcdBarrier xbar = xcd_barrier_post((unsigned*)(F.ws + WS_CTL) + CTL_BAR_WORD, (volatile LAS unsigned*)(F.lds + LDS_ST_OFF));
    if (args.ph_lo < 0) grid.sync();
#define GRID_SYNC() xcd_barrier(xbar)
#elif MK_COOP
    cg::grid_group grid = cg::this_grid();
#define GRID_SYNC() grid.sync()
#else
#define GRID_SYNC() do {} while (0)
#endif
#ifndef PHASE_MASK
#define PHASE_MASK 0xFFFF
#endif
#define IN(k) ((((PHASE_MASK) >> (k)) & 1) && lo <= (k) && (k) < hi)
#ifndef REPEAT_MASK
#define REPEAT_MASK 0x0
#endif
#define REP(k) ((((REPEAT_MASK) >> (k)) & 1) ? 2 : 1)
#define SEAM(k) do { if (IN(k) && IN((k) + 1)) GRID_SYNC(); } while (0)
    using namespace pg8;
    if (IN(0)) { for (int rep = 0; rep < REP(0); ++rep) { p0_prologue(F); if (rep + 1 < REP(0)) GRID_SYNC(); } } SEAM(0);
    if (IN(1)) { for (int rep = 0; rep < REP(1); ++rep) { p1_ada(F); if (rep + 1 < REP(1)) GRID_SYNC(); } } SEAM(1);
    if (IN(2)) { for (int rep = 0; rep < REP(2); ++rep) { p2_h1(F); if (rep + 1 < REP(2)) GRID_SYNC(); } } SEAM(2);
    if (IN(3)) {
        Gemm g{(const bf16*)(F.ws + WS_H12), (const bf16*)(F.ws + WS_WIN), M, NIN, D}; StaticOrder S; S.init(M, NIN, F.G, (int)blockIdx.x);
        EpiInProj E{0, (bf16*)(F.ws + WS_QKVB), (bf16*)(F.ws + WS_ZB), (bf16*)(F.ws + WS_UB), (float*)(F.ws + WS_AB), F.out + O_CONVP, F.out + O_CONVS};
        gemm_phase<EpiInProj, true, true>(F.lds, g, S, E);
    } SEAM(3);
    if (IN(4)) { for (int rep = 0; rep < REP(4); ++rep) { p4_prep(F); if (rep + 1 < REP(4)) GRID_SYNC(); } } SEAM(4);
    if (IN(5)) { for (int rep = 0; rep < REP(5); ++rep) { p5_mix(F); if (rep + 1 < REP(5)) GRID_SYNC(); } } SEAM(5);
    if (IN(6)) {
        p6_onorm(F);
        Gemm g{(const bf16*)(F.ws + WS_Y5), (const bf16*)(F.ws + WS_WGLU), M, 2 * MIX_B, MIX_B}; StaticOrder S; S.init(M, 2 * MIX_B, F.G, (int)blockIdx.x);
        EpiGlu E{0, (bf16*)(F.ws + WS_ACAT), (unsigned long long*)(F.ws + WS_CTL + CTL_RS5)};
        gemm_phase<EpiGlu, true, true>(F.lds, g, S, E);
    } SEAM(6);
    if (IN(7)) {
        Gemm g{(const bf16*)(F.ws + WS_ACAT), (const bf16*)(F.ws + WS_WOUT), M, D, D}; StaticOrder S; S.init(M, D, F.G, (int)blockIdx.x);
        EpiF32Rs<true> E{MIX_B / 64, (float*)(F.ws + WS_MIX), (const unsigned long long*)(F.ws + WS_CTL + CTL_RS5)};
        gemm_phase<EpiF32Rs<true>, true, true>(F.lds, g, S, E);
    } SEAM(7);
    if (IN(8)) { p8_x1h2(F); } SEAM(8);
    if (IN(9)) {
        Gemm g{(const bf16*)(F.ws + WS_H12), (const bf16*)(F.ws + WS_WGU), M, 2 * D_FF, D}; StaticOrder S; S.init(M, 2 * D_FF, F.G, (int)blockIdx.x);
        EpiSwiglu E{0, (bf16*)(F.ws + WS_HMID)};
        gemm_phase<EpiSwiglu, true, true>(F.lds, g, S, E);
    } SEAM(9);
    if (IN(10)) {
        Gemm g{(const bf16*)(F.ws + WS_HMID), (const bf16*)(F.ws + WS_WDN), M, D, D_FF}; StaticOrder S; S.init(M, D, F.G, (int)blockIdx.x);
        EpiF32Rs<false> E{0, (float*)(F.ws + WS_F), nullptr};
        gemm_phase<EpiF32Rs<false>, true, true>(F.lds, g, S, E);
    } SEAM(10);
    if (IN(11)) { for (int rep = 0; rep < REP(11); ++rep) { p11_out(F); if (rep + 1 < REP(11)) GRID_SYNC(); } }
#undef IN
#undef SEAM
}

#ifndef HOST_EMU
extern "C" void kernel_launch(void* const* d_in, const int* in_sizes, int n_in, void* d_out, int out_size, void* d_ws, size_t ws_size, hipStream_t stream) {
    static int grid = 0;
    if (grid == 0) {
        if (n_in != N_IN || (size_t)out_size != O_END || ws_size < WS_END) { fprintf(stderr, "kernel_launch: unexpected sizes n_in %d out %d ws %zu (need %zu)\n", n_in, out_size, ws_size, (size_t)WS_END); grid = -1; return; }
        int dev = 0, cus = 0, per_cu = 0;
        hipGetDevice(&dev); hipDeviceGetAttribute(&cus, hipDeviceAttributeMultiprocessorCount, dev);
        hipFuncSetAttribute((const void*)fwd_kernel, hipFuncAttributeMaxDynamicSharedMemorySize, LDS_BYTES);
        hipOccupancyMaxActiveBlocksPerMultiprocessor(&per_cu, (const void*)fwd_kernel, NTHREADS, LDS_BYTES);
        if (per_cu < 1) { fprintf(stderr, "kernel_launch: occupancy query says %d blocks per CU\n", per_cu); per_cu = 1; }
        grid = cus * 1;
        (void)hipGetLastError();
    }
    if (grid < 0) return;
    hipMemsetAsync((char*)d_ws + WS_CTL, 0, CTL_BYTES, stream);
    Args a{};
    for (int i = 0; i < N_IN; ++i) a.in[i] = (const float*)d_in[i];
    a.out = (float*)d_out; a.ws = (unsigned char*)d_ws;
#if MK_COOP
    a.ph_lo = 0; a.ph_hi = NPHASE;
    void* params[] = {&a};
    hipError_t e = hipLaunchCooperativeKernel((const void*)fwd_kernel, dim3(grid), dim3(NTHREADS), params, LDS_BYTES, stream);
    if (e != hipSuccess) fprintf(stderr, "cooperative launch failed: %s\n", hipGetErrorString(e));
#else
    for (int p = 0; p < NPHASE; ++p) { a.ph_lo = p; a.ph_hi = p + 1; hipLaunchKernelGGL(fwd_kernel, dim3(grid), dim3(NTHREADS), LDS_BYTES, stream, a); }
#endif
}
#endif
```

```cpp
#ifndef HOST_EMU
#include <hip/hip_runtime.h>
#include <hip/hip_cooperative_groups.h>
#endif
#include <cstdio>
#include <cstdint>
#include <cmath>

#ifndef TS_PHASE
#define TS_PHASE -1
#endif
#ifdef HOST_EMU
#ifndef EMU_BATCH
#define EMU_BATCH 2
#define EMU_SEQ 128
#endif
constexpr int D_MODEL = 512, BATCH = EMU_BATCH, SEQ = EMU_SEQ, DEC_BATCH = 32, DEC_SEQ = 8;
#else
constexpr int D_MODEL = 2048, BATCH = 4, SEQ = 2048, DEC_BATCH = 128, DEC_SEQ = 8;
#endif
constexpr int D = D_MODEL, MIX_A = D / 2, MIX_B = D - MIX_A, HD = 128, NH = MIX_A / HD, CHUNK = 64, NG = MIX_B / 16, NP = 64;
constexpr int QKV = 3 * MIX_A, PROJ = QKV + MIX_A + 2 * NH + MIX_B;
constexpr int D_FF = ((8 * D + 767) / 768) * 256;
constexpr int MP = BATCH * SEQ, MS = DEC_BATCH * DEC_SEQ, M = MP + MS, NB = BATCH + DEC_BATCH;
constexpr int NIN = QKV + MIX_A + MIX_B + 256;
constexpr int NT_QKV = QKV / 256, NT_Z = MIX_A / 256, NT_U = MIX_B / 256;
constexpr float EPS = 1e-6f;
static_assert(MP % 256 == 0 && MS % 256 == 0 && D % 256 == 0 && QKV % 256 == 0 && MIX_A % 256 == 0 && D_FF % 128 == 0 && 2 * NH <= 16, "shape");
static_assert(MIX_A == MIX_B && SEQ % CHUNK == 0 && DEC_SEQ == 8 && DEC_BATCH % 4 == 0, "shape");

#ifdef HOST_EMU
#define LAS
#define GAS
#define DEVI inline
#define WAIT_VM(n)
#define WAIT_LGKM(n)
#define CFENCE()
#define WAVE_LDS_SYNC() emu_wave_sync()
#define LDS_BARRIER() emu_block_barrier()
DEVI float f_exp(float x) { return expf(x); }
DEVI float f_rsqrt(float x) { return 1.0f / sqrtf(x); }
DEVI float f_sin(float x) { return sinf(x); }
DEVI float f_cos(float x) { return cosf(x); }
DEVI float f_rcp(float x) { return 1.0f / x; }
#else
#define LAS __attribute__((address_space(3)))
#define GAS __attribute__((address_space(1)))
#define DEVI __device__ __forceinline__
#define WAIT_VM(n) asm volatile("s_waitcnt vmcnt(" #n ")" ::: "memory")
#define WAIT_LGKM(n) asm volatile("s_waitcnt lgkmcnt(" #n ")" ::: "memory")
#define CFENCE() asm volatile("" ::: "memory")
#define WAVE_LDS_SYNC() asm volatile("s_waitcnt lgkmcnt(0)" ::: "memory")
#define LDS_BARRIER() do { asm volatile("s_waitcnt lgkmcnt(0)" ::: "memory"); __builtin_amdgcn_s_barrier(); asm volatile("" ::: "memory"); } while (0)
DEVI float f_exp(float x) { return __expf(x); }
DEVI float f_rsqrt(float x) { return rsqrtf(x); }
DEVI float f_sin(float x) { return sinf(x); }
DEVI float f_cos(float x) { return cosf(x); }
DEVI float f_rcp(float x) { return __builtin_amdgcn_rcpf(x); }
namespace cg = cooperative_groups;
#endif

typedef unsigned short bf16;
typedef short bf16x8 __attribute__((ext_vector_type(8)));
typedef float f32x4 __attribute__((ext_vector_type(4)));
typedef float f32x16 __attribute__((ext_vector_type(16)));
typedef unsigned u32x4 __attribute__((ext_vector_type(4)));
typedef unsigned u32x2 __attribute__((ext_vector_type(2)));

DEVI unsigned f2bf(float f) { unsigned u = __builtin_bit_cast(unsigned, f); return (u + 0x7fffu + ((u >> 16) & 1u)) >> 16; }
DEVI float bf2f(unsigned h) { return __builtin_bit_cast(float, (h & 0xffffu) << 16); }
typedef float f32x2_ __attribute__((ext_vector_type(2)));
typedef float f32x3_ __attribute__((ext_vector_type(3)));
#ifdef HOST_EMU
static inline f32x3_ ld3f(const void* p) { const float* f = (const float*)p; f32x3_ v; v.x = f[0]; v.y = f[1]; v.z = f[2]; return v; }
#else
__device__ __forceinline__ f32x3_ ld3f(const void* p) { return *(const f32x3_*)p; }
#endif
#ifndef HOST_EMU
typedef __bf16 bf16x2_ __attribute__((ext_vector_type(2)));
#endif
DEVI unsigned pk2(float lo, float hi) {
#ifdef HOST_EMU
    return f2bf(lo) | (f2bf(hi) << 16);
#else
    const f32x2_ v = {lo, hi}; return __builtin_bit_cast(unsigned, __builtin_convertvector(v, bf16x2_));
#endif
}
DEVI float sigmoidf_(float x) { return f_rcp(1.0f + f_exp(-x)); }
DEVI float siluf_(float x) { return x * sigmoidf_(x); }
DEVI float geluf_(float x) { const float u = 0.7978845608028654f * (x + 0.044715f * x * x * x); const float e = f_exp(2.0f * u); return 0.5f * x * (2.0f - 2.0f * f_rcp(e + 1.0f)); }
DEVI float wave_sum(float v) {
#pragma unroll
    for (int o = 1; o < 64; o <<= 1) v += __shfl_xor(v, o);
    return v;
}

namespace pg8 {
constexpr int BM = 256, BK = 64, HALF = 128, HTB = HALF * BK * 2, STAGE_BYTES = 8 * HTB, NXCD = 8, WGM = 8;
DEVI int lds_byte(int r, int c) { const int st = (r >> 4) * 2 + (c >> 5), rr = r & 15, cc = c & 31, ob = rr * 64 + cc * 2; return st * 1024 + (ob ^ (((ob >> 9) & 1) << 5)); }
DEVI void stage_rc(int b, int& R, int& C) { const int st = b / 1024, sb = b % 1024, swz = sb ^ (((sb >> 9) & 1) << 5); R = (st >> 1) * 16 + swz / 64; C = (st & 1) * 32 + (swz % 64) / 2; }
DEVI int perm32(int rho) { const int n = rho >> 4, i = rho & 15; return 8 * (i >> 2) + 4 * n + (i & 3); }
struct Unit { int pm, pn, kt0, kt1, ks; bool ok; };
struct Gemm { const bf16* A; const bf16* Bt; int M, N, K; };
struct StaticOrder {
    int nM, nN, nwg, G, c, ntk;
    DEVI void init(int M_, int N_, int K_, int G_, int c_) { nM = M_ / BM; nN = N_ / BM; nwg = nM * nN; G = G_; c = c_; ntk = K_ / BK; }
    DEVI Unit at(long L) const {
        Unit u; u.pm = 0; u.pn = 0; u.kt0 = 0; u.kt1 = ntk; u.ks = -1; u.ok = L < nwg;
        if (u.ok) {
            int wgid = (int)L; { const int q = nwg / NXCD, r = nwg % NXCD, xcd = wgid % NXCD, off = wgid / NXCD; wgid = (xcd < r ? xcd * (q + 1) : r * (q + 1) + (xcd - r) * q) + off; }
            const int nig = WGM * nN, gid = wgid / nig, fm = gid * WGM, gsz = (nM - fm) < WGM ? (nM - fm) : WGM;
            u.pm = fm + ((wgid % nig) % gsz); u.pn = (wgid % nig) / gsz; }
        return u;
    }
    DEVI Unit next(int i) const { return at((long)i * G + c); }
};
struct SplitOrder {
    StaticOrder full; int nfi, ntail, KS, mt0, nN, G, c, ntk;
    DEVI void init(int M_full, int M_, int N_, int K_, int KS_, int G_, int c_) { full.init(M_full, N_, K_, G_, c_); G = G_; c = c_; nN = N_ / BM; ntk = K_ / BK; KS = KS_; mt0 = M_full / BM; ntail = (M_ - M_full) / BM * nN;
        nfi = c < full.nwg ? (full.nwg - c + G - 1) / G : 0; }
    DEVI Unit next(int i) const {
        if (i < nfi) return full.next(i);
        Unit u; const long L = (long)(i - nfi) * G + c; u.ok = L < (long)ntail * KS;
        const int tu = (int)(L / KS), ks = (int)(L % KS), pairs = ntk / 2;
        u.pm = mt0 + tu / nN; u.pn = tu % nN; u.ks = ks; u.kt0 = 2 * ((pairs * ks) / KS); u.kt1 = 2 * ((pairs * (ks + 1)) / KS); return u;
    }
};
template <class Epi, class Sched, bool ALIGN_EPI, bool SP2>
DEVI void gemm_phase(LAS unsigned char* lds, const Gemm g, const Sched& S, const Epi& E) {
    const int tid = threadIdx.x, wid = __builtin_amdgcn_readfirstlane(tid >> 6), lane = tid & 63, wr = wid >> 2, wc = wid & 3, fr = lane & 15, fq = lane >> 4;
    const int K = g.K;
    unsigned voffA[2], voffB[2];
#pragma unroll
    for (int i = 0; i < 2; ++i) { int R, C; stage_rc(tid * 16 + i * 8192, R, C); const int Rb = Epi::PERM ? ((R & ~31) + perm32(R & 31)) : R;
        voffA[i] = (unsigned)(R * K + C) * 2u; voffB[i] = (unsigned)(Rb * K + C) * 2u; }
    const size_t kstep = (size_t)(BK * 2);
    const size_t hstep = (size_t)HALF * K * 2;
    const size_t tstep = 2 * hstep;
    const unsigned ldsw = (unsigned)wid * 1024u;
    const int aoff = lds_byte(wr * 64 + fr, fq * 8), boff = lds_byte(wc * 32 + fr, fq * 8);
#define PG8_SA(b, h) (((b) * 2 + (h)) * HTB)
#define PG8_SB(b, h) ((4 + (b) * 2 + (h)) * HTB)
#define PG8_STAGE(bufoff, gbase, voff) do { _Pragma("unroll") for (int _i = 0; _i < 2; ++_i) \
        __builtin_amdgcn_global_load_lds((const unsigned*)((const char*)(gbase) + (voff)[_i]), (LAS unsigned*)(lds + (bufoff) + ldsw + _i * 8192), 16, 0, 0); } while (0)
#define PG8_LDA(dst, b, h) do { _Pragma("unroll") for (int m = 0; m < 4; ++m) _Pragma("unroll") for (int k = 0; k < 2; ++k) dst[m][k] = *(const LAS bf16x8*)(lds + PG8_SA(b, h) + aoff + m * 2048 + k * 1024); } while (0)
#define PG8_LDB(dst, b, h) do { _Pragma("unroll") for (int n = 0; n < 2; ++n) _Pragma("unroll") for (int k = 0; k < 2; ++k) dst[n][k] = *(const LAS bf16x8*)(lds + PG8_SB(b, h) + boff + n * 2048 + k * 1024); } while (0)
#define PG8_MMA(ai, bj, At, Bt) do { __builtin_amdgcn_s_setprio(1); _Pragma("unroll") for (int m = 0; m < 4; ++m) _Pragma("unroll") for (int n = 0; n < 2; ++n) _Pragma("unroll") for (int k = 0; k < 2; ++k) \
        acc[ai][bj][m][n] = __builtin_amdgcn_mfma_f32_16x16x32_bf16(Bt[n][k], At[m][k], acc[ai][bj][m][n], 0, 0, 0); __builtin_amdgcn_s_setprio(0); } while (0)
#define PG8_WAIT_V(n) WAIT_VM(n)
#define PG8_WAIT_L(n) WAIT_LGKM(n)
#define PG8_BAR __builtin_amdgcn_s_barrier()
#define PG8_SCHED __builtin_amdgcn_sched_barrier(0)
    Unit cur = S.next(0), nxt = cur; int ui = 0;
    if (!cur.ok) return;
    f32x4 acc[2][2][4][2];
#pragma unroll
    for (int a = 0; a < 2; ++a)
#pragma unroll
        for (int b = 0; b < 2; ++b)
#pragma unroll
            for (int m = 0; m < 4; ++m)
#pragma unroll
                for (int n = 0; n < 2; ++n) acc[a][b][m][n] = (f32x4){0.f, 0.f, 0.f, 0.f};
    bf16x8 At[4][2], B0[2][2], B1[2][2];
    const char* cA = (const char*)g.A + (size_t)cur.pm * tstep; const char* cB = (const char*)g.Bt + (size_t)cur.pn * tstep;
    { const char* pA = cA; const char* pB = cB; cA += (size_t)cur.kt0 * kstep; cB += (size_t)cur.kt0 * kstep;
    if constexpr (SP2) {
        PG8_STAGE(PG8_SB(0, 0), cB, voffB); PG8_STAGE(PG8_SB(0, 1), cB + hstep, voffB); PG8_STAGE(PG8_SA(0, 0), cA, voffA); PG8_STAGE(PG8_SA(0, 1), cA + hstep, voffA);
        if (wr == 1) PG8_BAR;
        PG8_WAIT_V(2); PG8_BAR;
        PG8_STAGE(PG8_SB(1, 0), cB + kstep, voffB); PG8_STAGE(PG8_SA(1, 0), cA + kstep, voffA); PG8_STAGE(PG8_SB(1, 1), cB + hstep + kstep, voffB);
        PG8_WAIT_V(6); PG8_BAR;
    } else {
        PG8_STAGE(PG8_SB(0, 0), cB, voffB); PG8_STAGE(PG8_SA(0, 0), cA, voffA); PG8_STAGE(PG8_SB(0, 1), cB + hstep, voffB); PG8_STAGE(PG8_SA(0, 1), cA + hstep, voffA);
        if (wr == 1) PG8_BAR;
        PG8_WAIT_V(4); PG8_BAR;
        PG8_STAGE(PG8_SB(1, 0), cB + kstep, voffB); PG8_STAGE(PG8_SA(1, 0), cA + kstep, voffA); PG8_STAGE(PG8_SB(1, 1), cB + hstep + kstep, voffB);
        PG8_WAIT_V(6); PG8_BAR;
    }
    cA = pA; cB = pB; }
    for (;;) {
        nxt = S.next(ui + 1); const bool has_next = nxt.ok;
        const char* nA0 = has_next ? (const char*)g.A + (size_t)nxt.pm * tstep : cA; const char* nB0 = has_next ? (const char*)g.Bt + (size_t)nxt.pn * tstep : cB;
        const size_t nko = (size_t)(has_next ? nxt.kt0 : cur.kt0) * kstep; const char* nA = nA0 + nko; const char* nB = nB0 + nko; const int kt1 = cur.kt1;
#define PG8_KBODY \
            const bool last = (t == kt1 - 2); \
            const char* a1 = cA + (size_t)(t + 1) * kstep; \
            const char* a2 = last ? nA : cA + (size_t)(t + 2) * kstep; const char* b2 = last ? nB : cB + (size_t)(t + 2) * kstep; \
            const char* a3 = a2 + kstep; const char* b3 = b2 + kstep; \
            if constexpr (SP2) { \
            PG8_LDB(B0, 0, 0); PG8_LDB(B1, 0, 1); PG8_SCHED; PG8_LDA(At, 0, 0); PG8_STAGE(PG8_SA(1, 1), a1 + hstep, voffA); \
            PG8_WAIT_V(8); PG8_WAIT_L(0); PG8_BAR; PG8_MMA(0, 0, At, B0); PG8_MMA(0, 1, At, B1); PG8_BAR; PG8_SCHED; \
            PG8_LDA(At, 0, 1); PG8_STAGE(PG8_SB(0, 0), b2, voffB); PG8_STAGE(PG8_SB(0, 1), b2 + hstep, voffB); PG8_STAGE(PG8_SA(0, 0), a2, voffA); \
            PG8_WAIT_V(8); PG8_WAIT_L(0); PG8_BAR; PG8_MMA(1, 0, At, B0); PG8_MMA(1, 1, At, B1); PG8_BAR; PG8_SCHED; \
            PG8_LDB(B0, 1, 0); PG8_LDB(B1, 1, 1); PG8_SCHED; PG8_LDA(At, 1, 0); PG8_STAGE(PG8_SA(0, 1), a2 + hstep, voffA); \
            PG8_WAIT_V(8); PG8_WAIT_L(0); PG8_BAR; PG8_MMA(0, 0, At, B0); PG8_MMA(0, 1, At, B1); PG8_BAR; PG8_SCHED; \
            PG8_LDA(At, 1, 1); PG8_STAGE(PG8_SB(1, 0), b3, voffB); PG8_STAGE(PG8_SB(1, 1), b3 + hstep, voffB); PG8_STAGE(PG8_SA(1, 0), a3, voffA); \
            PG8_WAIT_V(8); PG8_WAIT_L(0); PG8_BAR; PG8_MMA(1, 0, At, B0); PG8_MMA(1, 1, At, B1); PG8_BAR; PG8_SCHED; \
            } else { \
            PG8_LDB(B0, 0, 0); PG8_SCHED; PG8_LDA(At, 0, 0); PG8_STAGE(PG8_SA(1, 1), a1 + hstep, voffA); \
            PG8_WAIT_L(8); PG8_BAR; PG8_WAIT_L(0); PG8_MMA(0, 0, At, B0); PG8_BAR; PG8_SCHED; \
            PG8_LDB(B1, 0, 1); PG8_STAGE(PG8_SB(0, 0), b2, voffB); \
            PG8_BAR; PG8_WAIT_L(0); PG8_MMA(0, 1, At, B1); PG8_BAR; \
            PG8_LDA(At, 0, 1); PG8_STAGE(PG8_SA(0, 0), a2, voffA); \
            PG8_BAR; PG8_WAIT_L(0); PG8_MMA(1, 0, At, B0); PG8_BAR; PG8_SCHED; \
            PG8_STAGE(PG8_SB(0, 1), b2 + hstep, voffB); \
            PG8_WAIT_V(6); PG8_BAR; PG8_MMA(1, 1, At, B1); PG8_BAR; \
            PG8_LDB(B0, 1, 0); PG8_SCHED; PG8_LDA(At, 1, 0); PG8_STAGE(PG8_SA(0, 1), a2 + hstep, voffA); \
            PG8_WAIT_L(8); PG8_BAR; PG8_WAIT_L(0); PG8_MMA(0, 0, At, B0); PG8_BAR; PG8_SCHED; \
            PG8_LDB(B1, 1, 1); PG8_STAGE(PG8_SB(1, 0), b3, voffB); \
            PG8_BAR; PG8_WAIT_L(0); PG8_MMA(0, 1, At, B1); PG8_BAR; \
            PG8_LDA(At, 1, 1); PG8_STAGE(PG8_SA(1, 0), a3, voffA); \
            PG8_BAR; PG8_WAIT_L(0); PG8_MMA(1, 0, At, B0); PG8_BAR; PG8_SCHED; \
            PG8_STAGE(PG8_SB(1, 1), b3 + hstep, voffB); \
            PG8_WAIT_V(6); PG8_BAR; PG8_MMA(1, 1, At, B1); PG8_BAR; \
            } \
         \

        if constexpr (Epi::HAS_MID) {
            const int e1 = kt1 < E.tmid ? kt1 : E.tmid, b2 = cur.kt0 > E.tmid ? cur.kt0 : E.tmid;
            for (int t = cur.kt0; t < e1; t += 2) { PG8_KBODY }
            if (cur.kt0 < E.tmid) E.mid(acc, cur, wr, fr);
            for (int t = b2; t < kt1; t += 2) { PG8_KBODY }
        } else {
            for (int t = cur.kt0; t < kt1; t += 2) { PG8_KBODY }
        }
#undef PG8_KBODY
        if constexpr (ALIGN_EPI) { if (wr == 0) PG8_BAR; }
        E(acc, cur, wr, wc, fr, fq);
        if (!has_next) break;
#pragma unroll
        for (int a = 0; a < 2; ++a)
#pragma unroll
            for (int b = 0; b < 2; ++b)
#pragma unroll
                for (int m = 0; m < 4; ++m)
#pragma unroll
                    for (int n = 0; n < 2; ++n) acc[a][b][m][n] = (f32x4){0.f, 0.f, 0.f, 0.f};
        cur = nxt; cA = nA0; cB = nB0; ++ui;
        if constexpr (ALIGN_EPI) { if (wr == 1) PG8_BAR; }
    }
    PG8_WAIT_V(0);
    if constexpr (!ALIGN_EPI) { if (wr == 0) PG8_BAR; }
    PG8_BAR;
#undef PG8_SA
#undef PG8_SB
#undef PG8_STAGE
#undef PG8_LDA
#undef PG8_LDB
#undef PG8_MMA
#undef PG8_WAIT_V
#undef PG8_WAIT_L
#undef PG8_BAR
#undef PG8_SCHED
}
}

constexpr size_t al256(size_t x) { return (x + 255) & ~(size_t)255; }
constexpr size_t WS_CTL = 0, CTL_BYTES = 1u << 20;
constexpr size_t CTL_RS5 = 65536;
static_assert(CTL_RS5 + (size_t)M * 16 <= CTL_BYTES, "ctl");
constexpr size_t CTL_USED = CTL_RS5 + (size_t)M * 16;
constexpr float FX_SCALE = 4294967296.0f, FX_INV = 1.0f / 4294967296.0f;
constexpr size_t WS_WIN = WS_CTL + CTL_BYTES;
constexpr size_t WS_WGLU = WS_WIN + al256((size_t)NIN * D * 2);
constexpr size_t WS_WOUT = WS_WGLU + al256((size_t)2 * MIX_B * MIX_B * 2);
constexpr size_t WS_WGU = WS_WOUT + al256((size_t)D * D * 2);
constexpr size_t WS_WDN = WS_WGU + al256((size_t)2 * D_FF * D * 2);
constexpr size_t WS_ASILU = WS_WDN + al256((size_t)D * D_FF * 2);
constexpr size_t WS_MOD = WS_ASILU + al256((size_t)256 * D * 2);
constexpr size_t WS_RM = WS_MOD + al256((size_t)NB * 6 * D * 4);
constexpr size_t WS_AB = WS_RM + al256((size_t)M * 4);
constexpr size_t WS_H12 = WS_AB + al256((size_t)M * 16 * 4);
constexpr size_t WS_ACAT = WS_H12 + al256((size_t)M * D * 2);
constexpr size_t WS_F = WS_H12;
constexpr size_t WS_QKVB = WS_ACAT + al256((size_t)M * D * 2);
constexpr size_t WS_ZB = WS_QKVB + al256((size_t)M * QKV * 2);
constexpr size_t WS_UB = WS_ZB + al256((size_t)M * MIX_A * 2);
constexpr size_t WS_Y5 = WS_UB + al256((size_t)M * MIX_B * 2);
constexpr int KS_OUT = (D / 64 / 2) < 8 ? (D / 64 / 2) : 8, KS_DN = (D_FF / 64 / 2) < 8 ? (D_FF / 64 / 2) : 8;
constexpr size_t WS_HMID = WS_QKVB;
constexpr size_t WS_MIX = WS_Y5 + al256((size_t)M * MIX_B * 2);
static_assert(WS_ACAT == WS_H12 + (size_t)M * D * 2 && WS_MIX - WS_QKVB >= (size_t)M * D_FF * 2, "overlay");
constexpr int FR_U = 0, FR_W = 32768, FR_Q = FR_W + 16384, FR_A = FR_Q + 16384, FR_K = FR_A + 8192, FR_SC = FR_K + 16384, CHUNK_BYTES = FR_SC + 256;
constexpr int NCHUNK_P = BATCH * NH * (SEQ / CHUNK);
constexpr size_t WS_FRAG = WS_MIX;
constexpr size_t FRAG_TOTAL = (size_t)NCHUNK_P * CHUNK_BYTES;
constexpr size_t WS_END0 = WS_MIX + (FRAG_TOTAL > (size_t)M * D * 4 ? FRAG_TOTAL : (size_t)M * D * 4);
#ifdef HOST_EMU
constexpr size_t WS_MIXS = WS_END0, WS_FS = WS_MIXS + (size_t)KS_OUT * MS * D * 2, WS_END = WS_FS + (size_t)KS_DN * MS * D * 2;
#else
constexpr size_t WS_MIXS = WS_QKVB;
constexpr size_t WS_FS = WS_WIN;
constexpr size_t WS_END = WS_END0;
static_assert(WS_MIX - WS_QKVB >= (size_t)KS_OUT * MS * D * 2 && WS_WDN - WS_WIN >= (size_t)KS_DN * MS * D * 2, "slab overlay");
#endif

constexpr size_t O_YP = 0, O_YS = O_YP + (size_t)MP * D, O_CONVP = O_YS + (size_t)MS * D, O_DELP = O_CONVP + (size_t)BATCH * 3 * QKV,
                 O_SREP = O_DELP + (size_t)BATCH * NH * HD * HD, O_SIMP = O_SREP + (size_t)BATCH * NG * NP, O_CONVS = O_SIMP + (size_t)BATCH * NG * NP,
                 O_DELS = O_CONVS + (size_t)DEC_BATCH * 3 * QKV, O_SRES = O_DELS + (size_t)DEC_BATCH * NH * HD * HD, O_SIMS = O_SRES + (size_t)DEC_BATCH * NG * NP,
                 O_END = O_SIMS + (size_t)DEC_BATCH * NG * NP;

constexpr int RING_BYTES = 131072, LDS_BYTES = 147456;
constexpr int NWAVES = 8, NTHREADS = 512;

enum InIdx { I_XP = 0, I_XS, I_CP, I_CS, I_SCONV, I_SDELTA, I_SSRE, I_SSIM, I_WADA, I_BADA, I_GPREMIX, I_GPOSTMIX, I_GPREFFN, I_GPOSTFFN, I_WIN, I_WCONV, I_ALOG, I_DTBIAS,
             I_GDN, I_LAMRE, I_LAMIM, I_LOGSTEP, I_BRE, I_BIM, I_CRE, I_CIM, I_DSKIP, I_WGLU, I_GS5, I_WOUT, I_WGATE, I_WUP, I_WDOWN, N_IN };
struct Args { const float* in[N_IN]; float* out; unsigned char* ws; int ph_lo, ph_hi; };

struct Frame {
    LAS unsigned char* lds;
    const float* const* in; float* out; unsigned char* ws;
    int tid, lane, wave, vcu, G;
};
DEVI const float* xrow(const Frame& F, int m) { return m < MP ? F.in[I_XP] + (size_t)m * D : F.in[I_XS] + (size_t)(m - MP) * D; }
DEVI int modrow(int m) { return m < MP ? m / SEQ : BATCH + (m - MP) / DEC_SEQ; }

DEVI void tr_item(const float* W, int ldw, int srccol, int k0, const float* kscale, bf16* WT, int dstK, int drow, int dk0, LAS float* scr, int lane) {
    float v[32];
    const float* wp = W + (size_t)(k0 + (lane >> 5)) * ldw + srccol + (lane & 31);
#pragma unroll
    for (int i = 0; i < 32; ++i) v[i] = wp[(size_t)(2 * i) * ldw];
    if (kscale) {
#pragma unroll
        for (int i = 0; i < 32; ++i) v[i] *= kscale[k0 + 2 * i + (lane >> 5)]; }
#pragma unroll
    for (int i = 0; i < 32; ++i) scr[(2 * i + (lane >> 5)) * 33 + (lane & 31)] = v[i];
    WAVE_LDS_SYNC();
    const int c = lane & 7;
#pragma unroll
    for (int j = 0; j < 4; ++j) { const int n = (lane >> 3) + 8 * j; const LAS float* s = scr + (8 * c) * 33 + n;
        u32x4 o; o.x = pk2(s[0 * 33], s[1 * 33]); o.y = pk2(s[2 * 33], s[3 * 33]); o.z = pk2(s[4 * 33], s[5 * 33]); o.w = pk2(s[6 * 33], s[7 * 33]);
        *(u32x4*)(WT + (size_t)(drow + n) * dstK + dk0 + 8 * c) = o; }
    WAVE_LDS_SYNC();
}
constexpr int NB_IN = (QKV + MIX_A + MIX_B) / 32, I_IN = (D / 64) * NB_IN, NB_GLU = 2 * MIX_B / 32, I_GLU = (MIX_B / 64) * NB_GLU, NB_OUT = D / 32, I_OUT = (D / 64) * NB_OUT,
              NB_GU = 2 * D_FF / 32, I_GU = (D / 64) * NB_GU, NB_DN = D / 32, I_DN = (D_FF / 64) * NB_DN, I_LATE = I_GLU + I_OUT + I_GU + I_DN;
DEVI void conv_item(Frame& F, LAS float* scr, int it) {
    bf16* Win = (bf16*)(F.ws + WS_WIN); bf16* Wglu = (bf16*)(F.ws + WS_WGLU); bf16* Wout = (bf16*)(F.ws + WS_WOUT); bf16* Wgu = (bf16*)(F.ws + WS_WGU); bf16* Wdn = (bf16*)(F.ws + WS_WDN);
    int r = it;
    if (r < I_IN) { const int kb = r / NB_IN, drow = 32 * (r % NB_IN); const int src = drow + (drow >= QKV + MIX_A ? 2 * NH : 0);
        tr_item(F.in[I_WIN], PROJ, src, 64 * kb, nullptr, Win, D, drow, 64 * kb, scr, F.lane); return; } r -= I_IN;
    if (r < I_GLU) { const int kb = r / NB_GLU, drow = 32 * (r % NB_GLU); const int src = ((drow >> 7) & 1) * MIX_B + 128 * (drow >> 8) + (drow & 127);
        tr_item(F.in[I_WGLU], 2 * MIX_B, src, 64 * kb, nullptr, Wglu, MIX_B, drow, 64 * kb, scr, F.lane); return; } r -= I_GLU;
    if (r < I_OUT) { const int kb = r / NB_OUT, drow = 32 * (r % NB_OUT); const int k0 = 64 * kb;
        tr_item(F.in[I_WOUT], D, drow, k0, k0 >= MIX_A ? F.in[I_GS5] - MIX_A : nullptr, Wout, D, drow, (k0 + MIX_B) % D, scr, F.lane); return; } r -= I_OUT;
    if (r < I_GU) { const int kb = r / NB_GU, drow = 32 * (r % NB_GU); const int src = 128 * (drow >> 8) + (drow & 127);
        tr_item(((drow >> 7) & 1) ? F.in[I_WUP] : F.in[I_WGATE], D_FF, src, 64 * kb, nullptr, Wgu, D, drow, 64 * kb, scr, F.lane); return; } r -= I_GU;
    { const int kb = r / NB_DN, drow = 32 * (r % NB_DN); tr_item(F.in[I_WDOWN], D, drow, 64 * kb, nullptr, Wdn, D_FF, drow, 64 * kb, scr, F.lane); }
}
#ifndef LATE_CONV
#define LATE_CONV 0
#endif
DEVI void p0_prologue(Frame& F) {
    LAS float* scr = (LAS float*)(F.lds + F.wave * 16384);
    const int gw = F.vcu * NWAVES + F.wave, NGW = F.G * NWAVES;
    bf16* Win = (bf16*)(F.ws + WS_WIN);
    for (int it = gw; it < (LATE_CONV ? I_IN : I_IN + I_LATE); it += NGW) conv_item(F, scr, it);
    const int gt = F.vcu * NTHREADS + F.tid, NGT = F.G * NTHREADS;
    for (int i = gt; i < 256 * D; i += NGT) { const int r = i / D, k = i % D;
        Win[(size_t)(QKV + MIX_A + MIX_B + r) * D + k] = (bf16)(r < 2 * NH ? f2bf(F.in[I_WIN][(size_t)k * PROJ + QKV + MIX_A + r]) : 0u); }
    bf16* As = (bf16*)(F.ws + WS_ASILU);
    for (int i = gt; i < 256 * D; i += NGT) { const int r = i / D, k = i % D; float v = 0.f;
        if (r < NB) v = siluf_(r < BATCH ? F.in[I_CP][(size_t)r * D + k] : F.in[I_CS][(size_t)(r - BATCH) * D + k]);
        As[i] = (bf16)f2bf(v); }
}

DEVI void p1_ada(Frame& F) {
    constexpr int MT = (NB + 15) / 16, NCOL = 48, UNITS = 6 * D / NCOL, KW = D / NWAVES, KS = KW / 32, SLOT = MT * 3 * 256;
    static_assert(6 * D % NCOL == 0 && KW % 32 == 0 && 4 * SLOT * 4 <= RING_BYTES, "ada");
    const bf16* As = (const bf16*)(F.ws + WS_ASILU); const float* W = F.in[I_WADA]; float* mod = (float*)(F.ws + WS_MOD);
    const int lane = F.lane, q = lane >> 4, c16 = lane & 15, wid = F.wave;
    LAS float* red = (LAS float*)F.lds;
    for (int unit = F.vcu; unit < UNITS; unit += F.G) {
        const int n0 = unit * NCOL;
        f32x4 acc[MT][3];
#pragma unroll
        for (int mt = 0; mt < MT; ++mt)
#pragma unroll
            for (int nt = 0; nt < 3; ++nt) acc[mt][nt] = (f32x4){0.f, 0.f, 0.f, 0.f};
        f32x3_ wn[8];
        const unsigned wo = (unsigned)(((wid * KW + 8 * q) * (6 * D) + n0 + 3 * c16) * 4);
#pragma unroll
        for (int j = 0; j < 8; ++j) wn[j] = ld3f((const char*)W + (wo + (unsigned)(j * 6 * D * 4)));
#pragma unroll 1
        for (int ks = 0; ks < KS; ++ks) {
            const int k0 = wid * KW + 32 * ks;
            bf16x8 b[3];
#pragma unroll
            for (int nt = 0; nt < 3; ++nt) { u32x4 p; p.x = pk2(wn[0][nt], wn[1][nt]); p.y = pk2(wn[2][nt], wn[3][nt]); p.z = pk2(wn[4][nt], wn[5][nt]); p.w = pk2(wn[6][nt], wn[7][nt]); b[nt] = __builtin_bit_cast(bf16x8, p); }
            if (ks + 1 < KS) { const unsigned wo2 = wo + (unsigned)((32 * (ks + 1)) * 6 * D * 4);
#pragma unroll
                for (int j = 0; j < 8; ++j) wn[j] = ld3f((const char*)W + (wo2 + (unsigned)(j * 6 * D * 4))); }
#pragma unroll
            for (int mt = 0; mt < MT; ++mt) { const bf16x8 a = *(const bf16x8*)((const char*)As + (unsigned)(((16 * mt + c16) * D + k0 + 8 * q) * 2));
#pragma unroll
                for (int nt = 0; nt < 3; ++nt) acc[mt][nt] = __builtin_amdgcn_mfma_f32_16x16x32_bf16(a, b[nt], acc[mt][nt], 0, 0, 0);
                if ((mt & 3) == 3) CFENCE(); }
        }
        for (int s = 4; s >= 1; s >>= 1) {
            if (wid >= s && wid < 2 * s) {
#pragma unroll
                for (int mt = 0; mt < MT; ++mt)
#pragma unroll
                    for (int nt = 0; nt < 3; ++nt) *(LAS f32x4*)(red + (wid - s) * SLOT + (mt * 3 + nt) * 256 + lane * 4) = acc[mt][nt];
            }
            LDS_BARRIER();
            if (wid < s) {
#pragma unroll
                for (int mt = 0; mt < MT; ++mt)
#pragma unroll
                    for (int nt = 0; nt < 3; ++nt) acc[mt][nt] += *(const LAS f32x4*)(red + wid * SLOT + (mt * 3 + nt) * 256 + lane * 4);
            }
            LDS_BARRIER();
        }
        if (wid == 0) {
#pragma unroll
            for (int mt = 0; mt < MT; ++mt)
#pragma unroll
                for (int nt = 0; nt < 3; ++nt) { const int col = n0 + 3 * c16 + nt; const float bias = F.in[I_BADA][col];
#pragma unroll
                    for (int r = 0; r < 4; ++r) { const int row = 16 * mt + 4 * q + r; if (row < NB) mod[(size_t)row * (6 * D) + col] = acc[mt][nt][r] + bias; } }
        }
    }
}

constexpr int NV = D / 256;
DEVI void p2_h1(Frame& F) {
    const int gw = F.wave * F.G + F.vcu, NGW = F.G * NWAVES; const float* mod = (const float*)(F.ws + WS_MOD); bf16* H = (bf16*)(F.ws + WS_H12);
    for (int m = gw; m < M; m += NGW) {
        const f32x4* xr = (const f32x4*)xrow(F, m) + F.lane; const float* md = mod + (size_t)modrow(m) * 6 * D;
        f32x4 v[NV]; float s = 0.f;
#pragma unroll
        for (int j = 0; j < NV; ++j) { v[j] = xr[64 * j]; s += (v[j].x * v[j].x + v[j].y * v[j].y) + (v[j].z * v[j].z + v[j].w * v[j].w); }
        const float rstd = f_rsqrt(wave_sum(s) * (1.f / D) + EPS);
#pragma unroll
        for (int j = 0; j < NV; ++j) { const int idx = 4 * (F.lane + 64 * j);
            const f32x4 g = *(const f32x4*)(F.in[I_GPREMIX] + idx), sh = *(const f32x4*)(md + idx), sc = *(const f32x4*)(md + D + idx);
            const f32x4 h = v[j] * rstd * g * (sc + 1.0f) + sh; u32x2 o; o.x = pk2(h.x, h.y); o.y = pk2(h.z, h.w);
            *(u32x2*)(H + (size_t)m * D + idx) = o; }
    }
}
DEVI f32x4 ld4bf(const bf16* p) { const u32x2 w = *(const u32x2*)p; return (f32x4){bf2f(w.x), bf2f(w.x >> 16), bf2f(w.y), bf2f(w.y >> 16)}; }
template <int KS> DEVI f32x4 rowval(const bf16* C, const bf16* slab, int m, int idx) {
    if (m < MP) return ld4bf(C + (size_t)m * D + idx);
    f32x4 a = ld4bf(slab + (size_t)(m - MP) * D + idx);
#pragma unroll
    for (int k = 1; k < KS; ++k) a += ld4bf(slab + ((size_t)k * MS + (m - MP)) * D + idx);
    return a;
}
DEVI void p8_x1h2(Frame& F) {
    const int gw = F.wave * F.G + F.vcu, NGW = F.G * NWAVES; const float* mod = (const float*)(F.ws + WS_MOD); bf16* H = (bf16*)(F.ws + WS_H12);
    bf16* mixb = (bf16*)(F.ws + WS_MIX); const bf16* mixs = (const bf16*)(F.ws + WS_MIXS); float* RM = (float*)(F.ws + WS_RM);
    for (int m = gw; m < M; m += NGW) {
        const f32x4* xr = (const f32x4*)xrow(F, m) + F.lane; const float* md = mod + (size_t)modrow(m) * 6 * D;
        f32x4 v[NV]; float sm = 0.f;
#pragma unroll
        for (int j = 0; j < NV; ++j) { const int idx = 4 * (F.lane + 64 * j); v[j] = rowval<KS_OUT>(mixb, mixs, m, idx);
            if (m >= MP) { u32x2 w; w.x = pk2(v[j].x, v[j].y); w.y = pk2(v[j].z, v[j].w); *(u32x2*)(mixb + (size_t)m * D + idx) = w; v[j] = (f32x4){bf2f(w.x), bf2f(w.x >> 16), bf2f(w.y), bf2f(w.y >> 16)}; }
            sm += (v[j].x * v[j].x + v[j].y * v[j].y) + (v[j].z * v[j].z + v[j].w * v[j].w); }
        const float rm = f_rsqrt(wave_sum(sm) * (1.f / D) + EPS);
        if (F.lane == 0) RM[m] = rm;
        float s = 0.f;
#pragma unroll
        for (int j = 0; j < NV; ++j) { const int idx = 4 * (F.lane + 64 * j);
            const f32x4 g = *(const f32x4*)(F.in[I_GPOSTMIX] + idx), gt = *(const f32x4*)(md + 2 * D + idx);
            v[j] = xr[64 * j] + gt * (v[j] * rm * g);
            s += (v[j].x * v[j].x + v[j].y * v[j].y) + (v[j].z * v[j].z + v[j].w * v[j].w); }
        const float rstd = f_rsqrt(wave_sum(s) * (1.f / D) + EPS);
#pragma unroll
        for (int j = 0; j < NV; ++j) { const int idx = 4 * (F.lane + 64 * j);
            const f32x4 g = *(const f32x4*)(F.in[I_GPREFFN] + idx), sh = *(const f32x4*)(md + 3 * D + idx), sc = *(const f32x4*)(md + 4 * D + idx);
            const f32x4 h = v[j] * rstd * g * (sc + 1.0f) + sh; u32x2 o; o.x = pk2(h.x, h.y); o.y = pk2(h.z, h.w);
            *(u32x2*)(H + (size_t)m * D + idx) = o; }
    }
}
DEVI void p11_out(Frame& F) {
    const int gw = F.wave * F.G + F.vcu, NGW = F.G * NWAVES; const float* mod = (const float*)(F.ws + WS_MOD);
    const bf16* mixb = (const bf16*)(F.ws + WS_MIX); const float* RM = (const float*)(F.ws + WS_RM);
    const bf16* fb = (const bf16*)(F.ws + WS_F); const bf16* fs = (const bf16*)(F.ws + WS_FS);
    for (int m = gw; m < M; m += NGW) {
        const float* md = mod + (size_t)modrow(m) * 6 * D; const f32x4* xr = (const f32x4*)xrow(F, m) + F.lane; f32x4* o = (f32x4*)(F.out + O_YP + (size_t)m * D) + F.lane;
        const float rm = RM[m];
        f32x4 v[NV]; float s = 0.f;
#pragma unroll
        for (int j = 0; j < NV; ++j) { v[j] = rowval<KS_DN>(fb, fs, m, 4 * (F.lane + 64 * j)); s += (v[j].x * v[j].x + v[j].y * v[j].y) + (v[j].z * v[j].z + v[j].w * v[j].w); }
        const float rf = f_rsqrt(wave_sum(s) * (1.f / D) + EPS);
#pragma unroll
        for (int j = 0; j < NV; ++j) { const int idx = 4 * (F.lane + 64 * j);
            const f32x4 g1 = *(const f32x4*)(F.in[I_GPOSTMIX] + idx), gt1 = *(const f32x4*)(md + 2 * D + idx), g2 = *(const f32x4*)(F.in[I_GPOSTFFN] + idx), gt2 = *(const f32x4*)(md + 5 * D + idx);
            const f32x4 x1 = xr[64 * j] + gt1 * (ld4bf(mixb + (size_t)m * D + idx) * rm * g1);
            o[64 * j] = x1 + gt2 * (v[j] * rf * g2); }
    }
}
template <int VW> DEVI void ld_bf(const bf16* p, float* o) {
    if constexpr (VW == 8) { const u32x4 w = *(const u32x4*)p; const unsigned ww[4] = {w.x, w.y, w.z, w.w};
#pragma unroll
        for (int e = 0; e < 4; ++e) { o[2 * e] = bf2f(ww[e]); o[2 * e + 1] = bf2f(ww[e] >> 16); } }
    else { const u32x2 w = *(const u32x2*)p; o[0] = bf2f(w.x); o[1] = bf2f(w.x >> 16); o[2] = bf2f(w.y); o[3] = bf2f(w.y >> 16); }
}
DEVI void p6_onorm(Frame& F) {
    constexpr int PL = MIX_A / 64, LPH = HD / PL, VW = PL >= 8 ? 8 : 4;
    static_assert(PL % VW == 0 && (LPH & (LPH - 1)) == 0, "onorm");
    const int gw = F.wave * F.G + F.vcu, NGW = F.G * NWAVES;
    const bf16* oraw = (const bf16*)(F.ws + WS_H12); const bf16* zb = (const bf16*)(F.ws + WS_ZB); bf16* acat = (bf16*)(F.ws + WS_ACAT);
    for (int m = gw; m < M; m += NGW) {
        float o[PL], z[PL]; float s = 0.f; const int c0 = F.lane * PL;
#pragma unroll
        for (int j = 0; j < PL / VW; ++j) { ld_bf<VW>(oraw + (size_t)m * D + c0 + VW * j, o + VW * j); ld_bf<VW>(zb + (size_t)m * MIX_A + c0 + VW * j, z + VW * j); }
#pragma unroll
        for (int j = 0; j < PL; ++j) s += o[j] * o[j];
#pragma unroll
        for (int d = 1; d < LPH; d <<= 1) s += __shfl_xor(s, d);
        const float rstd = f_rsqrt(s * (1.f / HD) + EPS);
#pragma unroll
        for (int j = 0; j < PL; j += 2) { const int d0 = (c0 + j) % HD;
            const float a = o[j] * rstd * F.in[I_GDN][d0] * siluf_(z[j]), b = o[j + 1] * rstd * F.in[I_GDN][d0 + 1] * siluf_(z[j + 1]);
            *(unsigned*)(acat + (size_t)m * D + MIX_B + c0 + j) = pk2(a, b); }
    }
}

using pg8::Unit;
DEVI void st8bf(bf16* p, const f32x4 v0, const f32x4 v1) { u32x4 w; w.x = pk2(v0[0], v0[1]); w.y = pk2(v0[2], v0[3]); w.z = pk2(v1[0], v1[1]); w.w = pk2(v1[2], v1[3]); *(u32x4*)p = w; }
struct EpiInProj {
    static constexpr bool PERM = true, HAS_MID = false; int tmid;
    bf16 *qkv, *z, *u; float *ab, *convp, *convs;
    DEVI void mid(f32x4 (&)[2][2][4][2], const Unit&, int, int) const {}
    DEVI void operator()(const f32x4 (&acc)[2][2][4][2], const Unit& un, int wr, int wc, int fr, int fq) const {
        const int row0 = un.pm * 256 + wr * 64 + fr, pn = un.pn;
#pragma unroll
        for (int ai = 0; ai < 2; ++ai)
#pragma unroll
            for (int m = 0; m < 4; ++m) { const int row = row0 + ai * 128 + m * 16;
                float* ct = nullptr;
                if (pn < NT_QKV) { if (row < MP) { const int t = row % SEQ; if (t >= SEQ - 3) ct = convp + ((size_t)(row / SEQ) * 3 + (t - (SEQ - 3))) * QKV; }
                                   else { const int r2 = row - MP, t = r2 % DEC_SEQ; if (t >= DEC_SEQ - 3) ct = convs + ((size_t)(r2 / DEC_SEQ) * 3 + (t - (DEC_SEQ - 3))) * QKV; } }
#pragma unroll
                for (int bj = 0; bj < 2; ++bj) { const int c0 = 128 * bj + 32 * wc + 8 * fq; const f32x4 v0 = acc[ai][bj][m][0], v1 = acc[ai][bj][m][1];
                    if (pn < NT_QKV) { const int col = pn * 256 + c0; st8bf(qkv + (size_t)row * QKV + col, v0, v1); if (ct) { *(f32x4*)(ct + col) = v0; *(f32x4*)(ct + col + 4) = v1; } }
                    else if (pn < NT_QKV + NT_Z) st8bf(z + (size_t)row * MIX_A + (pn - NT_QKV) * 256 + c0, v0, v1);
                    else if (pn < NT_QKV + NT_Z + NT_U) st8bf(u + (size_t)row * MIX_B + (pn - NT_QKV - NT_Z) * 256 + c0, v0, v1);
                    else if (c0 < 16) { *(f32x4*)(ab + (size_t)row * 16 + c0) = v0; *(f32x4*)(ab + (size_t)row * 16 + c0 + 4) = v1; } } }
    }
};
struct EpiGlu {
    static constexpr bool PERM = true, HAS_MID = false; int tmid;
    bf16* acat; unsigned long long* rs;
    DEVI void mid(f32x4 (&)[2][2][4][2], const Unit&, int, int) const {}
    DEVI void operator()(const f32x4 (&acc)[2][2][4][2], const Unit& un, int wr, int wc, int fr, int fq) const {
        const int row0 = un.pm * 256 + wr * 64 + fr, col = un.pn * 128 + 32 * wc + 8 * fq;
#pragma unroll
        for (int ai = 0; ai < 2; ++ai)
#pragma unroll
            for (int m = 0; m < 4; ++m) { const int row = row0 + ai * 128 + m * 16; f32x4 y[2]; float s = 0.f;
#pragma unroll
                for (int n = 0; n < 2; ++n)
#pragma unroll
                    for (int i = 0; i < 4; ++i) { const float v = acc[ai][0][m][n][i] * sigmoidf_(acc[ai][1][m][n][i]); y[n][i] = v; s += v * v; }
                st8bf(acat + (size_t)row * D + col, y[0], y[1]);
                s += __shfl_xor(s, 16); s += __shfl_xor(s, 32);
                if (fq == 0) atomicAdd(rs + row, (unsigned long long)(s * FX_SCALE)); }
    }
};
struct EpiSwiglu {
    static constexpr bool PERM = true, HAS_MID = false; int tmid;
    bf16* hm;
    DEVI void mid(f32x4 (&)[2][2][4][2], const Unit&, int, int) const {}
    DEVI void operator()(const f32x4 (&acc)[2][2][4][2], const Unit& un, int wr, int wc, int fr, int fq) const {
        const int row0 = un.pm * 256 + wr * 64 + fr, col = un.pn * 128 + 32 * wc + 8 * fq;
#pragma unroll
        for (int ai = 0; ai < 2; ++ai)
#pragma unroll
            for (int m = 0; m < 4; ++m) { const int row = row0 + ai * 128 + m * 16; f32x4 y[2];
#pragma unroll
                for (int n = 0; n < 2; ++n)
#pragma unroll
                    for (int i = 0; i < 4; ++i) y[n][i] = siluf_(acc[ai][0][m][n][i]) * acc[ai][1][m][n][i];
                st8bf(hm + (size_t)row * D_FF + col, y[0], y[1]); }
    }
};
template <bool MID> struct EpiF32Rs {
    static constexpr bool PERM = true, HAS_MID = MID; int tmid;
    bf16* C; bf16* slab; const unsigned long long* rs_in;
    DEVI void mid(f32x4 (&acc)[2][2][4][2], const Unit& un, int wr, int fr) const {
#pragma unroll
        for (int ai = 0; ai < 2; ++ai)
#pragma unroll
            for (int m = 0; m < 4; ++m) { const int row = un.pm * 256 + wr * 64 + fr + ai * 128 + m * 16; const float sc = f_rsqrt((float)rs_in[row] * (FX_INV / MIX_B) + EPS);
#pragma unroll
                for (int bj = 0; bj < 2; ++bj)
#pragma unroll
                    for (int n = 0; n < 2; ++n) acc[ai][bj][m][n] *= sc; }
    }
    DEVI void operator()(const f32x4 (&acc)[2][2][4][2], const Unit& un, int wr, int wc, int fr, int fq) const {
        const int row0 = un.pm * 256 + wr * 64 + fr, col0 = un.pn * 256 + wc * 32 + 8 * fq;
        bf16* base = un.ks < 0 ? C + (size_t)row0 * D : slab + ((size_t)un.ks * MS + (row0 - MP)) * D;
#pragma unroll
        for (int ai = 0; ai < 2; ++ai)
#pragma unroll
            for (int m = 0; m < 4; ++m) { bf16* rp = base + (size_t)(ai * 128 + m * 16) * D + col0;
#pragma unroll
                for (int bj = 0; bj < 2; ++bj) st8bf(rp + bj * 128, acc[ai][bj][m][0], acc[ai][bj][m][1]); }
    }
};

template <int C> struct PrepCfg { static constexpr int CP = C < 32 ? 32 : C, MT = C / 16, SC = CP / 32, LDQ = 136, LDT = CP + 8, LDL = CP + 4, XR = C + 3; };
template <int C> struct PrepLds {
    using P = PrepCfg<C>;
    static constexpr int QS = 0, KS = QS + C * P::LDQ * 2, KBS = KS + C * P::LDQ * 2, VBS = KBS + C * P::LDQ * 2, KGS = VBS + C * P::LDQ * 2, XS = KGS + C * P::LDQ * 2,
                         LS = XS, AS = LS + C * P::LDL * 4, TD = (AS + C * P::LDT * 2 + 15) & ~15, ALIAS_END = TD + P::MT * 16 * 20 * 4,
                         XEND = XS + P::XR * 384 * 2, SCAL = ((XEND > ALIAS_END ? XEND : ALIAS_END) + 15) & ~15, END = SCAL + 3 * C * 4 + 16;
};
template <int C> struct PrepPre { static constexpr int NXP = (PrepCfg<C>::XR * 48 + NTHREADS - 1) / NTHREADS; u32x4 xp[NXP]; float a_raw, b_raw; };
template <int C, int NVALID> DEVI void prep_prefetch(PrepPre<C>& P, const Frame& F, int seq_row0, int t0, int h) {
    constexpr int XR = PrepCfg<C>::XR; const bf16* qkv = (const bf16*)(F.ws + WS_QKVB); const float* ab = (const float*)(F.ws + WS_AB);
#pragma unroll
    for (int k = 0; k < PrepPre<C>::NXP; ++k) { const int p = F.tid + k * NTHREADS; u32x4 v = {0u, 0u, 0u, 0u};
        if (p < XR * 48) { const int i = p / 48, pc = p % 48, seg = pc >> 4, off = (pc & 15) * 8, j = t0 + i;
            if (j >= 3 && i - 3 < NVALID) v = *(const u32x4*)(qkv + (size_t)(seq_row0 + j - 3) * QKV + seg * MIX_A + h * HD + off); }
        P.xp[k] = v; }
    P.a_raw = 0.f; P.b_raw = 0.f;
    if (F.tid < NVALID) { const float* abr = ab + (size_t)(seq_row0 + t0 + F.tid) * 16; P.a_raw = abr[h]; P.b_raw = abr[NH + h]; }
}
template <int C, int NVALID, bool LDSF>
DEVI void delta_prep(Frame& F, LAS unsigned char* L, int seq_row0, int t0, int h, const float* conv_state, unsigned char* frag, PrepPre<C>* pre = nullptr, bool pf_next = false, int pf_row0 = 0, int pf_t0 = 0, int pf_h = 0) {
#ifndef HOST_EMU
    LAS unsigned char* fragl = (LAS unsigned char*)frag;
#else
    unsigned char* fragl = frag;
#endif
    using P = PrepCfg<C>; using O = PrepLds<C>;
    constexpr int LDQ = P::LDQ, LDT = P::LDT, LDL = P::LDL, CP = P::CP, MT = P::MT, SC = P::SC, XR = P::XR;
    LAS bf16* Qs = (LAS bf16*)(L + O::QS); LAS bf16* Ks = (LAS bf16*)(L + O::KS); LAS bf16* Kbs = (LAS bf16*)(L + O::KBS); LAS bf16* VbS = (LAS bf16*)(L + O::VBS); LAS bf16* KgS = (LAS bf16*)(L + O::KGS);
    LAS bf16* Xs = (LAS bf16*)(L + O::XS); LAS float* Ls = (LAS float*)(L + O::LS); LAS bf16* As = (LAS bf16*)(L + O::AS); LAS float* Td = (LAS float*)(L + O::TD);
    LAS float* gcs = (LAS float*)(L + O::SCAL); LAS float* bts = gcs + C; LAS float* egs = bts + C;
    const bf16* qkv = (const bf16*)(F.ws + WS_QKVB); const float* ab = (const float*)(F.ws + WS_AB);
    const int lane = F.lane, wid = F.wave, tid = F.tid, q4 = lane >> 4, c16 = lane & 15;
    if (wid == 0) {
        float g = 0.f, bt = 0.f;
        if (lane < NVALID) { float ar, br; if (pre) { ar = pre->a_raw; br = pre->b_raw; } else { const float* abr = ab + (size_t)(seq_row0 + t0 + lane) * 16; ar = abr[h]; br = abr[NH + h]; }
            const float x = ar + F.in[I_DTBIAS][h];
            const float sp = x > 20.f ? x : log1pf(f_exp(x)); g = -f_exp(F.in[I_ALOG][h]) * sp; bt = sigmoidf_(br); }
        float gc = g;
#pragma unroll
        for (int d = 1; d < 64; d <<= 1) { const float o = __shfl_up(gc, d); if (lane >= d) gc += o; }
        if (lane < C) { gcs[lane] = gc; bts[lane] = bt; egs[lane] = f_exp(gc); }
    }
    if (pre) {
#pragma unroll
        for (int k = 0; k < PrepPre<C>::NXP; ++k) { const int p = tid + k * NTHREADS; if (p < XR * 48) { const int i = p / 48, pc = p % 48, seg = pc >> 4, off = (pc & 15) * 8; *(LAS u32x4*)(Xs + i * 384 + seg * 128 + off) = pre->xp[k]; } }
        if (pf_next) prep_prefetch<C, NVALID>(*pre, F, pf_row0, pf_t0, pf_h);
    } else
    for (int p = tid; p < XR * 48; p += NTHREADS) {
        const int i = p / 48, pc = p % 48, seg = pc >> 4, off = (pc & 15) * 8; const int j = t0 + i;
        u32x4 v = {0u, 0u, 0u, 0u}; const int gcol = seg * MIX_A + h * HD + off;
        if (j < 3) { if (conv_state) { const f32x4 a = *(const f32x4*)(conv_state + (size_t)j * QKV + gcol), b = *(const f32x4*)(conv_state + (size_t)j * QKV + gcol + 4);
                                       v = (u32x4){pk2(a.x, a.y), pk2(a.z, a.w), pk2(b.x, b.y), pk2(b.z, b.w)}; } }
        else if (i - 3 < NVALID) v = *(const u32x4*)(qkv + (size_t)(seq_row0 + j - 3) * QKV + gcol);
        *(LAS u32x4*)(Xs + i * 384 + seg * 128 + off) = v;
    }
    LDS_BARRIER();
    {
        constexpr int RW = C / 8; const float* wc_ = F.in[I_WCONV];
        float w4[6][4];
#pragma unroll
        for (int sg = 0; sg < 3; ++sg)
#pragma unroll
            for (int e = 0; e < 2; ++e)
#pragma unroll
                for (int j = 0; j < 4; ++j) w4[sg * 2 + e][j] = wc_[(size_t)j * QKV + sg * MIX_A + h * HD + 2 * lane + e];
        const int tb = wid * RW;
        float win[6][3];
#pragma unroll
        for (int sg = 0; sg < 3; ++sg)
#pragma unroll
            for (int j = 0; j < 3; ++j) { const unsigned x = *(const LAS unsigned*)(Xs + (tb + j) * 384 + sg * 128 + 2 * lane); win[sg * 2][j] = bf2f(x); win[sg * 2 + 1][j] = bf2f(x >> 16); }
        constexpr int RB = RW < 4 ? RW : 4;
#pragma unroll 1
        for (int r0 = 0; r0 < RW; r0 += RB) {
            float val[RB][6], sq[RB], sk[RB];
#pragma unroll
            for (int r = 0; r < RB; ++r) { const int t = tb + r0 + r; const bool valid = t < NVALID;
#pragma unroll
                for (int sg = 0; sg < 3; ++sg) { const unsigned x = *(const LAS unsigned*)(Xs + (t + 3) * 384 + sg * 128 + 2 * lane);
#pragma unroll
                    for (int e = 0; e < 2; ++e) { const int s6 = sg * 2 + e; const float cur = bf2f(e ? (x >> 16) : x);
                        const float cv = w4[s6][0] * win[s6][0] + w4[s6][1] * win[s6][1] + w4[s6][2] * win[s6][2] + w4[s6][3] * cur;
                        win[s6][0] = win[s6][1]; win[s6][1] = win[s6][2]; win[s6][2] = cur; val[r][s6] = valid ? siluf_(cv) : 0.f; } }
                sq[r] = val[r][0] * val[r][0] + val[r][1] * val[r][1]; sk[r] = val[r][2] * val[r][2] + val[r][3] * val[r][3]; }
#pragma unroll
            for (int o = 1; o < 64; o <<= 1) {
#pragma unroll
                for (int r = 0; r < RB; ++r) { sq[r] += __shfl_xor(sq[r], o); sk[r] += __shfl_xor(sk[r], o); } }
#pragma unroll
            for (int r = 0; r < RB; ++r) { const int t = tb + r0 + r;
                const float rq = f_rsqrt(sq[r] + 1e-6f) * 0.08838834764831845f, rk = f_rsqrt(sk[r] + 1e-6f);
                const float bt = bts[t], eg = egs[t];
                const float q0 = val[r][0] * rq, q1 = val[r][1] * rq, k0 = val[r][2] * rk, k1 = val[r][3] * rk;
                *(LAS unsigned*)(Qs + t * LDQ + 2 * lane) = pk2(q0, q1); *(LAS unsigned*)(Ks + t * LDQ + 2 * lane) = pk2(k0, k1); *(LAS unsigned*)(Kbs + t * LDQ + 2 * lane) = pk2(k0 * bt, k1 * bt);
                *(LAS unsigned*)(VbS + t * LDQ + 2 * lane) = pk2(val[r][4] * bt, val[r][5] * bt); *(LAS unsigned*)(KgS + t * LDQ + 2 * lane) = pk2(k0 * bt * eg, k1 * bt * eg);
            }
        }
    }
    LDS_BARRIER();
    if constexpr (CP > C) {
        for (int i = tid; i < C * (CP - C); i += NTHREADS) { const int r = i / (CP - C), c = C + i % (CP - C); As[r * LDT + c] = 0; }
    }
    for (int tix = wid; tix < 2 * MT * MT; tix += NWAVES) {
        const int which = tix / (MT * MT), mi = (tix % (MT * MT)) / MT, nj = tix % MT;
        if (nj > mi) {
            if (which == 0) { for (int r = 0; r < 4; ++r) Ls[(16 * mi + 4 * q4 + r) * LDL + 16 * nj + c16] = 0.f; }
            else { for (int r = 0; r < 4; ++r) As[(16 * mi + 4 * q4 + r) * LDT + 16 * nj + c16] = 0; }
            continue; }
        const LAS bf16* A = which == 0 ? Kbs : Qs; f32x4 acc = {0.f, 0.f, 0.f, 0.f};
#pragma unroll
        for (int s = 0; s < 4; ++s) { const bf16x8 a = *(const LAS bf16x8*)(A + (16 * mi + c16) * LDQ + 32 * s + 8 * q4), b = *(const LAS bf16x8*)(Ks + (16 * nj + c16) * LDQ + 32 * s + 8 * q4);
            acc = __builtin_amdgcn_mfma_f32_16x16x32_bf16(a, b, acc, 0, 0, 0); }
        const int j = 16 * nj + c16; const float gj = gcs[j];
#pragma unroll
        for (int r = 0; r < 4; ++r) { const int i = 16 * mi + 4 * q4 + r; const float dec = f_exp(gcs[i] - gj);
            if (which == 0) Ls[i * LDL + j] = (i > j) ? acc[r] * dec : 0.f;
            else As[i * LDT + j] = (bf16)((i >= j) ? f2bf(acc[r] * dec) : 0u); }
    }
    LDS_BARRIER();
    if (wid == 0) {
        const int bk = lane >> 4;
        if (bk < MT) {
            float x[16];
#pragma unroll
            for (int i = 0; i < 16; ++i) { float sacc = (i == c16) ? 1.f : 0.f;
#pragma unroll
                for (int j = 0; j < i; ++j) sacc -= Ls[(16 * bk + i) * LDL + 16 * bk + j] * x[j];
                x[i] = sacc; Td[(bk * 16 + i) * 20 + c16] = sacc; }
        }
    } else {
        const float gl = gcs[C - 1];
        for (int i = tid - 64; i < C * 64; i += NTHREADS - 64) { const int t = i >> 6, c = (i & 63) * 2; const float eq = egs[t], ek = f_exp(gl - gcs[t]);
            const unsigned qx = *(LAS unsigned*)(Qs + t * LDQ + c), kx = *(LAS unsigned*)(Ks + t * LDQ + c);
            *(LAS unsigned*)(Qs + t * LDQ + c) = pk2(bf2f(qx) * eq, bf2f(qx >> 16) * eq); *(LAS unsigned*)(Ks + t * LDQ + c) = pk2(bf2f(kx) * ek, bf2f(kx >> 16) * ek); }
    }
    LDS_BARRIER();
    {
        bf16x8 tdf[MT];
#pragma unroll
        for (int rb = 0; rb < MT; ++rb) { const f32x4 t4 = *(const LAS f32x4*)(Td + (rb * 16 + c16) * 20 + 4 * q4); u32x4 p = {pk2(t4[0], t4[1]), pk2(t4[2], t4[3]), 0u, 0u}; tdf[rb] = __builtin_bit_cast(bf16x8, p); }
#pragma unroll
        for (int tt = 0; tt < 2; ++tt) {
            const int nt = 2 * wid + tt; const LAS bf16* R = (nt < 8 ? VbS : KgS) + 16 * (nt & 7) + c16;
            u32x4 xb[SC];
#pragma unroll
            for (int s = 0; s < SC; ++s) xb[s] = (u32x4){0u, 0u, 0u, 0u};
#pragma unroll
            for (int rb = 0; rb < MT; ++rb) {
                f32x4 acc;
#pragma unroll
                for (int r = 0; r < 4; ++r) acc[r] = bf2f(R[(16 * rb + 4 * q4 + r) * LDQ]);
#pragma unroll
                for (int s = 0; s < (rb + 1) / 2; ++s) {
                    const f32x4 l0 = *(const LAS f32x4*)(Ls + (16 * rb + c16) * LDL + 32 * s + 4 * q4), l1 = *(const LAS f32x4*)(Ls + (16 * rb + c16) * LDL + 32 * s + 16 + 4 * q4);
                    const u32x4 p = {pk2(-l0[0], -l0[1]), pk2(-l0[2], -l0[3]), pk2(-l1[0], -l1[1]), pk2(-l1[2], -l1[3])};
                    acc = __builtin_amdgcn_mfma_f32_16x16x32_bf16(__builtin_bit_cast(bf16x8, p), __builtin_bit_cast(bf16x8, xb[s]), acc, 0, 0, 0); }
                const u32x4 pa = {pk2(acc[0], acc[1]), pk2(acc[2], acc[3]), 0u, 0u}; const f32x4 z4 = {0.f, 0.f, 0.f, 0.f};
                const f32x4 xr = __builtin_amdgcn_mfma_f32_16x16x32_bf16(tdf[rb], __builtin_bit_cast(bf16x8, pa), z4, 0, 0, 0);
                if (rb & 1) { xb[rb >> 1].z = pk2(xr[0], xr[1]); xb[rb >> 1].w = pk2(xr[2], xr[3]); } else { xb[rb >> 1].x = pk2(xr[0], xr[1]); xb[rb >> 1].y = pk2(xr[2], xr[3]); }
                if (nt < 8) { const size_t fo = FR_U + ((size_t)(nt * MT + rb) * 64 + lane) * 16; if constexpr (LDSF) *(LAS f32x4*)(fragl + fo) = xr; else *(f32x4*)(frag + fo) = xr; }
                else {
#pragma unroll
                    for (int r = 0; r < 4; ++r) Kbs[(16 * rb + 4 * q4 + r) * LDQ + 16 * (nt - 8) + c16] = (bf16)f2bf(-xr[r]); }
            }
        }
    }
    LDS_BARRIER();
    constexpr int NFW = MT * 4, NFA = MT * SC, NFK = 8 * SC, NF = 2 * NFW + NFA + NFK;
    for (int it = tid; it < NF * 64; it += NTHREADS) {
        const int f = it >> 6, l = it & 63, i16 = l & 15, q = l >> 4; u32x4 o;
        if (f < 2 * NFW) { const int which = f / NFW, ff = f % NFW, m = ff / 4, s = ff % 4; const LAS bf16* src = (which == 0 ? Kbs : Qs) + (16 * m + i16) * LDQ + 32 * s + 4 * q;
            const u32x2 lo = *(const LAS u32x2*)src, hi = *(const LAS u32x2*)(src + 16); o = (u32x4){lo.x, lo.y, hi.x, hi.y};
            const size_t fo = (which == 0 ? FR_W : FR_Q) + ((size_t)ff * 64 + l) * 16; if constexpr (LDSF) *(LAS u32x4*)(fragl + fo) = o; else *(u32x4*)(frag + fo) = o; }
        else if (f < 2 * NFW + NFA) { const int ff = f - 2 * NFW, m = ff / SC, s = ff % SC; const LAS bf16* src = As + (16 * m + i16) * LDT + 32 * s + 4 * q;
            const u32x2 lo = *(const LAS u32x2*)src, hi = *(const LAS u32x2*)(src + 16); o = (u32x4){lo.x, lo.y, hi.x, hi.y};
            const size_t fo = FR_A + ((size_t)ff * 64 + l) * 16; if constexpr (LDSF) *(LAS u32x4*)(fragl + fo) = o; else *(u32x4*)(frag + fo) = o; }
        else { const int ff = f - 2 * NFW - NFA, T = ff / SC, s = ff % SC; unsigned e[8];
#pragma unroll
            for (int j = 0; j < 8; ++j) { const int c = 32 * s + 16 * (j >> 2) + 4 * q + (j & 3); e[j] = (c < C) ? (unsigned)Ks[c * LDQ + 16 * T + i16] : 0u; }
            o = (u32x4){e[0] | (e[1] << 16), e[2] | (e[3] << 16), e[4] | (e[5] << 16), e[6] | (e[7] << 16)};
            const size_t fo = FR_K + ((size_t)ff * 64 + l) * 16; if constexpr (LDSF) *(LAS u32x4*)(fragl + fo) = o; else *(u32x4*)(frag + fo) = o; }
    }
    if (tid == 0) { if constexpr (LDSF) *(LAS float*)(fragl + FR_SC) = egs[C - 1]; else *(float*)(frag + FR_SC) = egs[C - 1]; }
    LDS_BARRIER();
}

template <int C, int NVALID, bool LDSF>
DEVI void delta_apply(const unsigned char* frag, size_t fstride, int nchunks, f32x4 (&S)[8]  , float* Sout, bf16* oraw_base  , int vs, int lane) {
    using P = PrepCfg<C>; constexpr int MT = P::MT, SC = P::SC;
    const int q = lane >> 4, c16 = lane & 15;
#ifndef HOST_EMU
    const LAS unsigned char* fragl = (const LAS unsigned char*)frag;
#else
    const unsigned char* fragl = frag;
#endif
#define FLD(T_, off) (LDSF ? *(const LAS T_*)(fragl + (off)) : *(const T_*)(frag + (off)))
    for (int n = 0; n < nchunks; ++n, frag += fstride) {
        const float egl = FLD(float, FR_SC);
        bf16x8 Sb[4];
#pragma unroll
        for (int s = 0; s < 4; ++s) { u32x4 p; p.x = pk2(S[2 * s][0], S[2 * s][1]); p.y = pk2(S[2 * s][2], S[2 * s][3]); p.z = pk2(S[2 * s + 1][0], S[2 * s + 1][1]); p.w = pk2(S[2 * s + 1][2], S[2 * s + 1][3]); Sb[s] = __builtin_bit_cast(bf16x8, p); }
        f32x4 vn[MT], o[MT];
#pragma unroll
        for (int m = 0; m < MT; ++m) { vn[m] = FLD(f32x4, FR_U + ((size_t)(vs * MT + m) * 64 + lane) * 16); o[m] = (f32x4){0.f, 0.f, 0.f, 0.f};
#pragma unroll
            for (int s = 0; s < 4; ++s) { const bf16x8 w = FLD(bf16x8, FR_W + ((size_t)(m * 4 + s) * 64 + lane) * 16), qf = FLD(bf16x8, FR_Q + ((size_t)(m * 4 + s) * 64 + lane) * 16);
                vn[m] = __builtin_amdgcn_mfma_f32_16x16x32_bf16(w, Sb[s], vn[m], 0, 0, 0); o[m] = __builtin_amdgcn_mfma_f32_16x16x32_bf16(qf, Sb[s], o[m], 0, 0, 0); } }
        bf16x8 vb[SC];
#pragma unroll
        for (int s = 0; s < SC; ++s) { u32x4 p; p.x = pk2(vn[2 * s < MT ? 2 * s : 0][0], vn[2 * s < MT ? 2 * s : 0][1]); p.y = pk2(vn[2 * s < MT ? 2 * s : 0][2], vn[2 * s < MT ? 2 * s : 0][3]);
            if (2 * s + 1 < MT) { p.z = pk2(vn[2 * s + 1 < MT ? 2 * s + 1 : 0][0], vn[2 * s + 1 < MT ? 2 * s + 1 : 0][1]); p.w = pk2(vn[2 * s + 1 < MT ? 2 * s + 1 : 0][2], vn[2 * s + 1 < MT ? 2 * s + 1 : 0][3]); } else { p.z = 0u; p.w = 0u; }
            vb[s] = __builtin_bit_cast(bf16x8, p); }
#pragma unroll
        for (int m = 0; m < MT; ++m)
#pragma unroll
            for (int s = 0; s < SC; ++s) { const bf16x8 a = FLD(bf16x8, FR_A + ((size_t)(m * SC + s) * 64 + lane) * 16); o[m] = __builtin_amdgcn_mfma_f32_16x16x32_bf16(a, vb[s], o[m], 0, 0, 0); }
#pragma unroll
        for (int T = 0; T < 8; ++T) { S[T] *= egl;
#pragma unroll
            for (int s = 0; s < SC; ++s) { const bf16x8 kf = FLD(bf16x8, FR_K + ((size_t)(T * SC + s) * 64 + lane) * 16); S[T] = __builtin_amdgcn_mfma_f32_16x16x32_bf16(kf, vb[s], S[T], 0, 0, 0); } }
#pragma unroll
        for (int m = 0; m < MT; ++m)
#pragma unroll
            for (int r = 0; r < 4; ++r) { const int c = 16 * m + 4 * q + r; if (c < NVALID) oraw_base[(size_t)(n * C + c) * D + 16 * vs + c16] = (bf16)f2bf(o[m][r]); }
    }
#pragma unroll
    for (int T = 0; T < 8; ++T) { float* sp = Sout + (size_t)(16 * T + 4 * q) * HD + 16 * vs + c16; sp[0] = S[T][0]; sp[HD] = S[T][1]; sp[2 * HD] = S[T][2]; sp[3 * HD] = S[T][3]; }
#undef FLD
}

DEVI void p4_prep(Frame& F) {
    constexpr int NC = SEQ / CHUNK;
    PrepPre<CHUNK> pre;
    if (F.vcu < NCHUNK_P) { const int u = F.vcu, n = u % NC, bh = u / NC; prep_prefetch<CHUNK, CHUNK>(pre, F, (bh / NH) * SEQ, n * CHUNK, bh % NH); }
    for (int u = F.vcu; u < NCHUNK_P; u += F.G) {
        const int n = u % NC, bh = u / NC, h = bh % NH, b = bh / NH;
        const int u2 = u + F.G, n2 = u2 % NC, bh2 = u2 / NC;
        delta_prep<CHUNK, CHUNK, false>(F, F.lds, b * SEQ, n * CHUNK, h, nullptr, F.ws + WS_FRAG + (size_t)u * CHUNK_BYTES, &pre, u2 < NCHUNK_P, (bh2 / NH) * SEQ, n2 * CHUNK, bh2 % NH);
    }
}

template <bool SAMPLE>
DEVI void s5_job(Frame& F, LAS unsigned char* L  , int row0, int nrows, int g, int b0) {
    const int lane = F.lane, hi = lane >> 5, l31 = lane & 31, q = lane >> 4, c16 = lane & 15;
    LAS float* BUT = (LAS float*)L;
    LAS unsigned* Hs = (LAS unsigned*)(L + 10240);
    const bf16* ub = (const bf16*)(F.ws + WS_UB); bf16* y5 = (bf16*)(F.ws + WS_Y5);
    float are, aim;
    {
        const float lre = fminf(F.in[I_LAMRE][g * NP + lane], -1e-4f), lim = F.in[I_LAMIM][g * NP + lane], dt = f_exp(F.in[I_LOGSTEP][g]);
        const float mag = f_exp(lre * dt), ang = lim * dt; are = mag * f_cos(ang); aim = mag * f_sin(ang);
    }
    bf16x8 bbf[4];
#pragma unroll
    for (int nt = 0; nt < 4; ++nt) { const int pp = 32 * nt + l31, p = pp & 63;
        const float lre = fminf(F.in[I_LAMRE][g * NP + p], -1e-4f), lim = F.in[I_LAMIM][g * NP + p], dt = f_exp(F.in[I_LOGSTEP][g]);
        const float mag = f_exp(lre * dt), ang = lim * dt, nr = mag * f_cos(ang) - 1.f, ni = mag * f_sin(ang), den = lre * lre + lim * lim;
        const float cre = (nr * lre + ni * lim) / den, cim = (ni * lre - nr * lim) / den;
        const float* br = F.in[I_BRE] + ((size_t)g * NP + p) * 16 + 8 * hi; const float* bi = F.in[I_BIM] + ((size_t)g * NP + p) * 16 + 8 * hi; float e[8];
#pragma unroll
        for (int j = 0; j < 8; ++j) e[j] = pp < 64 ? cre * br[j] - cim * bi[j] : cre * bi[j] + cim * br[j];
        u32x4 pk; pk.x = pk2(e[0], e[1]); pk.y = pk2(e[2], e[3]); pk.z = pk2(e[4], e[5]); pk.w = pk2(e[6], e[7]); bbf[nt] = __builtin_bit_cast(bf16x8, pk); }
    bf16x8 ccf[4];
#pragma unroll
    for (int s = 0; s < 4; ++s) { float e[8];
#pragma unroll
        for (int j = 0; j < 8; ++j) { const int p = 16 * s + 4 * q + (j >> 1); e[j] = (j & 1) ? -F.in[I_CIM][((size_t)g * 16 + c16) * NP + p] : F.in[I_CRE][((size_t)g * 16 + c16) * NP + p]; }
        u32x4 pk; pk.x = pk2(e[0], e[1]); pk.y = pk2(e[2], e[3]); pk.z = pk2(e[4], e[5]); pk.w = pk2(e[6], e[7]); ccf[s] = __builtin_bit_cast(bf16x8, pk); }
    const float dsk = F.in[I_DSKIP][g * 16 + c16];
    float hre = 0.f, him = 0.f;
    for (int r0 = 0; r0 < nrows; r0 += 32) {
        const bf16x8 uf = *(const bf16x8*)(ub + (size_t)(row0 + r0 + l31) * MIX_B + g * 16 + 8 * hi);
        f32x16 bu[4];
#pragma unroll
        for (int nt = 0; nt < 4; ++nt) { const f32x16 z = {0.f, 0.f, 0.f, 0.f, 0.f, 0.f, 0.f, 0.f, 0.f, 0.f, 0.f, 0.f, 0.f, 0.f, 0.f, 0.f}; bu[nt] = __builtin_amdgcn_mfma_f32_32x32x16_bf16(uf, bbf[nt], z, 0, 0, 0); }
#pragma unroll
        for (int hf = 0; hf < 2; ++hf) {
            WAVE_LDS_SYNC();
#pragma unroll
            for (int nt = 0; nt < 4; ++nt)
#pragma unroll
                for (int i2 = 0; i2 < 2; ++i2) { const int i = 2 * hf + i2; *(LAS f32x4*)(BUT + (32 * nt + l31) * 20 + 8 * i2 + 4 * hi) = (f32x4){bu[nt][4 * i], bu[nt][4 * i + 1], bu[nt][4 * i + 2], bu[nt][4 * i + 3]}; }
            WAVE_LDS_SYNC();
            float br_[16], bi_[16];
#pragma unroll
            for (int j = 0; j < 4; ++j) { const f32x4 a = *(const LAS f32x4*)(BUT + lane * 20 + 4 * j), b = *(const LAS f32x4*)(BUT + (64 + lane) * 20 + 4 * j);
                br_[4 * j] = a[0]; br_[4 * j + 1] = a[1]; br_[4 * j + 2] = a[2]; br_[4 * j + 3] = a[3]; bi_[4 * j] = b[0]; bi_[4 * j + 1] = b[1]; bi_[4 * j + 2] = b[2]; bi_[4 * j + 3] = b[3]; }
#pragma unroll
            for (int tt = 0; tt < 16; ++tt) {
                if (SAMPLE && (tt & 7) == 0) { const int b = b0 + (r0 + 16 * hf + tt) / 8; hre = F.in[I_SSRE][((size_t)b * NG + g) * NP + lane]; him = F.in[I_SSIM][((size_t)b * NG + g) * NP + lane]; }
                const float nre = are * hre - aim * him + br_[tt], nim = are * him + aim * hre + bi_[tt]; hre = nre; him = nim;
                Hs[tt * 68 + lane] = pk2(hre, him);
                if (SAMPLE && (tt & 7) == 7) { const int b = b0 + (r0 + 16 * hf + tt) / 8; F.out[O_SRES + ((size_t)b * NG + g) * NP + lane] = hre; F.out[O_SIMS + ((size_t)b * NG + g) * NP + lane] = him; }
            }
            WAVE_LDS_SYNC();
            f32x4 y = {0.f, 0.f, 0.f, 0.f};
#pragma unroll
            for (int s = 0; s < 4; ++s) { const bf16x8 a = *(const LAS bf16x8*)(Hs + c16 * 68 + 16 * s + 4 * q); y = __builtin_amdgcn_mfma_f32_16x16x32_bf16(a, ccf[s], y, 0, 0, 0); }
#pragma unroll
            for (int r = 0; r < 4; ++r) { const size_t row = (size_t)(row0 + r0 + 16 * hf + 4 * q + r); const float u = bf2f(ub[row * MIX_B + g * 16 + c16]);
                y5[row * MIX_B + g * 16 + c16] = (bf16)f2bf(geluf_(y[r] + dsk * u)); }
        }
    }
    if (!SAMPLE) { F.out[O_SREP + ((size_t)b0 * NG + g) * NP + lane] = hre; F.out[O_SIMP + ((size_t)b0 * NG + g) * NP + lane] = him; }
}

struct DaFr { f32x4 u; bf16x8 wq[4]; bf16x8 a[2]; bf16x8 k[2]; float egl; };
DEVI void da_load(DaFr& f, const unsigned char* frag, int vs, int m, int role, int T, int lane) {
    const unsigned l16 = (unsigned)lane * 16u;
    f.egl = *(const float*)(frag + FR_SC);
    f.u = (f32x4){0.f, 0.f, 0.f, 0.f};
    if (role == 0) f.u = *(const f32x4*)(frag + (FR_U + (unsigned)(vs * 4 + m) * 1024u + l16));
    const unsigned wqo = (role == 0 ? FR_W : FR_Q) + (unsigned)(m * 4) * 1024u + l16;
#pragma unroll
    for (int s = 0; s < 4; ++s) f.wq[s] = *(const bf16x8*)(frag + (wqo + (unsigned)s * 1024u));
    const unsigned ao = FR_A + (unsigned)(m * 2) * 1024u + l16, ko = FR_K + (unsigned)(T * 2) * 1024u + l16;
#pragma unroll
    for (int s = 0; s < 2; ++s) { f.a[s] = *(const bf16x8*)(frag + (ao + (unsigned)s * 1024u)); f.k[s] = *(const bf16x8*)(frag + (ko + (unsigned)s * 1024u)); }
}
#define TSEG(k) do { if (TS_PHASE >= 60 && TS_PHASE < 70) { const unsigned long long tn_ = __builtin_amdgcn_s_memrealtime(); if (TS_PHASE - 60 == (k)) tsacc += tn_ - tprev; tprev = tn_; } } while (0)
DEVI void delta_apply8(Frame& F, LAS unsigned char* L, const unsigned char* frag, size_t fstride, int nchunks, float* Sout, bf16* oraw_base, int vs, unsigned long long& tsacc) {
    unsigned long long tprev = 0;
    const int w = F.wave, lane = F.lane, q = lane >> 4, c16 = lane & 15, m = w & 3, role = w >> 2, T = w;
    LAS unsigned char* SbL = L; LAS unsigned char* vbL = L + 4096;
    f32x4 S = {0.f, 0.f, 0.f, 0.f};
    *(LAS u32x2*)(SbL + ((T >> 1) * 64 + lane) * 16 + 8 * (T & 1)) = (u32x2){0u, 0u};
    DaFr f0, f1, f2;
    da_load(f0, frag, vs, m, role, T, lane); f1 = f0; f2 = f0;
    if (1 < nchunks) da_load(f1, frag + fstride, vs, m, role, T, lane);
    if (2 < nchunks) da_load(f2, frag + 2 * fstride, vs, m, role, T, lane);
    LDS_BARRIER();
#define DA_STEP(cur, n) do { \
        TSEG(9); f32x4 acc = cur.u; \
        _Pragma("unroll") for (int s = 0; s < 4; ++s) { const bf16x8 sb = *(const LAS bf16x8*)(SbL + (s * 64 + lane) * 16); acc = __builtin_amdgcn_mfma_f32_16x16x32_bf16(cur.wq[s], sb, acc, 0, 0, 0); } \
        if (role == 0) *(LAS u32x2*)(vbL + ((m >> 1) * 64 + lane) * 16 + 8 * (m & 1)) = (u32x2){pk2(acc[0], acc[1]), pk2(acc[2], acc[3])}; \
        TSEG(0); LDS_BARRIER(); TSEG(1); \
        bf16x8 vb[2]; \
        _Pragma("unroll") for (int s = 0; s < 2; ++s) vb[s] = *(const LAS bf16x8*)(vbL + (s * 64 + lane) * 16); \
        if (role == 1) { \
            _Pragma("unroll") for (int s = 0; s < 2; ++s) acc = __builtin_amdgcn_mfma_f32_16x16x32_bf16(cur.a[s], vb[s], acc, 0, 0, 0); \
            char* op = (char*)oraw_base + (unsigned)((((n) * CHUNK + 16 * m + 4 * q) * D + 16 * vs + c16) * 2); \
            *(bf16*)op = (bf16)f2bf(acc[0]); *(bf16*)(op + 2 * D) = (bf16)f2bf(acc[1]); *(bf16*)(op + 4 * D) = (bf16)f2bf(acc[2]); *(bf16*)(op + 6 * D) = (bf16)f2bf(acc[3]); \
        } \
        S *= cur.egl; \
        _Pragma("unroll") for (int s = 0; s < 2; ++s) S = __builtin_amdgcn_mfma_f32_16x16x32_bf16(cur.k[s], vb[s], S, 0, 0, 0); \
        *(LAS u32x2*)(SbL + ((T >> 1) * 64 + lane) * 16 + 8 * (T & 1)) = (u32x2){pk2(S[0], S[1]), pk2(S[2], S[3])}; \
        TSEG(2); LDS_BARRIER(); TSEG(3); \
        if ((n) + 3 < nchunks) da_load(cur, frag + (size_t)((n) + 3) * fstride, vs, m, role, T, lane); \
        TSEG(4); \
    } while (0)
    for (int n = 0; n < nchunks; n += 3) {
        DA_STEP(f0, n);
        if (n + 1 < nchunks) DA_STEP(f1, n + 1);
        if (n + 2 < nchunks) DA_STEP(f2, n + 2);
    }
#undef DA_STEP
    float* sp = Sout + (size_t)(16 * T + 4 * q) * HD + 16 * vs + c16; sp[0] = S[0]; sp[HD] = S[1]; sp[2 * HD] = S[2]; sp[3 * HD] = S[3];
}

struct S5C { float are, aim; bf16x8 bbf[4], ccf[4]; float dsk; };
DEVI void s5_consts(S5C& c, const Frame& F, int g, int lane) {
    const int hi = lane >> 5, l31 = lane & 31, q = lane >> 4, c16 = lane & 15;
    { const float lre = fminf(F.in[I_LAMRE][g * NP + lane], -1e-4f), lim = F.in[I_LAMIM][g * NP + lane], dt = f_exp(F.in[I_LOGSTEP][g]);
      const float mag = f_exp(lre * dt), ang = lim * dt; c.are = mag * f_cos(ang); c.aim = mag * f_sin(ang); }
#pragma unroll
    for (int nt = 0; nt < 4; ++nt) { const int pp = 32 * nt + l31, p = pp & 63;
        const float lre = fminf(F.in[I_LAMRE][g * NP + p], -1e-4f), lim = F.in[I_LAMIM][g * NP + p], dt = f_exp(F.in[I_LOGSTEP][g]);
        const float mag = f_exp(lre * dt), ang = lim * dt, nr = mag * f_cos(ang) - 1.f, ni = mag * f_sin(ang), den = lre * lre + lim * lim;
        const float cre = (nr * lre + ni * lim) / den, cim = (ni * lre - nr * lim) / den;
        const float* br = F.in[I_BRE] + ((size_t)g * NP + p) * 16 + 8 * hi; const float* bi = F.in[I_BIM] + ((size_t)g * NP + p) * 16 + 8 * hi; float e[8];
#pragma unroll
        for (int j = 0; j < 8; ++j) e[j] = pp < 64 ? cre * br[j] - cim * bi[j] : cre * bi[j] + cim * br[j];
        u32x4 pk; pk.x = pk2(e[0], e[1]); pk.y = pk2(e[2], e[3]); pk.z = pk2(e[4], e[5]); pk.w = pk2(e[6], e[7]); c.bbf[nt] = __builtin_bit_cast(bf16x8, pk); }
#pragma unroll
    for (int s = 0; s < 4; ++s) { float e[8];
#pragma unroll
        for (int j = 0; j < 8; ++j) { const int p = 16 * s + 4 * q + (j >> 1); e[j] = (j & 1) ? -F.in[I_CIM][((size_t)g * 16 + c16) * NP + p] : F.in[I_CRE][((size_t)g * 16 + c16) * NP + p]; }
        u32x4 pk; pk.x = pk2(e[0], e[1]); pk.y = pk2(e[2], e[3]); pk.z = pk2(e[4], e[5]); pk.w = pk2(e[6], e[7]); c.ccf[s] = __builtin_bit_cast(bf16x8, pk); }
    c.dsk = F.in[I_DSKIP][g * 16 + c16];
}
DEVI void s5_block(Frame& F, LAS unsigned char* L, LAS unsigned char* X, int b, int g) {
    constexpr int NC = SEQ / 32, NSC = (NC + 7) / 8;
    const int lane = F.lane, w = F.wave, hi = lane >> 5, l31 = lane & 31, q = lane >> 4, c16 = lane & 15;
    LAS unsigned char* wl = L + w * 16384;
    LAS float* BUT = (LAS float*)wl; LAS unsigned* Hs = (LAS unsigned*)(wl + 10240); LAS bf16* Us = (LAS bf16*)(wl + 10240 + 4352);
    LAS float* Ex = (LAS float*)X;
    const bf16* ub = (const bf16*)(F.ws + WS_UB); bf16* y5 = (bf16*)(F.ws + WS_Y5);
    S5C c; s5_consts(c, F, g, lane);
    float a32r = c.are, a32i = c.aim;
#pragma unroll
    for (int i = 0; i < 5; ++i) { const float r = a32r * a32r - a32i * a32i, im = 2.f * a32r * a32i; a32r = r; a32i = im; }
    float Hre = 0.f, Him = 0.f;
    bf16x8 ufn = *(const bf16x8*)(ub + (size_t)(b * SEQ + 32 * (w < NC ? w : 0) + l31) * MIX_B + g * 16 + 8 * hi);
    for (int sc = 0; sc < NSC; ++sc) {
        const int ch = 8 * sc + w; const bool act = ch < NC; const int row0 = b * SEQ + 32 * ch;
        const bf16x8 uf = ufn; { const int chn = ch + 8 < NC ? ch + 8 : ch; if (act) ufn = *(const bf16x8*)(ub + (size_t)(b * SEQ + 32 * chn + l31) * MIX_B + g * 16 + 8 * hi); }
        float br_[32], bi_[32];
        float ere = 0.f, eim = 0.f;
        if (act) {
            f32x16 bu[4];
#pragma unroll
            for (int nt = 0; nt < 4; ++nt) { const f32x16 z = {0.f, 0.f, 0.f, 0.f, 0.f, 0.f, 0.f, 0.f, 0.f, 0.f, 0.f, 0.f, 0.f, 0.f, 0.f, 0.f}; bu[nt] = __builtin_amdgcn_mfma_f32_32x32x16_bf16(uf, c.bbf[nt], z, 0, 0, 0); }
            WAVE_LDS_SYNC();
            *(LAS bf16x8*)(Us + l31 * 16 + 8 * hi) = uf;
#pragma unroll
            for (int hf = 0; hf < 2; ++hf) {
                WAVE_LDS_SYNC();
#pragma unroll
                for (int nt = 0; nt < 4; ++nt)
#pragma unroll
                    for (int i2 = 0; i2 < 2; ++i2) { const int i = 2 * hf + i2; *(LAS f32x4*)(BUT + (32 * nt + l31) * 20 + 8 * i2 + 4 * hi) = (f32x4){bu[nt][4 * i], bu[nt][4 * i + 1], bu[nt][4 * i + 2], bu[nt][4 * i + 3]}; }
                WAVE_LDS_SYNC();
#pragma unroll
                for (int j = 0; j < 4; ++j) { const f32x4 x = *(const LAS f32x4*)(BUT + lane * 20 + 4 * j), y = *(const LAS f32x4*)(BUT + (64 + lane) * 20 + 4 * j);
                    br_[16 * hf + 4 * j] = x[0]; br_[16 * hf + 4 * j + 1] = x[1]; br_[16 * hf + 4 * j + 2] = x[2]; br_[16 * hf + 4 * j + 3] = x[3];
                    bi_[16 * hf + 4 * j] = y[0]; bi_[16 * hf + 4 * j + 1] = y[1]; bi_[16 * hf + 4 * j + 2] = y[2]; bi_[16 * hf + 4 * j + 3] = y[3]; }
            }
#pragma unroll
            for (int t = 0; t < 32; ++t) { const float nr = c.are * ere - c.aim * eim + br_[t], ni = c.are * eim + c.aim * ere + bi_[t]; ere = nr; eim = ni; }
        }
        LAS float* Eb = Ex + (sc & 1) * (8 * 64 * 2);
        Eb[(w * 64 + lane) * 2] = ere; Eb[(w * 64 + lane) * 2 + 1] = eim;
        LDS_BARRIER();
        float cre = Hre, cim = Him;
        float hre = 0.f, him = 0.f;
#pragma unroll
        for (int i = 0; i < 8; ++i) { if (i == w) { hre = cre; him = cim; }
            const float e0 = Eb[(i * 64 + lane) * 2], e1 = Eb[(i * 64 + lane) * 2 + 1];
            if (8 * sc + i < NC) { const float nr = a32r * cre - a32i * cim + e0, ni = a32r * cim + a32i * cre + e1; cre = nr; cim = ni; } }
        Hre = cre; Him = cim;
        if (act) {
#pragma unroll
            for (int hf = 0; hf < 2; ++hf) {
                WAVE_LDS_SYNC();
#pragma unroll
                for (int tt = 0; tt < 16; ++tt) { const int t = 16 * hf + tt; const float nr = c.are * hre - c.aim * him + br_[t], ni = c.are * him + c.aim * hre + bi_[t]; hre = nr; him = ni; Hs[tt * 68 + lane] = pk2(hre, him); }
                WAVE_LDS_SYNC();
                f32x4 y = {0.f, 0.f, 0.f, 0.f};
#pragma unroll
                for (int s = 0; s < 4; ++s) { const bf16x8 a = *(const LAS bf16x8*)(Hs + c16 * 68 + 16 * s + 4 * q); y = __builtin_amdgcn_mfma_f32_16x16x32_bf16(a, c.ccf[s], y, 0, 0, 0); }
#pragma unroll
                for (int r = 0; r < 4; ++r) { const int tl = 16 * hf + 4 * q + r; const float u = bf2f(Us[tl * 16 + c16]);
                    y5[(size_t)(row0 + tl) * MIX_B + g * 16 + c16] = (bf16)f2bf(geluf_(y[r] + c.dsk * u)); }
            }
        }
    }
    if (w == 0) { F.out[O_SREP + ((size_t)b * NG + g) * NP + lane] = Hre; F.out[O_SIMP + ((size_t)b * NG + g) * NP + lane] = Him; }
    LDS_BARRIER();
}

DEVI void sample_delta_wave(Frame& F, LAS unsigned char* L, int b, int h) {
    constexpr int LDQ = 136, T8 = DEC_SEQ;
    LAS bf16* Qs = (LAS bf16*)L; LAS bf16* Ks = Qs + T8 * LDQ; LAS bf16* Kbs = Ks + T8 * LDQ; LAS bf16* VbS = Kbs + T8 * LDQ; LAS bf16* KgS = VbS + T8 * LDQ;
    LAS float* Ls = (LAS float*)(KgS + T8 * LDQ); LAS float* Td = Ls + 64; LAS bf16* As = (LAS bf16*)(Td + 64); LAS float* gcs = (LAS float*)(As + 64); LAS float* bts = gcs + 8; LAS float* egs = bts + 8;
    const int lane = F.lane, q = lane >> 4, c16 = lane & 15, row0 = MP + b * DEC_SEQ;
    const bf16* qkv = (const bf16*)(F.ws + WS_QKVB); const float* ab = (const float*)(F.ws + WS_AB); const float* cst = F.in[I_SCONV] + (size_t)b * 3 * QKV;
    const bool lo = c16 < 8, q2 = q < 2;
    WAVE_LDS_SYNC();
    { float g = 0.f, bt = 0.f;
      if (lane < T8) { const float* abr = ab + (size_t)(row0 + lane) * 16; const float x = abr[h] + F.in[I_DTBIAS][h]; const float sp = x > 20.f ? x : log1pf(f_exp(x)); g = -f_exp(F.in[I_ALOG][h]) * sp; bt = sigmoidf_(abr[NH + h]); }
      float gc = g;
#pragma unroll
      for (int d = 1; d < 8; d <<= 1) { const float o = __shfl_up(gc, d); if (lane >= d) gc += o; }
      if (lane < T8) { gcs[lane] = gc; bts[lane] = bt; egs[lane] = f_exp(gc); } }
    float val[T8][6], sq[T8], sk[T8];
    { float w4[6][4], win[6][3];
#pragma unroll
      for (int sg = 0; sg < 3; ++sg) { const int gcol = sg * MIX_A + h * HD + 2 * lane;
#pragma unroll
        for (int j = 0; j < 4; ++j) { const f32x2_ t2 = *(const f32x2_*)(F.in[I_WCONV] + (size_t)j * QKV + gcol); w4[sg * 2][j] = t2.x; w4[sg * 2 + 1][j] = t2.y; }
#pragma unroll
        for (int j = 0; j < 3; ++j) { const f32x2_ t2 = *(const f32x2_*)(cst + (size_t)j * QKV + gcol); win[sg * 2][j] = t2.x; win[sg * 2 + 1][j] = t2.y; } }
#pragma unroll
      for (int t = 0; t < T8; ++t) {
#pragma unroll
        for (int sg = 0; sg < 3; ++sg) { const unsigned x = *(const unsigned*)(qkv + (size_t)(row0 + t) * QKV + sg * MIX_A + h * HD + 2 * lane);
#pragma unroll
            for (int e = 0; e < 2; ++e) { const int s6 = sg * 2 + e; const float cur = bf2f(e ? (x >> 16) : x);
                const float cv = w4[s6][0] * win[s6][0] + w4[s6][1] * win[s6][1] + w4[s6][2] * win[s6][2] + w4[s6][3] * cur;
                win[s6][0] = win[s6][1]; win[s6][1] = win[s6][2]; win[s6][2] = cur; val[t][s6] = siluf_(cv); } }
        sq[t] = val[t][0] * val[t][0] + val[t][1] * val[t][1]; sk[t] = val[t][2] * val[t][2] + val[t][3] * val[t][3]; } }
#pragma unroll
    for (int o = 1; o < 64; o <<= 1) {
#pragma unroll
        for (int t = 0; t < T8; ++t) { sq[t] += __shfl_xor(sq[t], o); sk[t] += __shfl_xor(sk[t], o); } }
    WAVE_LDS_SYNC();
#pragma unroll
    for (int t = 0; t < T8; ++t) { const float rq = f_rsqrt(sq[t] + 1e-6f) * 0.08838834764831845f, rk = f_rsqrt(sk[t] + 1e-6f), bt = bts[t], eg = egs[t];
        const float q0 = val[t][0] * rq, q1 = val[t][1] * rq, k0 = val[t][2] * rk, k1 = val[t][3] * rk;
        *(LAS unsigned*)(Qs + t * LDQ + 2 * lane) = pk2(q0, q1); *(LAS unsigned*)(Ks + t * LDQ + 2 * lane) = pk2(k0, k1); *(LAS unsigned*)(Kbs + t * LDQ + 2 * lane) = pk2(k0 * bt, k1 * bt);
        *(LAS unsigned*)(VbS + t * LDQ + 2 * lane) = pk2(val[t][4] * bt, val[t][5] * bt); *(LAS unsigned*)(KgS + t * LDQ + 2 * lane) = pk2(k0 * bt * eg, k1 * bt * eg); }
    WAVE_LDS_SYNC();
    { f32x4 kk = {0.f, 0.f, 0.f, 0.f}, qk = {0.f, 0.f, 0.f, 0.f}; const int rr = lo ? c16 : 0;
#pragma unroll
      for (int s = 0; s < 4; ++s) { bf16x8 a0 = *(const LAS bf16x8*)(Kbs + rr * LDQ + 32 * s + 8 * q), a1 = *(const LAS bf16x8*)(Qs + rr * LDQ + 32 * s + 8 * q), bk = *(const LAS bf16x8*)(Ks + rr * LDQ + 32 * s + 8 * q);
          if (!lo) { a0 = (bf16x8){0, 0, 0, 0, 0, 0, 0, 0}; a1 = a0; bk = a0; }
          kk = __builtin_amdgcn_mfma_f32_16x16x32_bf16(a0, bk, kk, 0, 0, 0); qk = __builtin_amdgcn_mfma_f32_16x16x32_bf16(a1, bk, qk, 0, 0, 0); }
      if (lo && q2) { const float gj = gcs[c16];
#pragma unroll
          for (int r = 0; r < 4; ++r) { const int i = 4 * q + r; const float dec = f_exp(gcs[i] - gj); Ls[i * 8 + c16] = (i > c16) ? kk[r] * dec : 0.f; As[i * 8 + c16] = (bf16)((i >= c16) ? f2bf(qk[r] * dec) : 0u); } } }
    WAVE_LDS_SYNC();
    if (lane < 8) { float x[8];
#pragma unroll
        for (int i = 0; i < 8; ++i) { float sacc = (i == lane) ? 1.f : 0.f;
#pragma unroll
            for (int j = 0; j < i; ++j) sacc -= Ls[i * 8 + j] * x[j];
            x[i] = sacc; Td[i * 8 + lane] = sacc; } }
    { const float gl = gcs[T8 - 1];
#pragma unroll
      for (int t = 0; t < T8; ++t) { const float eq = egs[t], ek = f_exp(gl - gcs[t]); const unsigned qx = *(LAS unsigned*)(Qs + t * LDQ + 2 * lane), kx = *(LAS unsigned*)(Ks + t * LDQ + 2 * lane);
          *(LAS unsigned*)(Qs + t * LDQ + 2 * lane) = pk2(bf2f(qx) * eq, bf2f(qx >> 16) * eq); *(LAS unsigned*)(Ks + t * LDQ + 2 * lane) = pk2(bf2f(kx) * ek, bf2f(kx >> 16) * ek); } }
    WAVE_LDS_SYNC();
    bf16x8 tdf = {0, 0, 0, 0, 0, 0, 0, 0};
    if (lo && q2) { const f32x4 t4 = *(const LAS f32x4*)(Td + c16 * 8 + 4 * q); const u32x4 p = {pk2(t4[0], t4[1]), pk2(t4[2], t4[3]), 0u, 0u}; tdf = __builtin_bit_cast(bf16x8, p); }
#pragma unroll
    for (int nt = 0; nt < 8; ++nt) { const LAS bf16* R = KgS + 16 * nt + c16; u32x4 pb = {0u, 0u, 0u, 0u};
        if (q2) { pb.x = (unsigned)R[(4 * q) * LDQ] | ((unsigned)R[(4 * q + 1) * LDQ] << 16); pb.y = (unsigned)R[(4 * q + 2) * LDQ] | ((unsigned)R[(4 * q + 3) * LDQ] << 16); }
        const f32x4 z4 = {0.f, 0.f, 0.f, 0.f}; const f32x4 xr = __builtin_amdgcn_mfma_f32_16x16x32_bf16(tdf, __builtin_bit_cast(bf16x8, pb), z4, 0, 0, 0);
        if (q2) {
#pragma unroll
            for (int r = 0; r < 4; ++r) Kbs[(4 * q + r) * LDQ + 16 * nt + c16] = (bf16)f2bf(-xr[r]); } }
    WAVE_LDS_SYNC();
    bf16x8 Wf[4], Qf[4], Af, Kf[8];
    { const int rr = lo ? c16 : 0;
#pragma unroll
      for (int s = 0; s < 4; ++s) { const u32x2 wl_ = *(const LAS u32x2*)(Kbs + rr * LDQ + 32 * s + 4 * q), wh = *(const LAS u32x2*)(Kbs + rr * LDQ + 32 * s + 16 + 4 * q), ql = *(const LAS u32x2*)(Qs + rr * LDQ + 32 * s + 4 * q), qh = *(const LAS u32x2*)(Qs + rr * LDQ + 32 * s + 16 + 4 * q);
          u32x4 pw = {wl_.x, wl_.y, wh.x, wh.y}, pq = {ql.x, ql.y, qh.x, qh.y}; if (!lo) { pw = (u32x4){0u, 0u, 0u, 0u}; pq = pw; }
          Wf[s] = __builtin_bit_cast(bf16x8, pw); Qf[s] = __builtin_bit_cast(bf16x8, pq); }
      u32x4 pa = {0u, 0u, 0u, 0u}; if (lo && q2) { const u32x2 al = *(const LAS u32x2*)(As + c16 * 8 + 4 * q); pa.x = al.x; pa.y = al.y; } Af = __builtin_bit_cast(bf16x8, pa);
#pragma unroll
      for (int T = 0; T < 8; ++T) { u32x4 pk_ = {0u, 0u, 0u, 0u};
          if (q2) { const LAS bf16* kp = Ks + (4 * q) * LDQ + 16 * T + c16; pk_.x = (unsigned)kp[0] | ((unsigned)kp[LDQ] << 16); pk_.y = (unsigned)kp[2 * LDQ] | ((unsigned)kp[3 * LDQ] << 16); }
          Kf[T] = __builtin_bit_cast(bf16x8, pk_); } }
    const float egl = egs[T8 - 1];
    const float* s0 = F.in[I_SDELTA] + ((size_t)b * NH + h) * HD * HD + (size_t)(4 * q) * HD + c16; float* so = F.out + O_DELS + ((size_t)b * NH + h) * HD * HD + (size_t)(4 * q) * HD + c16;
    bf16* op = (bf16*)(F.ws + WS_H12) + (size_t)(row0 + 4 * q) * D + h * HD + c16;
    f32x4 Sn[8];
#pragma unroll
    for (int T = 0; T < 8; ++T) { const float* sp = s0 + (size_t)(16 * T) * HD; Sn[T] = (f32x4){sp[0], sp[HD], sp[2 * HD], sp[3 * HD]}; }
#pragma unroll 1
    for (int vs = 0; vs < 8; ++vs) {
        f32x4 S[8];
#pragma unroll
        for (int T = 0; T < 8; ++T) S[T] = Sn[T];
        if (vs + 1 < 8) {
#pragma unroll
            for (int T = 0; T < 8; ++T) { const float* sp = s0 + (size_t)(16 * T) * HD + 16 * (vs + 1); Sn[T] = (f32x4){sp[0], sp[HD], sp[2 * HD], sp[3 * HD]}; } }
        bf16x8 Sb[4];
#pragma unroll
        for (int s = 0; s < 4; ++s) { u32x4 p; p.x = pk2(S[2 * s][0], S[2 * s][1]); p.y = pk2(S[2 * s][2], S[2 * s][3]); p.z = pk2(S[2 * s + 1][0], S[2 * s + 1][1]); p.w = pk2(S[2 * s + 1][2], S[2 * s + 1][3]); Sb[s] = __builtin_bit_cast(bf16x8, p); }
        f32x4 vn, o = {0.f, 0.f, 0.f, 0.f};
        { const LAS bf16* R = VbS + 16 * vs + c16; u32x4 pb = {0u, 0u, 0u, 0u};
          if (q2) { pb.x = (unsigned)R[(4 * q) * LDQ] | ((unsigned)R[(4 * q + 1) * LDQ] << 16); pb.y = (unsigned)R[(4 * q + 2) * LDQ] | ((unsigned)R[(4 * q + 3) * LDQ] << 16); }
          const f32x4 z4 = {0.f, 0.f, 0.f, 0.f}; vn = __builtin_amdgcn_mfma_f32_16x16x32_bf16(tdf, __builtin_bit_cast(bf16x8, pb), z4, 0, 0, 0); }
#pragma unroll
        for (int s = 0; s < 4; ++s) { vn = __builtin_amdgcn_mfma_f32_16x16x32_bf16(Wf[s], Sb[s], vn, 0, 0, 0); o = __builtin_amdgcn_mfma_f32_16x16x32_bf16(Qf[s], Sb[s], o, 0, 0, 0); }
        const u32x4 pv = {pk2(vn[0], vn[1]), pk2(vn[2], vn[3]), 0u, 0u}; const bf16x8 vb = __builtin_bit_cast(bf16x8, pv);
        o = __builtin_amdgcn_mfma_f32_16x16x32_bf16(Af, vb, o, 0, 0, 0);
#pragma unroll
        for (int T = 0; T < 8; ++T) { S[T] *= egl; S[T] = __builtin_amdgcn_mfma_f32_16x16x32_bf16(Kf[T], vb, S[T], 0, 0, 0);
            float* sp = so + (size_t)(16 * T) * HD + 16 * vs; sp[0] = S[T][0]; sp[HD] = S[T][1]; sp[2 * HD] = S[T][2]; sp[3 * HD] = S[T][3]; }
        if (q2) { bf16* o2 = op + 16 * vs; o2[0] = (bf16)f2bf(o[0]); o2[D] = (bf16)f2bf(o[1]); o2[2 * D] = (bf16)f2bf(o[2]); o2[3 * D] = (bf16)f2bf(o[3]); }
    }
}

constexpr int LDS_X_OFF = RING_BYTES + 256;
#define TSMARK(i) do { if (TS_PHASE == 50 + (i)) ts0 = __builtin_amdgcn_s_memrealtime(); if (TS_PHASE == 50 + (i) - 1) ts1 = __builtin_amdgcn_s_memrealtime(); } while (0)
DEVI void p5_mix(Frame& F, unsigned long long& ts0, unsigned long long& ts1) {
    TSMARK(0);
    using OL = PrepLds<16>;
    constexpr int FRAG_OFF = (OL::END + 255) & ~255;
    static_assert(FRAG_OFF + CHUNK_BYTES <= RING_BYTES && LDS_X_OFF + 8192 <= LDS_BYTES - 16, "lds");
    TSMARK(1);
    for (int j = F.vcu; j < BATCH * NH * 8; j += F.G) { const int vs = j % 8, bh = j / 8, h = bh % NH, b = bh / NH;
        delta_apply8(F, F.lds + LDS_X_OFF, F.ws + WS_FRAG + (size_t)bh * (SEQ / CHUNK) * CHUNK_BYTES, CHUNK_BYTES, SEQ / CHUNK, F.out + O_DELP + (size_t)bh * HD * HD,
                     (bf16*)(F.ws + WS_H12) + (size_t)(b * SEQ) * D + h * HD, vs, ts1); }
    TSMARK(2);
    for (int j = F.vcu; j < BATCH * NG; j += F.G) s5_block(F, F.lds, F.lds + LDS_X_OFF, j / NG, j % NG);
    TSMARK(3);
    constexpr int NJ_SD = DEC_BATCH * NH, NJ_SS = (DEC_BATCH / 4) * NG;
    const int gw = F.wave * F.G + F.vcu, NGW = F.G * NWAVES;
    LAS unsigned char* wl = F.lds + F.wave * 16384;
    for (int j = gw; j < NJ_SD + NJ_SS; j += NGW) {
        if (j < NJ_SD) sample_delta_wave(F, wl, j / NH, j % NH);
        else { const int jj = j - NJ_SD, bq = jj / NG, g = jj % NG; s5_job<true>(F, wl, MP + bq * 32, 32, g, bq * 4); } }
#if LATE_CONV
    { const bool spare = NGW > NJ_SD;
      const int nh = spare ? NGW - NJ_SD : NGW, hw = spare ? gw - NJ_SD : gw;
      if (hw >= 0) for (int it = hw; it < I_LATE; it += nh) conv_item(F, (LAS float*)wl, I_IN + it); }
#endif
    LDS_BARRIER();
    TSMARK(4);
}

#ifndef HOST_EMU
#define XB_TMO      128
#define XB_XCNT(j)  (256  + 64 * (j))
#define XB_XSUB(j)  (1280 + 64 * (j))
#define XB_XGEN(j)  (2304 + 64 * (j))
#define XB_TOP      3328
#define XB_TOPGEN   3392
#define XCD_BAR_WORDS 3456
#define XB_SPIN_CAP (1u << 18)
__device__ __forceinline__ unsigned xb_ld(unsigned* p)              { return __hip_atomic_load(p, __ATOMIC_RELAXED, __HIP_MEMORY_SCOPE_AGENT); }
__device__ __forceinline__ unsigned xb_add(unsigned* p, unsigned v) { return __hip_atomic_fetch_add(p, v, __ATOMIC_RELAXED, __HIP_MEMORY_SCOPE_AGENT); }
__device__ __forceinline__ unsigned xb_xcc_id() { return (unsigned)__builtin_amdgcn_s_getreg((3 << 11) | 20) & 0xFu; }
#define XB_SPIN(cond, bar) do { unsigned _sp = 0; while (cond) { __builtin_amdgcn_s_sleep(1); \
    if ((++_sp & 255u) == 0u) { if (xb_ld(&(bar)[XB_TMO])) break; if (_sp > XB_SPIN_CAP) { atomicAdd(&(bar)[XB_TMO], 1u); break; } } } } while (0)
struct XcdBarrier { unsigned* bar; unsigned x; volatile LAS unsigned* st; };
__device__ __forceinline__ XcdBarrier xcd_barrier_post(unsigned* bar, volatile LAS unsigned* st) {
    XcdBarrier b; b.bar = bar; b.x = xb_xcc_id(); b.st = st;
    if (threadIdx.x == 0) (void)xb_add(&bar[XB_XCNT(b.x)], 1u);
    return b;
}
__device__ __forceinline__ void xcd_barrier_complete(unsigned* bar, unsigned x, unsigned& nloc, unsigned& nx) {
    const unsigned G = gridDim.x * gridDim.y * gridDim.z;
    unsigned sum, cnt, mine, sp = 0u;
    for (;;) {
        sum = 0u; cnt = 0u; mine = 0u;
#pragma unroll
        for (unsigned j = 0; j < 16; ++j) { const unsigned c = xb_ld(&bar[XB_XCNT(j)]); sum += c; cnt += (c > 0u) ? 1u : 0u; mine = (j == x) ? c : mine; }
        if (sum == G) break;
        __builtin_amdgcn_s_sleep(1);
        if ((++sp & 255u) == 0u) { if (xb_ld(&bar[XB_TMO])) break; if (sp > XB_SPIN_CAP) { atomicAdd(&bar[XB_TMO], 1u); break; } }
    }
    nloc = mine > 0u ? mine : 1u; nx = cnt > 0u ? cnt : 1u;
}
__device__ __forceinline__ void xcd_barrier(const XcdBarrier& b) {
    asm volatile("s_waitcnt vmcnt(0)" ::: "memory");
    __syncthreads();
    if (threadIdx.x == 0) {
        unsigned* bar = b.bar;
        __builtin_amdgcn_s_waitcnt(0);
        unsigned nloc = b.st[0], nx = b.st[1];
        if (nloc == 0u) { xcd_barrier_complete(bar, b.x, nloc, nx); b.st[0] = nloc; b.st[1] = nx; }
        const unsigned old = xb_add(&bar[XB_XSUB(b.x)], 1u);
        const unsigned gen = old / nloc;
        if (old + 1u == (gen + 1u) * nloc) {
            __builtin_amdgcn_fence(__ATOMIC_RELEASE, "agent");
            asm volatile("s_waitcnt vmcnt(0)" ::: "memory");
            const unsigned og = xb_add(&bar[XB_TOP], 1u);
            const unsigned tg = og / nx;
            if (og + 1u == (tg + 1u) * nx) xb_add(&bar[XB_TOPGEN], 1u);
            else XB_SPIN(xb_ld(&bar[XB_TOPGEN]) == tg, bar);
            __builtin_amdgcn_fence(__ATOMIC_ACQUIRE, "agent");
            xb_add(&bar[XB_XGEN(b.x)], 1u);
            asm volatile("s_waitcnt vmcnt(0)" ::: "memory");
        } else {
            XB_SPIN(xb_ld(&bar[XB_XGEN(b.x)]) == gen, bar);
            __builtin_amdgcn_fence(__ATOMIC_ACQUIRE, "agent");
            asm volatile("s_waitcnt vmcnt(0)" ::: "memory");
        }
    }
    __syncthreads();
}
#endif

constexpr int NPHASE = 12;
#ifndef MK_COOP
#define MK_COOP 1
#endif
#ifndef MK_PLAIN
#define MK_PLAIN 0
#endif
#ifndef MK_XCDBAR
#define MK_XCDBAR 1
#endif
constexpr int CTL_BAR_WORD = 1024;
constexpr int LDS_ST_OFF = LDS_BYTES - 16;
static_assert(PrepLds<CHUNK>::END <= LDS_ST_OFF, "prep scratch vs barrier words");
__global__ void __launch_bounds__(NTHREADS, 2) fwd_kernel(Args args) {
#ifdef HOST_EMU
    unsigned char* lds = emu_lds();
#else
    extern __shared__ __attribute__((aligned(16))) unsigned char lds[];
#endif
    Frame F; F.lds = (LAS unsigned char*)lds; F.in = args.in; F.out = args.out; F.ws = args.ws;
    F.tid = threadIdx.x; F.lane = F.tid & 63; F.wave = __builtin_amdgcn_readfirstlane(F.tid >> 6);
    F.G = gridDim.x; { const int bx = blockIdx.x; F.vcu = (F.G % 8 == 0) ? (bx % 8) * (F.G / 8) + bx / 8 : bx; }
    const int lo = args.ph_lo, hi = args.ph_hi;
#ifdef HOST_EMU
#define GRID_SYNC() emu_grid_sync()
#elif MK_COOP && MK_XCDBAR
#if !MK_PLAIN
    cg::grid_group grid = cg::this_grid();
#endif
    if (F.tid < 2) ((LAS unsigned*)(F.lds + LDS_ST_OFF))[F.tid] = 0u;
    __syncthreads();
    const XcdBarrier xbar = xcd_barrier_post((unsigned*)(F.ws + WS_CTL) + CTL_BAR_WORD, (volatile LAS unsigned*)(F.lds + LDS_ST_OFF));
#if !MK_PLAIN
    if (args.ph_lo < 0) grid.sync();
#endif
#define GRID_SYNC() xcd_barrier(xbar)
#elif MK_COOP
    cg::grid_group grid = cg::this_grid();
#define GRID_SYNC() grid.sync()
#else
#define GRID_SYNC() do {} while (0)
#endif
#ifndef PHASE_MASK
#define PHASE_MASK 0xFFFF
#endif
#define IN(k) ((((PHASE_MASK) >> (k)) & 1) && lo <= (k) && (k) < hi)
#ifndef REPEAT_MASK
#define REPEAT_MASK 0x0
#endif
#define REP(k) ((((REPEAT_MASK) >> (k)) & 1) ? 2 : 1)
#ifndef TS_DIV
#define TS_DIV 100.0f
#endif
    unsigned long long ts0 = 0, ts1 = 0;
#define SEAM(k) do { if (IN(k) && IN((k) + 1)) GRID_SYNC(); if (TS_PHASE == (k)) ts1 = __builtin_amdgcn_s_memrealtime(); if (TS_PHASE == (k) + 1) ts0 = __builtin_amdgcn_s_memrealtime(); } while (0)
    using namespace pg8;
    if (TS_PHASE == 0 || TS_PHASE == 99) ts0 = __builtin_amdgcn_s_memrealtime();
    if (IN(0)) { for (int rep = 0; rep < REP(0); ++rep) { p0_prologue(F); if (rep + 1 < REP(0)) GRID_SYNC(); } } SEAM(0);
    if (IN(1)) { for (int rep = 0; rep < REP(1); ++rep) { p1_ada(F); if (rep + 1 < REP(1)) GRID_SYNC(); } } SEAM(1);
    if (IN(2)) { for (int rep = 0; rep < REP(2); ++rep) { p2_h1(F); if (rep + 1 < REP(2)) GRID_SYNC(); } } SEAM(2);
    if (IN(3)) {
        {
        Gemm g{(const bf16*)(F.ws + WS_H12), (const bf16*)(F.ws + WS_WIN), M, NIN, D}; StaticOrder S; S.init(M, NIN, D, F.G, (int)blockIdx.x);
        EpiInProj E{0, (bf16*)(F.ws + WS_QKVB), (bf16*)(F.ws + WS_ZB), (bf16*)(F.ws + WS_UB), (float*)(F.ws + WS_AB), F.out + O_CONVP, F.out + O_CONVS};
        gemm_phase<EpiInProj, StaticOrder, true, true>(F.lds, g, S, E);
        }
        if (REP(3) == 2) { GRID_SYNC();
        Gemm g{(const bf16*)(F.ws + WS_H12), (const bf16*)(F.ws + WS_WIN), M, NIN, D}; StaticOrder S; S.init(M, NIN, D, F.G, (int)blockIdx.x);
        EpiInProj E{0, (bf16*)(F.ws + WS_QKVB), (bf16*)(F.ws + WS_ZB), (bf16*)(F.ws + WS_UB), (float*)(F.ws + WS_AB), F.out + O_CONVP, F.out + O_CONVS};
        gemm_phase<EpiInProj, StaticOrder, true, true>(F.lds, g, S, E);
        }
    } SEAM(3);
    if (IN(4)) { for (int rep = 0; rep < REP(4); ++rep) { p4_prep(F); if (rep + 1 < REP(4)) GRID_SYNC(); } } SEAM(4);
    if (IN(5)) { for (int rep = 0; rep < REP(5); ++rep) { p5_mix(F, ts0, ts1); if (rep + 1 < REP(5)) GRID_SYNC(); } } SEAM(5);
    if (IN(6)) {
        {
        p6_onorm(F);
        Gemm g{(const bf16*)(F.ws + WS_Y5), (const bf16*)(F.ws + WS_WGLU), M, 2 * MIX_B, MIX_B}; StaticOrder S; S.init(M, 2 * MIX_B, MIX_B, F.G, (int)blockIdx.x);
        EpiGlu E{0, (bf16*)(F.ws + WS_ACAT), (unsigned long long*)(F.ws + WS_CTL + CTL_RS5)};
        gemm_phase<EpiGlu, StaticOrder, true, true>(F.lds, g, S, E);
        }
        if (REP(6) == 2) { GRID_SYNC();
        p6_onorm(F);
        Gemm g{(const bf16*)(F.ws + WS_Y5), (const bf16*)(F.ws + WS_WGLU), M, 2 * MIX_B, MIX_B}; StaticOrder S; S.init(M, 2 * MIX_B, MIX_B, F.G, (int)blockIdx.x);
        EpiGlu E{0, (bf16*)(F.ws + WS_ACAT), (unsigned long long*)(F.ws + WS_CTL + CTL_RS5 + (size_t)M * 8)};
        gemm_phase<EpiGlu, StaticOrder, true, true>(F.lds, g, S, E);
        }
    } SEAM(6);
    if (IN(7)) {
        {
        Gemm g{(const bf16*)(F.ws + WS_ACAT), (const bf16*)(F.ws + WS_WOUT), M, D, D}; SplitOrder S; S.init(MP, M, D, D, KS_OUT, F.G, (int)blockIdx.x);
        EpiF32Rs<true> E{MIX_B / 64, (bf16*)(F.ws + WS_MIX), (bf16*)(F.ws + WS_MIXS), (const unsigned long long*)(F.ws + WS_CTL + CTL_RS5)};
        gemm_phase<EpiF32Rs<true>, SplitOrder, true, true>(F.lds, g, S, E);
        }
        if (REP(7) == 2) { GRID_SYNC();
        Gemm g{(const bf16*)(F.ws + WS_ACAT), (const bf16*)(F.ws + WS_WOUT), M, D, D}; SplitOrder S; S.init(MP, M, D, D, KS_OUT, F.G, (int)blockIdx.x);
        EpiF32Rs<true> E{MIX_B / 64, (bf16*)(F.ws + WS_MIX), (bf16*)(F.ws + WS_MIXS), (const unsigned long long*)(F.ws + WS_CTL + CTL_RS5)};
        gemm_phase<EpiF32Rs<true>, SplitOrder, true, true>(F.lds, g, S, E);
        }
    } SEAM(7);
    if (IN(8)) { p8_x1h2(F); } SEAM(8);
    if (IN(9)) {
        {
        Gemm g{(const bf16*)(F.ws + WS_H12), (const bf16*)(F.ws + WS_WGU), M, 2 * D_FF, D}; StaticOrder S; S.init(M, 2 * D_FF, D, F.G, (int)blockIdx.x);
        EpiSwiglu E{0, (bf16*)(F.ws + WS_HMID)};
        gemm_phase<EpiSwiglu, StaticOrder, true, true>(F.lds, g, S, E);
        }
        if (REP(9) == 2) { GRID_SYNC();
        Gemm g{(const bf16*)(F.ws + WS_H12), (const bf16*)(F.ws + WS_WGU), M, 2 * D_FF, D}; StaticOrder S; S.init(M, 2 * D_FF, D, F.G, (int)blockIdx.x);
        EpiSwiglu E{0, (bf16*)(F.ws + WS_HMID)};
        gemm_phase<EpiSwiglu, StaticOrder, true, true>(F.lds, g, S, E);
        }
    } SEAM(9);
    if (IN(10)) {
        {
        Gemm g{(const bf16*)(F.ws + WS_HMID), (const bf16*)(F.ws + WS_WDN), M, D, D_FF}; SplitOrder S; S.init(MP, M, D, D_FF, KS_DN, F.G, (int)blockIdx.x);
        EpiF32Rs<false> E{0, (bf16*)(F.ws + WS_F), (bf16*)(F.ws + WS_FS), nullptr};
        gemm_phase<EpiF32Rs<false>, SplitOrder, true, true>(F.lds, g, S, E);
        }
        if (REP(10) == 2) { GRID_SYNC();
        Gemm g{(const bf16*)(F.ws + WS_HMID), (const bf16*)(F.ws + WS_WDN), M, D, D_FF}; SplitOrder S; S.init(MP, M, D, D_FF, KS_DN, F.G, (int)blockIdx.x);
        EpiF32Rs<false> E{0, (bf16*)(F.ws + WS_F), (bf16*)(F.ws + WS_FS), nullptr};
        gemm_phase<EpiF32Rs<false>, SplitOrder, true, true>(F.lds, g, S, E);
        }
    } SEAM(10);
    if (IN(11)) { for (int rep = 0; rep < REP(11); ++rep) { p11_out(F); if (rep + 1 < REP(11)) GRID_SYNC(); } }
    if (TS_PHASE >= 0) { if (TS_PHASE == 11 || TS_PHASE == 99) ts1 = __builtin_amdgcn_s_memrealtime(); __syncthreads(); if (blockIdx.x == 0 && F.tid == 0) F.out[0] += (float)(ts1 - ts0) * (0.01f / TS_DIV); }
#undef IN
#undef SEAM
}

#ifndef HOST_EMU
extern "C" void kernel_launch(void* const* d_in, const int* in_sizes, int n_in, void* d_out, int out_size, void* d_ws, size_t ws_size, hipStream_t stream) {
    static int grid = 0;
    if (grid == 0) {
        if (n_in != N_IN || (size_t)out_size != O_END || ws_size < WS_END) { fprintf(stderr, "kernel_launch: unexpected sizes n_in %d out %d ws %zu (need %zu)\n", n_in, out_size, ws_size, (size_t)WS_END); grid = -1; return; }
        int dev = 0, cus = 0, per_cu = 0;
        hipGetDevice(&dev); hipDeviceGetAttribute(&cus, hipDeviceAttributeMultiprocessorCount, dev);
        hipFuncSetAttribute((const void*)fwd_kernel, hipFuncAttributeMaxDynamicSharedMemorySize, LDS_BYTES);
        hipOccupancyMaxActiveBlocksPerMultiprocessor(&per_cu, (const void*)fwd_kernel, NTHREADS, LDS_BYTES);
        if (per_cu < 1) { fprintf(stderr, "kernel_launch: occupancy query says %d blocks per CU\n", per_cu); per_cu = 1; }
        grid = cus * 1;
        (void)hipGetLastError();
    }
    if (grid < 0) return;
    hipMemsetAsync((char*)d_ws + WS_CTL, 0, CTL_USED, stream);
    Args a{};
    for (int i = 0; i < N_IN; ++i) a.in[i] = (const float*)d_in[i];
    a.out = (float*)d_out; a.ws = (unsigned char*)d_ws;
#if MK_COOP && MK_PLAIN
    a.ph_lo = 0; a.ph_hi = NPHASE;
    hipLaunchKernelGGL(fwd_kernel, dim3(grid), dim3(NTHREADS), LDS_BYTES, stream, a);
#elif MK_COOP
    a.ph_lo = 0; a.ph_hi = NPHASE;
    void* params[] = {&a};
    hipError_t e = hipLaunchCooperativeKernel((const void*)fwd_kernel, dim3(grid), dim3(NTHREADS), params, LDS_BYTES, stream);
    if (e != hipSuccess) fprintf(stderr, "cooperative launch failed: %s\n", hipGetErrorString(e));
#else
    for (int p = 0; p < NPHASE; ++p) { a.ph_lo = p; a.ph_hi = p + 1; hipLaunchKernelGGL(fwd_kernel, dim3(grid), dim3(NTHREADS), LDS_BYTES, stream, a); }
#endif
}
#endif
```

```cpp
#ifndef HOST_EMU
#include <hip/hip_runtime.h>
#include <hip/hip_cooperative_groups.h>
#endif
#include <cstdio>
#include <cstdint>
#include <cmath>

#ifndef HALF_ROWS
#define HALF_ROWS 1
#endif
#ifndef TS_PHASE
#define TS_PHASE -1
#endif
#ifdef HOST_EMU
#ifndef EMU_BATCH
#define EMU_BATCH 2
#define EMU_SEQ 128
#endif
constexpr int D_MODEL = 512, BATCH = EMU_BATCH, SEQ = EMU_SEQ, DEC_BATCH = 32, DEC_SEQ = 8;
#else
constexpr int D_MODEL = 2048, BATCH = 4, SEQ = 2048, DEC_BATCH = 128, DEC_SEQ = 8;
#endif
constexpr int D = D_MODEL, MIX_A = D / 2, MIX_B = D - MIX_A, HD = 128, NH = MIX_A / HD, CHUNK = 64, NG = MIX_B / 16, NP = 64;
constexpr int QKV = 3 * MIX_A, PROJ = QKV + MIX_A + 2 * NH + MIX_B;
constexpr int D_FF = ((8 * D + 767) / 768) * 256;
constexpr int MP = BATCH * SEQ, MS = DEC_BATCH * DEC_SEQ, M = MP + MS, NB = BATCH + DEC_BATCH;
constexpr int NIN = QKV + MIX_A + MIX_B + 256;
constexpr int NT_QKV = QKV / 256, NT_Z = MIX_A / 256, NT_U = MIX_B / 256;
constexpr float EPS = 1e-6f;
static_assert(MP % 256 == 0 && MS % 256 == 0 && D % 256 == 0 && QKV % 256 == 0 && MIX_A % 256 == 0 && D_FF % 128 == 0 && 2 * NH <= 16, "shape");
static_assert(MIX_A == MIX_B && SEQ % CHUNK == 0 && DEC_SEQ == 8 && DEC_BATCH % 4 == 0, "shape");

#ifdef HOST_EMU
#define LAS
#define GAS
#define DEVI inline
#define WAIT_VM(n)
#define WAIT_LGKM(n)
#define CFENCE()
#define OPAQUE(p)
#define SFENCE()
#define WAVE_LDS_SYNC() emu_wave_sync()
#define LDS_BARRIER() emu_block_barrier()
DEVI float f_exp(float x) { return expf(x); }
DEVI float f_rsqrt(float x) { return 1.0f / sqrtf(x); }
DEVI float f_sin(float x) { return sinf(x); }
DEVI float f_cos(float x) { return cosf(x); }
DEVI float f_rcp(float x) { return 1.0f / x; }
#else
#define LAS __attribute__((address_space(3)))
#define GAS __attribute__((address_space(1)))
#define DEVI __device__ __forceinline__
#define WAIT_VM(n) asm volatile("s_waitcnt vmcnt(" #n ")" ::: "memory")
#define WAIT_LGKM(n) asm volatile("s_waitcnt lgkmcnt(" #n ")" ::: "memory")
#define CFENCE() asm volatile("" ::: "memory")
#define OPAQUE(p) asm volatile("" : "+v"(p))
#define SFENCE() __builtin_amdgcn_sched_barrier(0)
#define WAVE_LDS_SYNC() asm volatile("s_waitcnt lgkmcnt(0)" ::: "memory")
#define LDS_BARRIER() do { asm volatile("s_waitcnt lgkmcnt(0)" ::: "memory"); __builtin_amdgcn_s_barrier(); asm volatile("" ::: "memory"); } while (0)
DEVI float f_exp(float x) { return __expf(x); }
DEVI float f_rsqrt(float x) { return rsqrtf(x); }
DEVI float f_sin(float x) { return sinf(x); }
DEVI float f_cos(float x) { return cosf(x); }
DEVI float f_rcp(float x) { return __builtin_amdgcn_rcpf(x); }
namespace cg = cooperative_groups;
#endif

typedef unsigned short bf16;
typedef short bf16x8 __attribute__((ext_vector_type(8)));
typedef float f32x4 __attribute__((ext_vector_type(4)));
typedef float f32x16 __attribute__((ext_vector_type(16)));
typedef unsigned u32x4 __attribute__((ext_vector_type(4)));
typedef unsigned u32x2 __attribute__((ext_vector_type(2)));

DEVI unsigned f2bf(float f) { unsigned u = __builtin_bit_cast(unsigned, f); return (u + 0x7fffu + ((u >> 16) & 1u)) >> 16; }
DEVI float bf2f(unsigned h) { return __builtin_bit_cast(float, (h & 0xffffu) << 16); }
typedef float f32x2_ __attribute__((ext_vector_type(2)));
typedef float f32x3_ __attribute__((ext_vector_type(3)));
#ifdef HOST_EMU
static inline f32x3_ ld3f(const void* p) { const float* f = (const float*)p; f32x3_ v; v.x = f[0]; v.y = f[1]; v.z = f[2]; return v; }
#else
__device__ __forceinline__ f32x3_ ld3f(const void* p) { return *(const f32x3_*)p; }
#endif
#ifndef HOST_EMU
typedef __bf16 bf16x2_ __attribute__((ext_vector_type(2)));
#endif
DEVI unsigned pk2(float lo, float hi) {
#ifdef HOST_EMU
    return f2bf(lo) | (f2bf(hi) << 16);
#else
    const f32x2_ v = {lo, hi}; return __builtin_bit_cast(unsigned, __builtin_convertvector(v, bf16x2_));
#endif
}
DEVI float sigmoidf_(float x) { return f_rcp(1.0f + f_exp(-x)); }
DEVI float siluf_(float x) { return x * sigmoidf_(x); }
DEVI float geluf_(float x) { const float u = 0.7978845608028654f * (x + 0.044715f * x * x * x); const float e = f_exp(2.0f * u); return 0.5f * x * (2.0f - 2.0f * f_rcp(e + 1.0f)); }
DEVI float wave_sum(float v) {
#pragma unroll
    for (int o = 1; o < 64; o <<= 1) v += __shfl_xor(v, o);
    return v;
}

namespace pg8 {
constexpr int BM = 256, BK = 64, HALF = 128, HTB = HALF * BK * 2, STAGE_BYTES = 8 * HTB, NXCD = 8, WGM = 8;
DEVI int lds_byte(int r, int c) { const int st = (r >> 4) * 2 + (c >> 5), rr = r & 15, cc = c & 31, ob = rr * 64 + cc * 2; return st * 1024 + (ob ^ (((ob >> 9) & 1) << 5)); }
DEVI void stage_rc(int b, int& R, int& C) { const int st = b / 1024, sb = b % 1024, swz = sb ^ (((sb >> 9) & 1) << 5); R = (st >> 1) * 16 + swz / 64; C = (st & 1) * 32 + (swz % 64) / 2; }
DEVI int perm32(int rho) { const int n = rho >> 4, i = rho & 15; return 8 * (i >> 2) + 4 * n + (i & 3); }
struct Unit { int pm, pn, kt0, kt1, ks; bool ok; };
struct Gemm { const bf16* A; const bf16* Bt; int M, N, K; };
struct StaticOrder {
    int nM, nN, nwg, G, c, ntk;
    DEVI void init(int M_, int N_, int K_, int G_, int c_) { nM = M_ / BM; nN = N_ / BM; nwg = nM * nN; G = G_; c = c_; ntk = K_ / BK; }
    DEVI Unit at(long L) const {
        Unit u; u.pm = 0; u.pn = 0; u.kt0 = 0; u.kt1 = ntk; u.ks = -1; u.ok = L < nwg;
        if (u.ok) {
            int wgid = (int)L; { const int q = nwg / NXCD, r = nwg % NXCD, xcd = wgid % NXCD, off = wgid / NXCD; wgid = (xcd < r ? xcd * (q + 1) : r * (q + 1) + (xcd - r) * q) + off; }
            const int nig = WGM * nN, gid = wgid / nig, fm = gid * WGM, gsz = (nM - fm) < WGM ? (nM - fm) : WGM;
            u.pm = fm + ((wgid % nig) % gsz); u.pn = (wgid % nig) / gsz; }
        return u;
    }
    DEVI Unit next(int i) const { return at((long)i * G + c); }
};
struct SplitOrder {
    StaticOrder full; int nfi, ntail, KS, mt0, nN, G, c, ntk;
    DEVI void init(int M_full, int M_, int N_, int K_, int KS_, int G_, int c_) { full.init(M_full, N_, K_, G_, c_); G = G_; c = c_; nN = N_ / BM; ntk = K_ / BK; KS = KS_; mt0 = M_full / BM; ntail = (M_ - M_full) / BM * nN;
        nfi = c < full.nwg ? (full.nwg - c + G - 1) / G : 0; }
    DEVI Unit next(int i) const {
        if (i < nfi) return full.next(i);
        Unit u; const long L = (long)(i - nfi) * G + c; u.ok = L < (long)ntail * KS;
        const int tu = (int)(L / KS), ks = (int)(L % KS), pairs = ntk / 2;
        u.pm = mt0 + tu / nN; u.pn = tu % nN; u.ks = ks; u.kt0 = 2 * ((pairs * ks) / KS); u.kt1 = 2 * ((pairs * (ks + 1)) / KS); return u;
    }
};
template <class Epi, class Sched, bool ALIGN_EPI, bool SP2>
DEVI void gemm_phase(LAS unsigned char* lds, const Gemm g, const Sched& S, const Epi& E) {
    const int tid = threadIdx.x, wid = __builtin_amdgcn_readfirstlane(tid >> 6), lane = tid & 63, wr = wid >> 2, wc = wid & 3, fr = lane & 15, fq = lane >> 4;
    const int K = g.K;
    unsigned voffA[2], voffB[2];
#pragma unroll
    for (int i = 0; i < 2; ++i) { int R, C; stage_rc(tid * 16 + i * 8192, R, C); const int Rb = Epi::PERM ? ((R & ~31) + perm32(R & 31)) : R;
        voffA[i] = (unsigned)(R * K + C) * 2u; voffB[i] = (unsigned)(Rb * K + C) * 2u; }
    const size_t kstep = (size_t)(BK * 2);
    const size_t hstep = (size_t)HALF * K * 2;
    const size_t tstep = 2 * hstep;
    const unsigned ldsw = (unsigned)wid * 1024u;
    const int aoff = lds_byte(wr * 64 + fr, fq * 8), boff = lds_byte(wc * 32 + fr, fq * 8);
#define PG8_SA(b, h) (((b) * 2 + (h)) * HTB)
#define PG8_SB(b, h) ((4 + (b) * 2 + (h)) * HTB)
#define PG8_STAGE(bufoff, gbase, voff) do { _Pragma("unroll") for (int _i = 0; _i < 2; ++_i) \
        __builtin_amdgcn_global_load_lds((const unsigned*)((const char*)(gbase) + (voff)[_i]), (LAS unsigned*)(lds + (bufoff) + ldsw + _i * 8192), 16, 0, 0); } while (0)
#define PG8_LDA(dst, b, h) do { _Pragma("unroll") for (int m = 0; m < 4; ++m) _Pragma("unroll") for (int k = 0; k < 2; ++k) dst[m][k] = *(const LAS bf16x8*)(lds + PG8_SA(b, h) + aoff + m * 2048 + k * 1024); } while (0)
#define PG8_LDB(dst, b, h) do { _Pragma("unroll") for (int n = 0; n < 2; ++n) _Pragma("unroll") for (int k = 0; k < 2; ++k) dst[n][k] = *(const LAS bf16x8*)(lds + PG8_SB(b, h) + boff + n * 2048 + k * 1024); } while (0)
#define PG8_MMA(ai, bj, At, Bt) do { __builtin_amdgcn_s_setprio(1); _Pragma("unroll") for (int m = 0; m < 4; ++m) _Pragma("unroll") for (int n = 0; n < 2; ++n) _Pragma("unroll") for (int k = 0; k < 2; ++k) \
        acc[ai][bj][m][n] = __builtin_amdgcn_mfma_f32_16x16x32_bf16(Bt[n][k], At[m][k], acc[ai][bj][m][n], 0, 0, 0); __builtin_amdgcn_s_setprio(0); } while (0)
#define PG8_WAIT_V(n) WAIT_VM(n)
#define PG8_WAIT_L(n) WAIT_LGKM(n)
#define PG8_BAR __builtin_amdgcn_s_barrier()
#define PG8_SCHED __builtin_amdgcn_sched_barrier(0)
    Unit cur = S.next(0), nxt = cur; int ui = 0;
    if (!cur.ok) return;
    f32x4 acc[2][2][4][2];
#pragma unroll
    for (int a = 0; a < 2; ++a)
#pragma unroll
        for (int b = 0; b < 2; ++b)
#pragma unroll
            for (int m = 0; m < 4; ++m)
#pragma unroll
                for (int n = 0; n < 2; ++n) acc[a][b][m][n] = (f32x4){0.f, 0.f, 0.f, 0.f};
    bf16x8 At[4][2], B0[2][2], B1[2][2];
    const char* cA = (const char*)g.A + (size_t)cur.pm * tstep; const char* cB = (const char*)g.Bt + (size_t)cur.pn * tstep;
    { const char* pA = cA; const char* pB = cB; cA += (size_t)cur.kt0 * kstep; cB += (size_t)cur.kt0 * kstep;
    if constexpr (SP2) {
        PG8_STAGE(PG8_SB(0, 0), cB, voffB); PG8_STAGE(PG8_SB(0, 1), cB + hstep, voffB); PG8_STAGE(PG8_SA(0, 0), cA, voffA); PG8_STAGE(PG8_SA(0, 1), cA + hstep, voffA);
        if (wr == 1) PG8_BAR;
        PG8_WAIT_V(2); PG8_BAR;
        PG8_STAGE(PG8_SB(1, 0), cB + kstep, voffB); PG8_STAGE(PG8_SA(1, 0), cA + kstep, voffA); PG8_STAGE(PG8_SB(1, 1), cB + hstep + kstep, voffB);
        PG8_WAIT_V(6); PG8_BAR;
    } else {
        PG8_STAGE(PG8_SB(0, 0), cB, voffB); PG8_STAGE(PG8_SA(0, 0), cA, voffA); PG8_STAGE(PG8_SB(0, 1), cB + hstep, voffB); PG8_STAGE(PG8_SA(0, 1), cA + hstep, voffA);
        if (wr == 1) PG8_BAR;
        PG8_WAIT_V(4); PG8_BAR;
        PG8_STAGE(PG8_SB(1, 0), cB + kstep, voffB); PG8_STAGE(PG8_SA(1, 0), cA + kstep, voffA); PG8_STAGE(PG8_SB(1, 1), cB + hstep + kstep, voffB);
        PG8_WAIT_V(6); PG8_BAR;
    }
    cA = pA; cB = pB; }
    for (;;) {
        nxt = S.next(ui + 1); const bool has_next = nxt.ok;
        const char* nA0 = has_next ? (const char*)g.A + (size_t)nxt.pm * tstep : cA; const char* nB0 = has_next ? (const char*)g.Bt + (size_t)nxt.pn * tstep : cB;
        const size_t nko = (size_t)(has_next ? nxt.kt0 : cur.kt0) * kstep; const char* nA = nA0 + nko; const char* nB = nB0 + nko; const int kt1 = cur.kt1;
#define PG8_KBODY \
            const bool last = (t == kt1 - 2); \
            const char* a1 = cA + (size_t)(t + 1) * kstep; \
            const char* a2 = last ? nA : cA + (size_t)(t + 2) * kstep; const char* b2 = last ? nB : cB + (size_t)(t + 2) * kstep; \
            const char* a3 = a2 + kstep; const char* b3 = b2 + kstep; \
            if constexpr (SP2) { \
            PG8_LDB(B0, 0, 0); PG8_LDB(B1, 0, 1); PG8_SCHED; PG8_LDA(At, 0, 0); PG8_STAGE(PG8_SA(1, 1), a1 + hstep, voffA); \
            PG8_WAIT_V(8); PG8_WAIT_L(0); PG8_BAR; PG8_MMA(0, 0, At, B0); PG8_MMA(0, 1, At, B1); PG8_BAR; PG8_SCHED; \
            PG8_LDA(At, 0, 1); PG8_STAGE(PG8_SB(0, 0), b2, voffB); PG8_STAGE(PG8_SB(0, 1), b2 + hstep, voffB); PG8_STAGE(PG8_SA(0, 0), a2, voffA); \
            PG8_WAIT_V(8); PG8_WAIT_L(0); PG8_BAR; PG8_MMA(1, 0, At, B0); PG8_MMA(1, 1, At, B1); PG8_BAR; PG8_SCHED; \
            PG8_LDB(B0, 1, 0); PG8_LDB(B1, 1, 1); PG8_SCHED; PG8_LDA(At, 1, 0); PG8_STAGE(PG8_SA(0, 1), a2 + hstep, voffA); \
            PG8_WAIT_V(8); PG8_WAIT_L(0); PG8_BAR; PG8_MMA(0, 0, At, B0); PG8_MMA(0, 1, At, B1); PG8_BAR; PG8_SCHED; \
            PG8_LDA(At, 1, 1); PG8_STAGE(PG8_SB(1, 0), b3, voffB); PG8_STAGE(PG8_SB(1, 1), b3 + hstep, voffB); PG8_STAGE(PG8_SA(1, 0), a3, voffA); \
            PG8_WAIT_V(8); PG8_WAIT_L(0); PG8_BAR; PG8_MMA(1, 0, At, B0); PG8_MMA(1, 1, At, B1); PG8_BAR; PG8_SCHED; \
            } else { \
            PG8_LDB(B0, 0, 0); PG8_SCHED; PG8_LDA(At, 0, 0); PG8_STAGE(PG8_SA(1, 1), a1 + hstep, voffA); \
            PG8_WAIT_L(8); PG8_BAR; PG8_WAIT_L(0); PG8_MMA(0, 0, At, B0); PG8_BAR; PG8_SCHED; \
            PG8_LDB(B1, 0, 1); PG8_STAGE(PG8_SB(0, 0), b2, voffB); \
            PG8_BAR; PG8_WAIT_L(0); PG8_MMA(0, 1, At, B1); PG8_BAR; \
            PG8_LDA(At, 0, 1); PG8_STAGE(PG8_SA(0, 0), a2, voffA); \
            PG8_BAR; PG8_WAIT_L(0); PG8_MMA(1, 0, At, B0); PG8_BAR; PG8_SCHED; \
            PG8_STAGE(PG8_SB(0, 1), b2 + hstep, voffB); \
            PG8_WAIT_V(6); PG8_BAR; PG8_MMA(1, 1, At, B1); PG8_BAR; \
            PG8_LDB(B0, 1, 0); PG8_SCHED; PG8_LDA(At, 1, 0); PG8_STAGE(PG8_SA(0, 1), a2 + hstep, voffA); \
            PG8_WAIT_L(8); PG8_BAR; PG8_WAIT_L(0); PG8_MMA(0, 0, At, B0); PG8_BAR; PG8_SCHED; \
            PG8_LDB(B1, 1, 1); PG8_STAGE(PG8_SB(1, 0), b3, voffB); \
            PG8_BAR; PG8_WAIT_L(0); PG8_MMA(0, 1, At, B1); PG8_BAR; \
            PG8_LDA(At, 1, 1); PG8_STAGE(PG8_SA(1, 0), a3, voffA); \
            PG8_BAR; PG8_WAIT_L(0); PG8_MMA(1, 0, At, B0); PG8_BAR; PG8_SCHED; \
            PG8_STAGE(PG8_SB(1, 1), b3 + hstep, voffB); \
            PG8_WAIT_V(6); PG8_BAR; PG8_MMA(1, 1, At, B1); PG8_BAR; \
            } \
         \

        if constexpr (Epi::HAS_MID) {
            const int e1 = kt1 < E.tmid ? kt1 : E.tmid, b2 = cur.kt0 > E.tmid ? cur.kt0 : E.tmid;
            for (int t = cur.kt0; t < e1; t += 2) { PG8_KBODY }
            if (cur.kt0 < E.tmid) E.mid(acc, cur, wr, fr);
            for (int t = b2; t < kt1; t += 2) { PG8_KBODY }
        } else {
            for (int t = cur.kt0; t < kt1; t += 2) { PG8_KBODY }
        }
#undef PG8_KBODY
        if constexpr (ALIGN_EPI) { if (wr == 0) PG8_BAR; }
        E(acc, cur, wr, wc, fr, fq);
        if (!has_next) break;
#pragma unroll
        for (int a = 0; a < 2; ++a)
#pragma unroll
            for (int b = 0; b < 2; ++b)
#pragma unroll
                for (int m = 0; m < 4; ++m)
#pragma unroll
                    for (int n = 0; n < 2; ++n) acc[a][b][m][n] = (f32x4){0.f, 0.f, 0.f, 0.f};
        cur = nxt; cA = nA0; cB = nB0; ++ui;
        if constexpr (ALIGN_EPI) { if (wr == 1) PG8_BAR; }
    }
    PG8_WAIT_V(0);
    if constexpr (!ALIGN_EPI) { if (wr == 0) PG8_BAR; }
    PG8_BAR;
#undef PG8_SA
#undef PG8_SB
#undef PG8_STAGE
#undef PG8_LDA
#undef PG8_LDB
#undef PG8_MMA
#undef PG8_WAIT_V
#undef PG8_WAIT_L
#undef PG8_BAR
#undef PG8_SCHED
}
}

constexpr size_t al256(size_t x) { return (x + 255) & ~(size_t)255; }
constexpr size_t WS_CTL = 0, CTL_BYTES = 1u << 20;
constexpr size_t CTL_RS5 = 65536;
static_assert(CTL_RS5 + (size_t)M * 16 <= CTL_BYTES, "ctl");
constexpr size_t CTL_USED = CTL_RS5 + (size_t)M * 16;
constexpr float FX_SCALE = 4294967296.0f, FX_INV = 1.0f / 4294967296.0f;
constexpr size_t WS_WIN = WS_CTL + CTL_BYTES;
constexpr size_t WS_WGLU = WS_WIN + al256((size_t)NIN * D * 2);
constexpr size_t WS_WOUT = WS_WGLU + al256((size_t)2 * MIX_B * MIX_B * 2);
constexpr size_t WS_WGU = WS_WOUT + al256((size_t)D * D * 2);
constexpr size_t WS_WDN = WS_WGU + al256((size_t)2 * D_FF * D * 2);
constexpr size_t WS_ASILU = WS_WDN + al256((size_t)D * D_FF * 2);
constexpr size_t WS_MOD = WS_ASILU + al256((size_t)256 * D * 2);
constexpr size_t WS_RM = WS_MOD + al256((size_t)NB * 6 * D * 4);
constexpr size_t WS_AB = WS_RM + al256((size_t)M * 4);
constexpr size_t WS_H12 = WS_AB + al256((size_t)M * 16 * 4);
constexpr size_t WS_ACAT = WS_H12 + al256((size_t)M * D * 2);
constexpr size_t WS_F = WS_H12;
constexpr size_t WS_QKVB = WS_ACAT + al256((size_t)M * D * 2);
constexpr size_t WS_ZB = WS_QKVB + al256((size_t)M * QKV * 2);
constexpr size_t WS_UB = WS_ZB + al256((size_t)M * MIX_A * 2);
constexpr size_t WS_Y5 = WS_UB + al256((size_t)M * MIX_B * 2);
constexpr int KS_OUT = (D / 64 / 2) < 8 ? (D / 64 / 2) : 8, KS_DN = (D_FF / 64 / 2) < 8 ? (D_FF / 64 / 2) : 8;
constexpr size_t WS_HMID = WS_QKVB;
constexpr size_t WS_MIX = WS_Y5 + al256((size_t)M * MIX_B * 2);
static_assert(WS_ACAT == WS_H12 + (size_t)M * D * 2 && WS_MIX - WS_QKVB >= (size_t)M * D_FF * 2, "overlay");
constexpr int FR_U = 0, FR_W = 32768, FR_Q = FR_W + 16384, FR_A = FR_Q + 16384, FR_K = FR_A + 8192, FR_SC = FR_K + 16384, CHUNK_BYTES = FR_SC + 256;
constexpr int NCHUNK_P = BATCH * NH * (SEQ / CHUNK);
constexpr size_t WS_FRAG = WS_MIX;
constexpr size_t FRAG_TOTAL = (size_t)NCHUNK_P * CHUNK_BYTES;
constexpr size_t WS_END0 = WS_MIX + (FRAG_TOTAL > (size_t)M * D * 4 ? FRAG_TOTAL : (size_t)M * D * 4);
#ifdef HOST_EMU
constexpr size_t WS_MIXS = WS_END0, WS_FS = WS_MIXS + (size_t)KS_OUT * MS * D * 2, WS_END = WS_FS + (size_t)KS_DN * MS * D * 2;
#else
constexpr size_t WS_MIXS = WS_QKVB;
constexpr size_t WS_FS = WS_WIN;
constexpr size_t WS_END = WS_END0;
static_assert(WS_MIX - WS_QKVB >= (size_t)KS_OUT * MS * D * 2 && WS_WDN - WS_WIN >= (size_t)KS_DN * MS * D * 2, "slab overlay");
#endif

constexpr size_t O_YP = 0, O_YS = O_YP + (size_t)MP * D, O_CONVP = O_YS + (size_t)MS * D, O_DELP = O_CONVP + (size_t)BATCH * 3 * QKV,
                 O_SREP = O_DELP + (size_t)BATCH * NH * HD * HD, O_SIMP = O_SREP + (size_t)BATCH * NG * NP, O_CONVS = O_SIMP + (size_t)BATCH * NG * NP,
                 O_DELS = O_CONVS + (size_t)DEC_BATCH * 3 * QKV, O_SRES = O_DELS + (size_t)DEC_BATCH * NH * HD * HD, O_SIMS = O_SRES + (size_t)DEC_BATCH * NG * NP,
                 O_END = O_SIMS + (size_t)DEC_BATCH * NG * NP;

constexpr int RING_BYTES = 131072, LDS_BYTES = 147456;
constexpr int NWAVES = 8, NTHREADS = 512;

enum InIdx { I_XP = 0, I_XS, I_CP, I_CS, I_SCONV, I_SDELTA, I_SSRE, I_SSIM, I_WADA, I_BADA, I_GPREMIX, I_GPOSTMIX, I_GPREFFN, I_GPOSTFFN, I_WIN, I_WCONV, I_ALOG, I_DTBIAS,
             I_GDN, I_LAMRE, I_LAMIM, I_LOGSTEP, I_BRE, I_BIM, I_CRE, I_CIM, I_DSKIP, I_WGLU, I_GS5, I_WOUT, I_WGATE, I_WUP, I_WDOWN, N_IN };
struct Args { const float* in[N_IN]; float* out; unsigned char* ws; int ph_lo, ph_hi; };

struct Frame {
    LAS unsigned char* lds;
    const float* const* in; float* out; unsigned char* ws;
    int tid, lane, wave, vcu, G;
};
DEVI const float* xrow(const Frame& F, int m) { return m < MP ? F.in[I_XP] + (size_t)m * D : F.in[I_XS] + (size_t)(m - MP) * D; }
DEVI int modrow(int m) { return m < MP ? m / SEQ : BATCH + (m - MP) / DEC_SEQ; }

DEVI void tr_item(const float* W, int ldw, int srccol, int k0, const float* kscale, bf16* WT, int dstK, int drow, int dk0, LAS float* scr, int lane) {
    float v[32];
    const float* wp = W + (size_t)(k0 + (lane >> 5)) * ldw + srccol + (lane & 31);
#pragma unroll
    for (int i = 0; i < 32; ++i) v[i] = wp[(size_t)(2 * i) * ldw];
    if (kscale) {
#pragma unroll
        for (int i = 0; i < 32; ++i) v[i] *= kscale[k0 + 2 * i + (lane >> 5)]; }
#pragma unroll
    for (int i = 0; i < 32; ++i) scr[(2 * i + (lane >> 5)) * 33 + (lane & 31)] = v[i];
    WAVE_LDS_SYNC();
    const int c = lane & 7;
#pragma unroll
    for (int j = 0; j < 4; ++j) { const int n = (lane >> 3) + 8 * j; const LAS float* s = scr + (8 * c) * 33 + n;
        u32x4 o; o.x = pk2(s[0 * 33], s[1 * 33]); o.y = pk2(s[2 * 33], s[3 * 33]); o.z = pk2(s[4 * 33], s[5 * 33]); o.w = pk2(s[6 * 33], s[7 * 33]);
        *(u32x4*)(WT + (size_t)(drow + n) * dstK + dk0 + 8 * c) = o; }
    WAVE_LDS_SYNC();
}
constexpr int NB_IN = (QKV + MIX_A + MIX_B) / 32, I_IN = (D / 64) * NB_IN, NB_GLU = 2 * MIX_B / 32, I_GLU = (MIX_B / 64) * NB_GLU, NB_OUT = D / 32, I_OUT = (D / 64) * NB_OUT,
              NB_GU = 2 * D_FF / 32, I_GU = (D / 64) * NB_GU, NB_DN = D / 32, I_DN = (D_FF / 64) * NB_DN, I_LATE = I_GLU + I_OUT + I_GU + I_DN;
DEVI void conv_item(Frame& F, LAS float* scr, int it) {
    bf16* Win = (bf16*)(F.ws + WS_WIN); bf16* Wglu = (bf16*)(F.ws + WS_WGLU); bf16* Wout = (bf16*)(F.ws + WS_WOUT); bf16* Wgu = (bf16*)(F.ws + WS_WGU); bf16* Wdn = (bf16*)(F.ws + WS_WDN);
    int r = it;
    if (r < I_IN) { const int kb = r / NB_IN, drow = 32 * (r % NB_IN); const int src = drow + (drow >= QKV + MIX_A ? 2 * NH : 0);
        tr_item(F.in[I_WIN], PROJ, src, 64 * kb, nullptr, Win, D, drow, 64 * kb, scr, F.lane); return; } r -= I_IN;
    if (r < I_GLU) { const int kb = r / NB_GLU, drow = 32 * (r % NB_GLU); const int src = ((drow >> 7) & 1) * MIX_B + 128 * (drow >> 8) + (drow & 127);
        tr_item(F.in[I_WGLU], 2 * MIX_B, src, 64 * kb, nullptr, Wglu, MIX_B, drow, 64 * kb, scr, F.lane); return; } r -= I_GLU;
    if (r < I_OUT) { const int kb = r / NB_OUT, drow = 32 * (r % NB_OUT); const int k0 = 64 * kb;
        tr_item(F.in[I_WOUT], D, drow, k0, k0 >= MIX_A ? F.in[I_GS5] - MIX_A : nullptr, Wout, D, drow, (k0 + MIX_B) % D, scr, F.lane); return; } r -= I_OUT;
    if (r < I_GU) { const int kb = r / NB_GU, drow = 32 * (r % NB_GU); const int src = 128 * (drow >> 8) + (drow & 127);
        tr_item(((drow >> 7) & 1) ? F.in[I_WUP] : F.in[I_WGATE], D_FF, src, 64 * kb, nullptr, Wgu, D, drow, 64 * kb, scr, F.lane); return; } r -= I_GU;
    { const int kb = r / NB_DN, drow = 32 * (r % NB_DN); tr_item(F.in[I_WDOWN], D, drow, 64 * kb, nullptr, Wdn, D_FF, drow, 64 * kb, scr, F.lane); }
}
#ifndef DN_LATE
#define DN_LATE 1
#endif
#ifndef LATE_CONV
#define LATE_CONV 0
#endif
constexpr int ADA_MT = (NB + 15) / 16;
DEVI void p0_prologue(Frame& F) {
    LAS float* scr = (LAS float*)(F.lds + F.wave * 16384);
    const int gw = F.vcu * NWAVES + F.wave, NGW = F.G * NWAVES;
    bf16* Win = (bf16*)(F.ws + WS_WIN);
    for (int it = gw; it < (LATE_CONV ? I_IN : I_IN + I_LATE - (DN_LATE ? I_DN : 0)); it += NGW) conv_item(F, scr, it);
    const int gt = F.vcu * NTHREADS + F.tid, NGT = F.G * NTHREADS;
    for (int i = gt; i < (int)((CTL_USED - CTL_RS5) / 8); i += NGT) ((unsigned long long*)(F.ws + WS_CTL + CTL_RS5))[i] = 0ull;
    for (int i = gt; i < 256 * D; i += NGT) { const int r = i / D, k = i % D;
        Win[(size_t)(QKV + MIX_A + MIX_B + r) * D + k] = (bf16)(r < 2 * NH ? f2bf(F.in[I_WIN][(size_t)k * PROJ + QKV + MIX_A + r]) : 0u); }
    unsigned char* As = F.ws + WS_ASILU;
    for (int g = gt; g < (D / 32) * ADA_MT * 64; g += NGT) { const int f = g >> 6, l = g & 63, ks = f / ADA_MT, mt = f % ADA_MT, r = 16 * mt + (l & 15), k = 32 * ks + 8 * (l >> 4);
        u32x4 o = (u32x4){0u, 0u, 0u, 0u};
        if (r < NB) { const float* c = (r < BATCH ? F.in[I_CP] + (size_t)r * D : F.in[I_CS] + (size_t)(r - BATCH) * D) + k; const f32x4 c0 = *(const f32x4*)c, c1 = *(const f32x4*)(c + 4);
            o.x = pk2(siluf_(c0.x), siluf_(c0.y)); o.y = pk2(siluf_(c0.z), siluf_(c0.w)); o.z = pk2(siluf_(c1.x), siluf_(c1.y)); o.w = pk2(siluf_(c1.z), siluf_(c1.w)); }
        *(u32x4*)(As + (size_t)g * 16) = o; }
}

DEVI void p1_ada(Frame& F, unsigned long long& ts0, unsigned long long& ts1) {
#define P1MARK(i) do { if (TS_PHASE == 70 + (i)) ts0 = __builtin_amdgcn_s_memrealtime(); if (TS_PHASE == 70 + (i) - 1) ts1 = __builtin_amdgcn_s_memrealtime(); } while (0)
    P1MARK(0);
    constexpr int MT = ADA_MT, NCOL = 48, UNITS = 6 * D / NCOL, KW = D / NWAVES, KS = KW / 32, SLOT = MT * 3 * 256;
    static_assert(6 * D % NCOL == 0 && KW % 32 == 0 && (KS & (KS - 1)) == 0 && 4 * SLOT * 4 <= RING_BYTES, "ada");
    const bf16* As = (const bf16*)(F.ws + WS_ASILU); const float* W = F.in[I_WADA]; float* mod = (float*)(F.ws + WS_MOD);
    const int lane = F.lane, q = lane >> 4, c16 = lane & 15, wid = F.wave;
    LAS float* red = (LAS float*)F.lds;
    for (int unit = F.vcu; unit < UNITS; unit += F.G) {
        const int n0 = unit * NCOL;
        f32x4 acc[MT][3];
#pragma unroll
        for (int mt = 0; mt < MT; ++mt)
#pragma unroll
            for (int nt = 0; nt < 3; ++nt) acc[mt][nt] = (f32x4){0.f, 0.f, 0.f, 0.f};
        const unsigned vw = (unsigned)((8 * q * (6 * D) + 3 * c16) * 4), va = (unsigned)(lane * 16);
        const char* Wb = (const char*)W + (size_t)(wid * KW) * (6 * D) * 4 + (size_t)n0 * 4; const char* Ab = (const char*)As + (size_t)(wid * KS) * (MT * 1024);
        f32x3_ w0[8], w1[8];
#pragma unroll
        for (int j = 0; j < 8; ++j) w0[j] = ld3f(Wb + (size_t)j * (6 * D * 4) + vw);
#pragma unroll
        for (int j = 0; j < 8; ++j) w1[j] = ld3f(Wb + (size_t)(32 * (KS > 1 ? 1 : 0)) * (6 * D * 4) + (size_t)j * (6 * D * 4) + vw);
#define P1_STEP(ks_, wc_) do { \
            const int ksv = (ks_), kn = ksv + 2 < KS ? ksv + 2 : ksv; \
            bf16x8 a[MT]; \
            _Pragma("unroll") for (int mt = 0; mt < MT; ++mt) a[mt] = *(const bf16x8*)(Ab + (size_t)ksv * (MT * 1024) + (size_t)mt * 1024 + va); \
            SFENCE(); \
            bf16x8 b[3]; \
            _Pragma("unroll") for (int nt = 0; nt < 3; ++nt) { u32x4 p; p.x = pk2(wc_[0][nt], wc_[1][nt]); p.y = pk2(wc_[2][nt], wc_[3][nt]); p.z = pk2(wc_[4][nt], wc_[5][nt]); p.w = pk2(wc_[6][nt], wc_[7][nt]); b[nt] = __builtin_bit_cast(bf16x8, p); } \
            SFENCE(); \
            { const char* W2 = Wb + (size_t)(32 * kn) * (6 * D * 4);        \
              _Pragma("unroll") for (int j = 0; j < 8; ++j) wc_[j] = ld3f(W2 + (size_t)j * (6 * D * 4) + vw); } \
            SFENCE(); \
            _Pragma("unroll") for (int mt = 0; mt < MT; ++mt) _Pragma("unroll") for (int nt = 0; nt < 3; ++nt) acc[mt][nt] = __builtin_amdgcn_mfma_f32_16x16x32_bf16(a[mt], b[nt], acc[mt][nt], 0, 0, 0); \
        } while (0)
        static_assert(KS % 2 == 0, "ada k-steps");
#pragma unroll 1
        for (int ks = 0; ks < KS; ks += 2) { P1_STEP(ks, w0); P1_STEP(ks + 1, w1); }
#undef P1_STEP
        P1MARK(1);
        float bias[3], gm[3];
#pragma unroll
        for (int nt = 0; nt < 3; ++nt) { const int col = n0 + 3 * c16 + nt; const int ch = col / D, cc = col % D;
            const float* gp = ch == 1 ? F.in[I_GPREMIX] : ch == 2 ? F.in[I_GPOSTMIX] : ch == 4 ? F.in[I_GPREFFN] : ch == 5 ? F.in[I_GPOSTFFN] : nullptr;
            bias[nt] = F.in[I_BADA][col] + ((ch == 1 || ch == 4) ? 1.f : 0.f); gm[nt] = gp ? gp[cc] : 1.f; }
        for (int s = 4; s >= 1; s >>= 1) {
            if (wid >= s && wid < 2 * s) { LAS float* rb = red + (wid - s) * SLOT + lane * 4; OPAQUE(rb);
#pragma unroll
                for (int mt = 0; mt < MT; ++mt)
#pragma unroll
                    for (int nt = 0; nt < 3; ++nt) *(LAS f32x4*)(rb + (mt * 3 + nt) * 256) = acc[mt][nt];
            }
            LDS_BARRIER();
            if (s == 4) P1MARK(2);
            if (wid < s) { const LAS float* rb = red + wid * SLOT + lane * 4; OPAQUE(rb);
#pragma unroll
                for (int mt = 0; mt < MT; ++mt)
#pragma unroll
                    for (int nt = 0; nt < 3; ++nt) acc[mt][nt] += *(const LAS f32x4*)(rb + (mt * 3 + nt) * 256);
            }
            LDS_BARRIER();
        }
        P1MARK(3);
        if (wid == 0) { LAS float* rb = red + lane * 4; OPAQUE(rb);
#pragma unroll
            for (int mt = 0; mt < MT; ++mt)
#pragma unroll
                for (int nt = 0; nt < 3; ++nt) *(LAS f32x4*)(rb + (mt * 3 + nt) * 256) = acc[mt][nt];
        }
        LDS_BARRIER();
        {   const unsigned eo = (unsigned)((4 * q) * (6 * D) + n0 + 3 * c16);
            for (int mt = wid; mt < MT; mt += NWAVES) {
                f32x4 v[3];
#pragma unroll
                for (int nt = 0; nt < 3; ++nt) v[nt] = *(const LAS f32x4*)(red + (mt * 3 + nt) * 256 + lane * 4);
#pragma unroll
                for (int nt = 0; nt < 3; ++nt)
#pragma unroll
                    for (int r = 0; r < 4; ++r) { const int row = 16 * mt + 4 * q + r; if (row < NB) mod[(size_t)eo + (size_t)((16 * mt + r) * (6 * D) + nt)] = (v[nt][r] + bias[nt]) * gm[nt]; }
            }
        }
        LDS_BARRIER();
        P1MARK(4);
    }
}

constexpr int NV = D / 256;
DEVI f32x4 ld4bf(const bf16* p) { const u32x2 w = *(const u32x2*)p; return (f32x4){bf2f(w.x), bf2f(w.x >> 16), bf2f(w.y), bf2f(w.y >> 16)}; }
DEVI f32x4 up4bf(const u32x2 w) { return (f32x4){bf2f(w.x), bf2f(w.x >> 16), bf2f(w.y), bf2f(w.y >> 16)}; }
DEVI float sq4(const f32x4 v) { return (v.x * v.x + v.y * v.y) + (v.z * v.z + v.w * v.w); }
template <int KS> DEVI f32x4 slabval(const bf16* slab, int ms, int idx) {
    f32x4 a = ld4bf(slab + (size_t)ms * D + idx);
#pragma unroll
    for (int k = 1; k < KS; ++k) a += ld4bf(slab + ((size_t)k * MS + ms) * D + idx);
    return a;
}
DEVI void p2_h1(Frame& F) {
    const int gw = F.wave * F.G + F.vcu, NGW = F.G * NWAVES; const float* mod = (const float*)(F.ws + WS_MOD); bf16* H = (bf16*)(F.ws + WS_H12);
    const bool halfrows = HALF_ROWS && NGW == 2 * MS && NV % 2 == 0; const int Mloop = halfrows ? MP : M;
    int m = gw; f32x4 v[NV];
    if (m < Mloop) { const f32x4* xr = (const f32x4*)xrow(F, m) + F.lane;
#pragma unroll
        for (int j = 0; j < NV; ++j) v[j] = xr[64 * j]; }
    SFENCE();
    if (halfrows) { constexpr int NH2 = NV / 2; LAS float* xs = (LAS float*)F.lds;
        const int ms = MP + gw % MS, j0 = (gw / MS) * NH2; const f32x4* xr = (const f32x4*)xrow(F, ms) + F.lane; const float* md = mod + (size_t)modrow(ms) * 6 * D;
        f32x4 hv[NH2], sh[NH2], gs[NH2]; float s = 0.f;
#pragma unroll
        for (int j = 0; j < NH2; ++j) { const int idx = 4 * (F.lane + 64 * (j0 + j)); hv[j] = xr[64 * (j0 + j)]; sh[j] = *(const f32x4*)(md + idx); gs[j] = *(const f32x4*)(md + D + idx); s += sq4(hv[j]); }
        s = wave_sum(s); if (F.lane == 0) xs[F.wave] = s;
        LDS_BARRIER();
        const float rstd = f_rsqrt((xs[F.wave & 3] + xs[(F.wave & 3) + 4]) * (1.f / D) + EPS);
#pragma unroll
        for (int j = 0; j < NH2; ++j) { const f32x4 h = hv[j] * rstd * gs[j] + sh[j]; u32x2 o; o.x = pk2(h.x, h.y); o.y = pk2(h.z, h.w); *(u32x2*)(H + (size_t)ms * D + 4 * (F.lane + 64 * (j0 + j))) = o; }
    }
    while (m < Mloop) {
        const int mn = m + NGW; const float* md = mod + (size_t)modrow(m) * 6 * D;
        float s = 0.f;
#pragma unroll
        for (int j = 0; j < NV; ++j) s += sq4(v[j]);
        const float rstd = f_rsqrt(wave_sum(s) * (1.f / D) + EPS);
        u32x2 o[NV];
#pragma unroll
        for (int j = 0; j < NV; ++j) { const int idx = 4 * (F.lane + 64 * j);
            const f32x4 sh = *(const f32x4*)(md + idx), gs = *(const f32x4*)(md + D + idx);
            const f32x4 h = v[j] * rstd * gs + sh; o[j].x = pk2(h.x, h.y); o[j].y = pk2(h.z, h.w); }
        SFENCE();
        if (mn < Mloop) { const f32x4* xr = (const f32x4*)xrow(F, mn) + F.lane;
#pragma unroll
            for (int j = 0; j < NV; ++j) v[j] = xr[64 * j]; }
        SFENCE();
#pragma unroll
        for (int j = 0; j < NV; ++j) *(u32x2*)(H + (size_t)m * D + 4 * (F.lane + 64 * j)) = o[j];
        m = mn;
    }
}
DEVI void p8_tail(Frame& F, int m, const float* md, f32x4 (&v)[NV], const f32x4 (&xv)[NV], float sm, float& rm, u32x2 (&o)[NV]) {
    rm = f_rsqrt(wave_sum(sm) * (1.f / D) + EPS);
    float s = 0.f;
#pragma unroll
    for (int j = 0; j < NV; ++j) { const int idx = 4 * (F.lane + 64 * j);
        const f32x4 gg = *(const f32x4*)(md + 2 * D + idx);
        v[j] = xv[j] + gg * (v[j] * rm); s += sq4(v[j]); }
    const float rstd = f_rsqrt(wave_sum(s) * (1.f / D) + EPS);
#pragma unroll
    for (int j = 0; j < NV; ++j) { const int idx = 4 * (F.lane + 64 * j);
        const f32x4 sh = *(const f32x4*)(md + 3 * D + idx), gs = *(const f32x4*)(md + 4 * D + idx);
        const f32x4 h = v[j] * rstd * gs + sh; o[j].x = pk2(h.x, h.y); o[j].y = pk2(h.z, h.w); }
}
DEVI void p8_x1h2(Frame& F) {
    const int gw = F.wave * F.G + F.vcu, NGW = F.G * NWAVES; const float* mod = (const float*)(F.ws + WS_MOD); bf16* H = (bf16*)(F.ws + WS_H12);
    const bool halfrows = HALF_ROWS && NGW == 2 * MS && NV % 2 == 0;
    bf16* mixb = (bf16*)(F.ws + WS_MIX); const bf16* mixs = (const bf16*)(F.ws + WS_MIXS); float* RM = (float*)(F.ws + WS_RM);
    {
        int m = gw; f32x4 xv[NV]; u32x2 mr[NV];
        if (m < MP) { const f32x4* xr = (const f32x4*)xrow(F, m) + F.lane;
#pragma unroll
            for (int j = 0; j < NV; ++j) { xv[j] = xr[64 * j]; mr[j] = *(const u32x2*)(mixb + (size_t)m * D + 4 * (F.lane + 64 * j)); } }
    SFENCE();
    if (halfrows) { constexpr int NH2 = NV / 2; LAS float* xs = (LAS float*)F.lds;
        const int m = MP + gw % MS, j0 = (gw / MS) * NH2; const f32x4* xr = (const f32x4*)xrow(F, m) + F.lane; const float* md = mod + (size_t)modrow(m) * 6 * D;
        f32x4 v[NH2], xv[NH2]; u32x2 w[NH2], o[NH2]; float sm = 0.f;
#pragma unroll
        for (int j = 0; j < NH2; ++j) { xv[j] = xr[64 * (j0 + j)]; v[j] = slabval<KS_OUT>(mixs, m - MP, 4 * (F.lane + 64 * (j0 + j))); }
#pragma unroll
        for (int j = 0; j < NH2; ++j) { w[j].x = pk2(v[j].x, v[j].y); w[j].y = pk2(v[j].z, v[j].w); v[j] = up4bf(w[j]); sm += sq4(v[j]); }
        sm = wave_sum(sm); if (F.lane == 0) xs[F.wave] = sm;
        LDS_BARRIER();
        const float rm = f_rsqrt((xs[F.wave & 3] + xs[(F.wave & 3) + 4]) * (1.f / D) + EPS);
        float s2 = 0.f;
#pragma unroll
        for (int j = 0; j < NH2; ++j) { const int idx = 4 * (F.lane + 64 * (j0 + j)); const f32x4 gg = *(const f32x4*)(md + 2 * D + idx); v[j] = xv[j] + gg * (v[j] * rm); s2 += sq4(v[j]); }
        s2 = wave_sum(s2); if (F.lane == 0) xs[8 + F.wave] = s2;
        LDS_BARRIER();
        const float rstd = f_rsqrt((xs[8 + (F.wave & 3)] + xs[8 + (F.wave & 3) + 4]) * (1.f / D) + EPS);
#pragma unroll
        for (int j = 0; j < NH2; ++j) { const int idx = 4 * (F.lane + 64 * (j0 + j)); const f32x4 sh = *(const f32x4*)(md + 3 * D + idx), gs = *(const f32x4*)(md + 4 * D + idx);
            const f32x4 h = v[j] * rstd * gs + sh; o[j].x = pk2(h.x, h.y); o[j].y = pk2(h.z, h.w); }
        SFENCE();
        if (F.lane == 0 && j0 == 0) RM[m] = rm;
#pragma unroll
        for (int j = 0; j < NH2; ++j) { *(u32x2*)(mixb + (size_t)m * D + 4 * (F.lane + 64 * (j0 + j))) = w[j]; *(u32x2*)(H + (size_t)m * D + 4 * (F.lane + 64 * (j0 + j))) = o[j]; }
    }
        while (m < MP) {
            const int mn = m + NGW; const float* md = mod + (size_t)modrow(m) * 6 * D;
            f32x4 v[NV]; float sm = 0.f, rm; u32x2 o[NV];
#pragma unroll
            for (int j = 0; j < NV; ++j) { v[j] = up4bf(mr[j]); sm += sq4(v[j]); }
            p8_tail(F, m, md, v, xv, sm, rm, o);
            SFENCE();
            if (mn < MP) { const f32x4* xr = (const f32x4*)xrow(F, mn) + F.lane;
#pragma unroll
                for (int j = 0; j < NV; ++j) { xv[j] = xr[64 * j]; mr[j] = *(const u32x2*)(mixb + (size_t)mn * D + 4 * (F.lane + 64 * j)); } }
            SFENCE();
            if (F.lane == 0) RM[m] = rm;
#pragma unroll
            for (int j = 0; j < NV; ++j) *(u32x2*)(H + (size_t)m * D + 4 * (F.lane + 64 * j)) = o[j];
            m = mn;
        }
    }
    if (!halfrows)
    for (int m = MP + gw; m < M; m += NGW) {
        const f32x4* xr = (const f32x4*)xrow(F, m) + F.lane; const float* md = mod + (size_t)modrow(m) * 6 * D;
        f32x4 v[NV], xv[NV]; u32x2 w[NV], o[NV]; float sm = 0.f, rm;
#pragma unroll
        for (int j = 0; j < NV; ++j) { xv[j] = xr[64 * j]; v[j] = slabval<KS_OUT>(mixs, m - MP, 4 * (F.lane + 64 * j)); }
#pragma unroll
        for (int j = 0; j < NV; ++j) { w[j].x = pk2(v[j].x, v[j].y); w[j].y = pk2(v[j].z, v[j].w); v[j] = up4bf(w[j]); sm += sq4(v[j]); }
        p8_tail(F, m, md, v, xv, sm, rm, o);
        SFENCE();
        if (F.lane == 0) RM[m] = rm;
#pragma unroll
        for (int j = 0; j < NV; ++j) { *(u32x2*)(mixb + (size_t)m * D + 4 * (F.lane + 64 * j)) = w[j]; *(u32x2*)(H + (size_t)m * D + 4 * (F.lane + 64 * j)) = o[j]; }
    }
}
DEVI void p11_tail(Frame& F, const float* md, const f32x4 (&v)[NV], const f32x4 (&xv)[NV], const u32x2 (&mr)[NV], float sf, float rm, f32x4 (&res)[NV]) {
    const float rf = f_rsqrt(wave_sum(sf) * (1.f / D) + EPS);
#pragma unroll
    for (int j = 0; j < NV; ++j) { const int idx = 4 * (F.lane + 64 * j);
        const f32x4 gg1 = *(const f32x4*)(md + 2 * D + idx), gg2 = *(const f32x4*)(md + 5 * D + idx);
        const f32x4 x1 = xv[j] + gg1 * (up4bf(mr[j]) * rm);
        res[j] = x1 + gg2 * (v[j] * rf); }
}
DEVI void p11_out(Frame& F) {
    const int gw = F.wave * F.G + F.vcu, NGW = F.G * NWAVES; const float* mod = (const float*)(F.ws + WS_MOD);
    const bool halfrows = HALF_ROWS && NGW == 2 * MS && NV % 2 == 0;
    const bf16* mixb = (const bf16*)(F.ws + WS_MIX); const float* RM = (const float*)(F.ws + WS_RM);
    const bf16* fb = (const bf16*)(F.ws + WS_F); const bf16* fs = (const bf16*)(F.ws + WS_FS);
    {
        int m = gw; f32x4 xv[NV]; u32x2 mr[NV], fr[NV]; float rm = 0.f;
        if (m < MP) { const f32x4* xr = (const f32x4*)xrow(F, m) + F.lane; rm = RM[m];
#pragma unroll
            for (int j = 0; j < NV; ++j) { const size_t e = (size_t)m * D + 4 * (F.lane + 64 * j); xv[j] = xr[64 * j]; mr[j] = *(const u32x2*)(mixb + e); fr[j] = *(const u32x2*)(fb + e); } }
    SFENCE();
    if (halfrows) { constexpr int NH2 = NV / 2; LAS float* xs = (LAS float*)F.lds;
        const int m = MP + gw % MS, j0 = (gw / MS) * NH2; const float* md = mod + (size_t)modrow(m) * 6 * D; const f32x4* xr = (const f32x4*)xrow(F, m) + F.lane; f32x4* o = (f32x4*)(F.out + O_YP + (size_t)m * D) + F.lane;
        const float rm = RM[m]; f32x4 v[NH2], xv[NH2], gg1[NH2], gg2[NH2]; u32x2 mr[NH2]; float sf = 0.f;
#pragma unroll
        for (int j = 0; j < NH2; ++j) { const int idx = 4 * (F.lane + 64 * (j0 + j)); xv[j] = xr[64 * (j0 + j)]; mr[j] = *(const u32x2*)(mixb + (size_t)m * D + idx); gg1[j] = *(const f32x4*)(md + 2 * D + idx); gg2[j] = *(const f32x4*)(md + 5 * D + idx);
            v[j] = slabval<KS_DN>(fs, m - MP, idx); sf += sq4(v[j]); }
        sf = wave_sum(sf); if (F.lane == 0) xs[F.wave] = sf;
        LDS_BARRIER();
        const float rf = f_rsqrt((xs[F.wave & 3] + xs[(F.wave & 3) + 4]) * (1.f / D) + EPS);
#pragma unroll
        for (int j = 0; j < NH2; ++j) { const f32x4 x1 = xv[j] + gg1[j] * (up4bf(mr[j]) * rm); o[64 * (j0 + j)] = x1 + gg2[j] * (v[j] * rf); }
    }
        while (m < MP) {
            const int mn = m + NGW; const float* md = mod + (size_t)modrow(m) * 6 * D;
            f32x4 v[NV], res[NV]; float sf = 0.f;
#pragma unroll
            for (int j = 0; j < NV; ++j) { v[j] = up4bf(fr[j]); sf += sq4(v[j]); }
            p11_tail(F, md, v, xv, mr, sf, rm, res);
            SFENCE();
            if (mn < MP) { const f32x4* xr = (const f32x4*)xrow(F, mn) + F.lane; rm = RM[mn];
#pragma unroll
                for (int j = 0; j < NV; ++j) { const size_t e = (size_t)mn * D + 4 * (F.lane + 64 * j); xv[j] = xr[64 * j]; mr[j] = *(const u32x2*)(mixb + e); fr[j] = *(const u32x2*)(fb + e); } }
            SFENCE();
            f32x4* o = (f32x4*)(F.out + O_YP + (size_t)m * D) + F.lane;
#pragma unroll
            for (int j = 0; j < NV; ++j) o[64 * j] = res[j];
            m = mn;
        }
    }
    if (!halfrows)
    for (int m = MP + gw; m < M; m += NGW) {
        const float* md = mod + (size_t)modrow(m) * 6 * D; const f32x4* xr = (const f32x4*)xrow(F, m) + F.lane; f32x4* o = (f32x4*)(F.out + O_YP + (size_t)m * D) + F.lane;
        const float rm = RM[m]; f32x4 v[NV], xv[NV], res[NV]; u32x2 mr[NV]; float sf = 0.f;
#pragma unroll
        for (int j = 0; j < NV; ++j) { const int idx = 4 * (F.lane + 64 * j); xv[j] = xr[64 * j]; mr[j] = *(const u32x2*)(mixb + (size_t)m * D + idx); v[j] = slabval<KS_DN>(fs, m - MP, idx); sf += sq4(v[j]); }
        p11_tail(F, md, v, xv, mr, sf, rm, res);
        SFENCE();
#pragma unroll
        for (int j = 0; j < NV; ++j) o[64 * j] = res[j];
    }
}
template <int VW> DEVI void ld_bf(const bf16* p, float* o) {
    if constexpr (VW == 8) { const u32x4 w = *(const u32x4*)p; const unsigned ww[4] = {w.x, w.y, w.z, w.w};
#pragma unroll
        for (int e = 0; e < 4; ++e) { o[2 * e] = bf2f(ww[e]); o[2 * e + 1] = bf2f(ww[e] >> 16); } }
    else { const u32x2 w = *(const u32x2*)p; o[0] = bf2f(w.x); o[1] = bf2f(w.x >> 16); o[2] = bf2f(w.y); o[3] = bf2f(w.y >> 16); }
}
DEVI void p6_onorm(Frame& F, int bidx, int nblk) {
    constexpr int PL = MIX_A / 64, LPH = HD / PL, VW = PL >= 8 ? 8 : 4;
    static_assert(PL % VW == 0 && (LPH & (LPH - 1)) == 0, "onorm");
    const int gw = F.wave * nblk + bidx, NGW = nblk * NWAVES;
    const bf16* oraw = (const bf16*)(F.ws + WS_H12); const bf16* zb = (const bf16*)(F.ws + WS_ZB); bf16* acat = (bf16*)(F.ws + WS_ACAT);
    for (int m = gw; m < M; m += NGW) {
        float o[PL], z[PL]; float s = 0.f; const int c0 = F.lane * PL;
#pragma unroll
        for (int j = 0; j < PL / VW; ++j) { ld_bf<VW>(oraw + (size_t)m * D + c0 + VW * j, o + VW * j); ld_bf<VW>(zb + (size_t)m * MIX_A + c0 + VW * j, z + VW * j); }
#pragma unroll
        for (int j = 0; j < PL; ++j) s += o[j] * o[j];
#pragma unroll
        for (int d = 1; d < LPH; d <<= 1) s += __shfl_xor(s, d);
        const float rstd = f_rsqrt(s * (1.f / HD) + EPS);
#pragma unroll
        for (int j = 0; j < PL; j += 2) { const int d0 = (c0 + j) % HD;
            const float a = o[j] * rstd * F.in[I_GDN][d0] * siluf_(z[j]), b = o[j + 1] * rstd * F.in[I_GDN][d0 + 1] * siluf_(z[j + 1]);
            *(unsigned*)(acat + (size_t)m * D + MIX_B + c0 + j) = pk2(a, b); }
    }
}

using pg8::Unit;
DEVI void st8bf(bf16* p, const f32x4 v0, const f32x4 v1) { u32x4 w; w.x = pk2(v0[0], v0[1]); w.y = pk2(v0[2], v0[3]); w.z = pk2(v1[0], v1[1]); w.w = pk2(v1[2], v1[3]); *(u32x4*)p = w; }
struct EpiInProj {
    static constexpr bool PERM = true, HAS_MID = false; int tmid;
    bf16 *qkv, *z, *u; float *ab, *convp, *convs;
    DEVI void mid(f32x4 (&)[2][2][4][2], const Unit&, int, int) const {}
    DEVI void operator()(const f32x4 (&acc)[2][2][4][2], const Unit& un, int wr, int wc, int fr, int fq) const {
        const int row0 = un.pm * 256 + wr * 64 + fr, pn = un.pn;
#pragma unroll
        for (int ai = 0; ai < 2; ++ai)
#pragma unroll
            for (int m = 0; m < 4; ++m) { const int row = row0 + ai * 128 + m * 16;
                float* ct = nullptr;
                if (pn < NT_QKV) { if (row < MP) { const int t = row % SEQ; if (t >= SEQ - 3) ct = convp + ((size_t)(row / SEQ) * 3 + (t - (SEQ - 3))) * QKV; }
                                   else { const int r2 = row - MP, t = r2 % DEC_SEQ; if (t >= DEC_SEQ - 3) ct = convs + ((size_t)(r2 / DEC_SEQ) * 3 + (t - (DEC_SEQ - 3))) * QKV; } }
#pragma unroll
                for (int bj = 0; bj < 2; ++bj) { const int c0 = 128 * bj + 32 * wc + 8 * fq; const f32x4 v0 = acc[ai][bj][m][0], v1 = acc[ai][bj][m][1];
                    if (pn < NT_QKV) { const int col = pn * 256 + c0; st8bf(qkv + (size_t)row * QKV + col, v0, v1); if (ct) { *(f32x4*)(ct + col) = v0; *(f32x4*)(ct + col + 4) = v1; } }
                    else if (pn < NT_QKV + NT_Z) st8bf(z + (size_t)row * MIX_A + (pn - NT_QKV) * 256 + c0, v0, v1);
                    else if (pn < NT_QKV + NT_Z + NT_U) st8bf(u + (size_t)row * MIX_B + (pn - NT_QKV - NT_Z) * 256 + c0, v0, v1);
                    else if (c0 < 16) { *(f32x4*)(ab + (size_t)row * 16 + c0) = v0; *(f32x4*)(ab + (size_t)row * 16 + c0 + 4) = v1; } } }
    }
};
struct EpiGlu {
    static constexpr bool PERM = true, HAS_MID = false; int tmid;
    bf16* acat; unsigned long long* rs;
    DEVI void mid(f32x4 (&)[2][2][4][2], const Unit&, int, int) const {}
    DEVI void operator()(const f32x4 (&acc)[2][2][4][2], const Unit& un, int wr, int wc, int fr, int fq) const {
        const int row0 = un.pm * 256 + wr * 64 + fr, col = un.pn * 128 + 32 * wc + 8 * fq;
#pragma unroll
        for (int ai = 0; ai < 2; ++ai)
#pragma unroll
            for (int m = 0; m < 4; ++m) { const int row = row0 + ai * 128 + m * 16; f32x4 y[2]; float s = 0.f;
#pragma unroll
                for (int n = 0; n < 2; ++n)
#pragma unroll
                    for (int i = 0; i < 4; ++i) { const float v = acc[ai][0][m][n][i] * sigmoidf_(acc[ai][1][m][n][i]); y[n][i] = v; s += v * v; }
                st8bf(acat + (size_t)row * D + col, y[0], y[1]);
                s += __shfl_xor(s, 16); s += __shfl_xor(s, 32);
                if (fq == 0) atomicAdd(rs + row, (unsigned long long)(s * FX_SCALE)); }
    }
};
struct EpiSwiglu {
    static constexpr bool PERM = true, HAS_MID = false; int tmid;
    bf16* hm;
    DEVI void mid(f32x4 (&)[2][2][4][2], const Unit&, int, int) const {}
    DEVI void operator()(const f32x4 (&acc)[2][2][4][2], const Unit& un, int wr, int wc, int fr, int fq) const {
        const int row0 = un.pm * 256 + wr * 64 + fr, col = un.pn * 128 + 32 * wc + 8 * fq;
#pragma unroll
        for (int ai = 0; ai < 2; ++ai)
#pragma unroll
            for (int m = 0; m < 4; ++m) { const int row = row0 + ai * 128 + m * 16; f32x4 y[2];
#pragma unroll
                for (int n = 0; n < 2; ++n)
#pragma unroll
                    for (int i = 0; i < 4; ++i) y[n][i] = siluf_(acc[ai][0][m][n][i]) * acc[ai][1][m][n][i];
                st8bf(hm + (size_t)row * D_FF + col, y[0], y[1]); }
    }
};
template <bool MID> struct EpiF32Rs {
    static constexpr bool PERM = true, HAS_MID = MID; int tmid;
    bf16* C; bf16* slab; const unsigned long long* rs_in;
    DEVI void mid(f32x4 (&acc)[2][2][4][2], const Unit& un, int wr, int fr) const {
#pragma unroll
        for (int ai = 0; ai < 2; ++ai)
#pragma unroll
            for (int m = 0; m < 4; ++m) { const int row = un.pm * 256 + wr * 64 + fr + ai * 128 + m * 16; const float sc = f_rsqrt((float)rs_in[row] * (FX_INV / MIX_B) + EPS);
#pragma unroll
                for (int bj = 0; bj < 2; ++bj)
#pragma unroll
                    for (int n = 0; n < 2; ++n) acc[ai][bj][m][n] *= sc; }
    }
    DEVI void operator()(const f32x4 (&acc)[2][2][4][2], const Unit& un, int wr, int wc, int fr, int fq) const {
        const int row0 = un.pm * 256 + wr * 64 + fr, col0 = un.pn * 256 + wc * 32 + 8 * fq;
        bf16* base = un.ks < 0 ? C + (size_t)row0 * D : slab + ((size_t)un.ks * MS + (row0 - MP)) * D;
#pragma unroll
        for (int ai = 0; ai < 2; ++ai)
#pragma unroll
            for (int m = 0; m < 4; ++m) { bf16* rp = base + (size_t)(ai * 128 + m * 16) * D + col0;
#pragma unroll
                for (int bj = 0; bj < 2; ++bj) st8bf(rp + bj * 128, acc[ai][bj][m][0], acc[ai][bj][m][1]); }
    }
};

template <int C> struct PrepCfg { static constexpr int CP = C < 32 ? 32 : C, MT = C / 16, SC = CP / 32, LDQ = 136, LDT = CP + 8, LDL = CP + 4, XR = C + 3; };
template <int C> struct PrepLds {
    using P = PrepCfg<C>;
    static constexpr int QS = 0, KS = QS + C * P::LDQ * 2, KBS = KS + C * P::LDQ * 2, VBS = KBS + C * P::LDQ * 2, KGS = VBS + C * P::LDQ * 2, XS = KGS + C * P::LDQ * 2,
                         LS = XS, AS = LS + C * P::LDL * 4, TD = (AS + C * P::LDT * 2 + 15) & ~15, ALIAS_END = TD + P::MT * 16 * 20 * 4,
                         XEND = XS + P::XR * 384 * 2, SCAL = ((XEND > ALIAS_END ? XEND : ALIAS_END) + 15) & ~15, END = SCAL + 3 * C * 4 + 16;
};
template <int C> struct PrepPre { static constexpr int NXP = (PrepCfg<C>::XR * 48 + NTHREADS - 1) / NTHREADS; u32x4 xp[NXP]; float a_raw, b_raw; };
template <int C, int NVALID> DEVI void prep_prefetch(PrepPre<C>& P, const Frame& F, int seq_row0, int t0, int h) {
    constexpr int XR = PrepCfg<C>::XR; const bf16* qkv = (const bf16*)(F.ws + WS_QKVB); const float* ab = (const float*)(F.ws + WS_AB);
#pragma unroll
    for (int k = 0; k < PrepPre<C>::NXP; ++k) { const int p = F.tid + k * NTHREADS; u32x4 v = {0u, 0u, 0u, 0u};
        if (p < XR * 48) { const int i = p / 48, pc = p % 48, seg = pc >> 4, off = (pc & 15) * 8, j = t0 + i;
            if (j >= 3 && i - 3 < NVALID) v = *(const u32x4*)(qkv + (size_t)(seq_row0 + j - 3) * QKV + seg * MIX_A + h * HD + off); }
        P.xp[k] = v; }
    P.a_raw = 0.f; P.b_raw = 0.f;
    if (F.tid < NVALID) { const float* abr = ab + (size_t)(seq_row0 + t0 + F.tid) * 16; P.a_raw = abr[h]; P.b_raw = abr[NH + h]; }
}
template <int C, int NVALID, bool LDSF>
DEVI void delta_prep(Frame& F, LAS unsigned char* L, int seq_row0, int t0, int h, const float* conv_state, unsigned char* frag, PrepPre<C>* pre = nullptr, bool pf_next = false, int pf_row0 = 0, int pf_t0 = 0, int pf_h = 0) {
#ifndef HOST_EMU
    LAS unsigned char* fragl = (LAS unsigned char*)frag;
#else
    unsigned char* fragl = frag;
#endif
    using P = PrepCfg<C>; using O = PrepLds<C>;
    constexpr int LDQ = P::LDQ, LDT = P::LDT, LDL = P::LDL, CP = P::CP, MT = P::MT, SC = P::SC, XR = P::XR;
    LAS bf16* Qs = (LAS bf16*)(L + O::QS); LAS bf16* Ks = (LAS bf16*)(L + O::KS); LAS bf16* Kbs = (LAS bf16*)(L + O::KBS); LAS bf16* VbS = (LAS bf16*)(L + O::VBS); LAS bf16* KgS = (LAS bf16*)(L + O::KGS);
    LAS bf16* Xs = (LAS bf16*)(L + O::XS); LAS float* Ls = (LAS float*)(L + O::LS); LAS bf16* As = (LAS bf16*)(L + O::AS); LAS float* Td = (LAS float*)(L + O::TD);
    LAS float* gcs = (LAS float*)(L + O::SCAL); LAS float* bts = gcs + C; LAS float* egs = bts + C;
    const bf16* qkv = (const bf16*)(F.ws + WS_QKVB); const float* ab = (const float*)(F.ws + WS_AB);
    const int lane = F.lane, wid = F.wave, tid = F.tid, q4 = lane >> 4, c16 = lane & 15;
    if (wid == 0) {
        float g = 0.f, bt = 0.f;
        if (lane < NVALID) { float ar, br; if (pre) { ar = pre->a_raw; br = pre->b_raw; } else { const float* abr = ab + (size_t)(seq_row0 + t0 + lane) * 16; ar = abr[h]; br = abr[NH + h]; }
            const float x = ar + F.in[I_DTBIAS][h];
            const float sp = x > 20.f ? x : log1pf(f_exp(x)); g = -f_exp(F.in[I_ALOG][h]) * sp; bt = sigmoidf_(br); }
        float gc = g;
#pragma unroll
        for (int d = 1; d < 64; d <<= 1) { const float o = __shfl_up(gc, d); if (lane >= d) gc += o; }
        if (lane < C) { gcs[lane] = gc; bts[lane] = bt; egs[lane] = f_exp(gc); }
    }
    if (pre) {
#pragma unroll
        for (int k = 0; k < PrepPre<C>::NXP; ++k) { const int p = tid + k * NTHREADS; if (p < XR * 48) { const int i = p / 48, pc = p % 48, seg = pc >> 4, off = (pc & 15) * 8; *(LAS u32x4*)(Xs + i * 384 + seg * 128 + off) = pre->xp[k]; } }
        if (pf_next) prep_prefetch<C, NVALID>(*pre, F, pf_row0, pf_t0, pf_h);
    } else
    for (int p = tid; p < XR * 48; p += NTHREADS) {
        const int i = p / 48, pc = p % 48, seg = pc >> 4, off = (pc & 15) * 8; const int j = t0 + i;
        u32x4 v = {0u, 0u, 0u, 0u}; const int gcol = seg * MIX_A + h * HD + off;
        if (j < 3) { if (conv_state) { const f32x4 a = *(const f32x4*)(conv_state + (size_t)j * QKV + gcol), b = *(const f32x4*)(conv_state + (size_t)j * QKV + gcol + 4);
                                       v = (u32x4){pk2(a.x, a.y), pk2(a.z, a.w), pk2(b.x, b.y), pk2(b.z, b.w)}; } }
        else if (i - 3 < NVALID) v = *(const u32x4*)(qkv + (size_t)(seq_row0 + j - 3) * QKV + gcol);
        *(LAS u32x4*)(Xs + i * 384 + seg * 128 + off) = v;
    }
    LDS_BARRIER();
    {
        constexpr int RW = C / 8; constexpr bool ALLV = NVALID >= C; const float* wc_ = F.in[I_WCONV];
        const int tb = wid * RW;
        f32x2_ wv[3][4], win[3][3];
#pragma unroll
        for (int sg = 0; sg < 3; ++sg) {
#pragma unroll
            for (int j = 0; j < 4; ++j) wv[sg][j] = *(const f32x2_*)(wc_ + (size_t)j * QKV + sg * MIX_A + h * HD + 2 * lane);
#pragma unroll
            for (int j = 0; j < 3; ++j) { const unsigned x = *(const LAS unsigned*)(Xs + (tb + j) * 384 + sg * 128 + 2 * lane); win[sg][j] = (f32x2_){__builtin_bit_cast(float, x << 16), __builtin_bit_cast(float, x & 0xffff0000u)}; } }
        constexpr int RB = RW < 4 ? RW : 4;
#pragma unroll
        for (int r0 = 0; r0 < RW; r0 += RB) {
            f32x2_ val[RB][3]; float sq[RB], sk[RB];
#pragma unroll
            for (int r = 0; r < RB; ++r) { const int t = tb + r0 + r; const bool valid = ALLV || t < NVALID;
#pragma unroll
                for (int sg = 0; sg < 3; ++sg) { const unsigned x = *(const LAS unsigned*)(Xs + (t + 3) * 384 + sg * 128 + 2 * lane);
                    const f32x2_ cur = {__builtin_bit_cast(float, x << 16), __builtin_bit_cast(float, x & 0xffff0000u)};
                    const f32x2_ cv = wv[sg][0] * win[sg][0] + wv[sg][1] * win[sg][1] + wv[sg][2] * win[sg][2] + wv[sg][3] * cur;
                    win[sg][0] = win[sg][1]; win[sg][1] = win[sg][2]; win[sg][2] = cur;
                    f32x2_ e; e.x = f_exp(-cv.x); e.y = f_exp(-cv.y); e = e + 1.0f; f32x2_ rc; rc.x = f_rcp(e.x); rc.y = f_rcp(e.y);
                    const f32x2_ sv = cv * rc; val[r][sg] = valid ? sv : (f32x2_){0.f, 0.f}; }
                sq[r] = val[r][0].x * val[r][0].x + val[r][0].y * val[r][0].y; sk[r] = val[r][1].x * val[r][1].x + val[r][1].y * val[r][1].y; }
#pragma unroll
            for (int o = 1; o < 64; o <<= 1) {
#pragma unroll
                for (int r = 0; r < RB; ++r) { sq[r] += __shfl_xor(sq[r], o); sk[r] += __shfl_xor(sk[r], o); } }
#pragma unroll
            for (int r = 0; r < RB; ++r) { const int t = tb + r0 + r;
                const float rq = f_rsqrt(sq[r] + 1e-6f) * 0.08838834764831845f, rk = f_rsqrt(sk[r] + 1e-6f);
                const float bt = bts[t], eg = egs[t];
                const f32x2_ qn = val[r][0] * rq, kn = val[r][1] * rk, kb = kn * bt, vb = val[r][2] * bt, kg = kb * eg;
                *(LAS unsigned*)(Qs + t * LDQ + 2 * lane) = pk2(qn.x, qn.y); *(LAS unsigned*)(Ks + t * LDQ + 2 * lane) = pk2(kn.x, kn.y); *(LAS unsigned*)(Kbs + t * LDQ + 2 * lane) = pk2(kb.x, kb.y);
                *(LAS unsigned*)(VbS + t * LDQ + 2 * lane) = pk2(vb.x, vb.y); *(LAS unsigned*)(KgS + t * LDQ + 2 * lane) = pk2(kg.x, kg.y);
            }
        }
    }
    LDS_BARRIER();
    if constexpr (CP > C) {
        for (int i = tid; i < C * (CP - C); i += NTHREADS) { const int r = i / (CP - C), c = C + i % (CP - C); As[r * LDT + c] = 0; }
    }
    for (int tix = wid; tix < 2 * MT * MT; tix += NWAVES) {
        const int which = tix / (MT * MT), mi = (tix % (MT * MT)) / MT, nj = tix % MT;
        if (nj > mi) {
            if (which == 0) { for (int r = 0; r < 4; ++r) Ls[(16 * mi + 4 * q4 + r) * LDL + 16 * nj + c16] = 0.f; }
            else { for (int r = 0; r < 4; ++r) As[(16 * mi + 4 * q4 + r) * LDT + 16 * nj + c16] = 0; }
            continue; }
        const LAS bf16* A = which == 0 ? Kbs : Qs; f32x4 acc = {0.f, 0.f, 0.f, 0.f};
#pragma unroll
        for (int s = 0; s < 4; ++s) { const bf16x8 a = *(const LAS bf16x8*)(A + (16 * mi + c16) * LDQ + 32 * s + 8 * q4), b = *(const LAS bf16x8*)(Ks + (16 * nj + c16) * LDQ + 32 * s + 8 * q4);
            acc = __builtin_amdgcn_mfma_f32_16x16x32_bf16(a, b, acc, 0, 0, 0); }
        const int j = 16 * nj + c16; const float gj = gcs[j];
#pragma unroll
        for (int r = 0; r < 4; ++r) { const int i = 16 * mi + 4 * q4 + r; const float dec = f_exp(gcs[i] - gj);
            if (which == 0) Ls[i * LDL + j] = (i > j) ? acc[r] * dec : 0.f;
            else As[i * LDT + j] = (bf16)((i >= j) ? f2bf(acc[r] * dec) : 0u); }
    }
    LDS_BARRIER();
    if (wid == 0) {
        const int bk = lane >> 4;
        if (bk < MT) {
            float x[16];
#pragma unroll
            for (int i = 0; i < 16; ++i) { float sacc = (i == c16) ? 1.f : 0.f;
#pragma unroll
                for (int j = 0; j < i; ++j) sacc -= Ls[(16 * bk + i) * LDL + 16 * bk + j] * x[j];
                x[i] = sacc; Td[(bk * 16 + i) * 20 + c16] = sacc; }
        }
    } else {
        const float gl = gcs[C - 1];
        for (int i = tid - 64; i < C * 64; i += NTHREADS - 64) { const int t = i >> 6, c = (i & 63) * 2; const float eq = egs[t], ek = f_exp(gl - gcs[t]);
            const unsigned qx = *(LAS unsigned*)(Qs + t * LDQ + c), kx = *(LAS unsigned*)(Ks + t * LDQ + c);
            *(LAS unsigned*)(Qs + t * LDQ + c) = pk2(bf2f(qx) * eq, bf2f(qx >> 16) * eq); *(LAS unsigned*)(Ks + t * LDQ + c) = pk2(bf2f(kx) * ek, bf2f(kx >> 16) * ek); }
    }
    LDS_BARRIER();
    {
        bf16x8 tdf[MT];
#pragma unroll
        for (int rb = 0; rb < MT; ++rb) { const f32x4 t4 = *(const LAS f32x4*)(Td + (rb * 16 + c16) * 20 + 4 * q4); u32x4 p = {pk2(t4[0], t4[1]), pk2(t4[2], t4[3]), 0u, 0u}; tdf[rb] = __builtin_bit_cast(bf16x8, p); }
#pragma unroll
        for (int tt = 0; tt < 2; ++tt) {
            const int nt = 2 * wid + tt; const LAS bf16* R = (nt < 8 ? VbS : KgS) + 16 * (nt & 7) + c16;
            u32x4 xb[SC];
#pragma unroll
            for (int s = 0; s < SC; ++s) xb[s] = (u32x4){0u, 0u, 0u, 0u};
#pragma unroll
            for (int rb = 0; rb < MT; ++rb) {
                f32x4 acc;
#pragma unroll
                for (int r = 0; r < 4; ++r) acc[r] = bf2f(R[(16 * rb + 4 * q4 + r) * LDQ]);
#pragma unroll
                for (int s = 0; s < (rb + 1) / 2; ++s) {
                    const f32x4 l0 = *(const LAS f32x4*)(Ls + (16 * rb + c16) * LDL + 32 * s + 4 * q4), l1 = *(const LAS f32x4*)(Ls + (16 * rb + c16) * LDL + 32 * s + 16 + 4 * q4);
                    const u32x4 p = {pk2(-l0[0], -l0[1]), pk2(-l0[2], -l0[3]), pk2(-l1[0], -l1[1]), pk2(-l1[2], -l1[3])};
                    acc = __builtin_amdgcn_mfma_f32_16x16x32_bf16(__builtin_bit_cast(bf16x8, p), __builtin_bit_cast(bf16x8, xb[s]), acc, 0, 0, 0); }
                const u32x4 pa = {pk2(acc[0], acc[1]), pk2(acc[2], acc[3]), 0u, 0u}; const f32x4 z4 = {0.f, 0.f, 0.f, 0.f};
                const f32x4 xr = __builtin_amdgcn_mfma_f32_16x16x32_bf16(tdf[rb], __builtin_bit_cast(bf16x8, pa), z4, 0, 0, 0);
                if (rb & 1) { xb[rb >> 1].z = pk2(xr[0], xr[1]); xb[rb >> 1].w = pk2(xr[2], xr[3]); } else { xb[rb >> 1].x = pk2(xr[0], xr[1]); xb[rb >> 1].y = pk2(xr[2], xr[3]); }
                if (nt < 8) { const size_t fo = FR_U + ((size_t)(nt * MT + rb) * 64 + lane) * 16; if constexpr (LDSF) *(LAS f32x4*)(fragl + fo) = xr; else *(f32x4*)(frag + fo) = xr; }
                else {
#pragma unroll
                    for (int r = 0; r < 4; ++r) Kbs[(16 * rb + 4 * q4 + r) * LDQ + 16 * (nt - 8) + c16] = (bf16)f2bf(-xr[r]); }
            }
        }
    }
    LDS_BARRIER();
    constexpr int NFW = MT * 4, NFA = MT * SC, NFK = 8 * SC, NF = 2 * NFW + NFA + NFK;
    for (int it = tid; it < NF * 64; it += NTHREADS) {
        const int f = it >> 6, l = it & 63, i16 = l & 15, q = l >> 4; u32x4 o;
        if (f < 2 * NFW) { const int which = f / NFW, ff = f % NFW, m = ff / 4, s = ff % 4; const LAS bf16* src = (which == 0 ? Kbs : Qs) + (16 * m + i16) * LDQ + 32 * s + 4 * q;
            const u32x2 lo = *(const LAS u32x2*)src, hi = *(const LAS u32x2*)(src + 16); o = (u32x4){lo.x, lo.y, hi.x, hi.y};
            const size_t fo = (which == 0 ? FR_W : FR_Q) + ((size_t)ff * 64 + l) * 16; if constexpr (LDSF) *(LAS u32x4*)(fragl + fo) = o; else *(u32x4*)(frag + fo) = o; }
        else if (f < 2 * NFW + NFA) { const int ff = f - 2 * NFW, m = ff / SC, s = ff % SC; const LAS bf16* src = As + (16 * m + i16) * LDT + 32 * s + 4 * q;
            const u32x2 lo = *(const LAS u32x2*)src, hi = *(const LAS u32x2*)(src + 16); o = (u32x4){lo.x, lo.y, hi.x, hi.y};
            const size_t fo = FR_A + ((size_t)ff * 64 + l) * 16; if constexpr (LDSF) *(LAS u32x4*)(fragl + fo) = o; else *(u32x4*)(frag + fo) = o; }
        else { const int ff = f - 2 * NFW - NFA, T = ff / SC, s = ff % SC; unsigned e[8];
#pragma unroll
            for (int j = 0; j < 8; ++j) { const int c = 32 * s + 16 * (j >> 2) + 4 * q + (j & 3); e[j] = (c < C) ? (unsigned)Ks[c * LDQ + 16 * T + i16] : 0u; }
            o = (u32x4){e[0] | (e[1] << 16), e[2] | (e[3] << 16), e[4] | (e[5] << 16), e[6] | (e[7] << 16)};
            const size_t fo = FR_K + ((size_t)ff * 64 + l) * 16; if constexpr (LDSF) *(LAS u32x4*)(fragl + fo) = o; else *(u32x4*)(frag + fo) = o; }
    }
    if (tid == 0) { if constexpr (LDSF) *(LAS float*)(fragl + FR_SC) = egs[C - 1]; else *(float*)(frag + FR_SC) = egs[C - 1]; }
    LDS_BARRIER();
}

template <int C, int NVALID, bool LDSF>
DEVI void delta_apply(const unsigned char* frag, size_t fstride, int nchunks, f32x4 (&S)[8]  , float* Sout, bf16* oraw_base  , int vs, int lane) {
    using P = PrepCfg<C>; constexpr int MT = P::MT, SC = P::SC;
    const int q = lane >> 4, c16 = lane & 15;
#ifndef HOST_EMU
    const LAS unsigned char* fragl = (const LAS unsigned char*)frag;
#else
    const unsigned char* fragl = frag;
#endif
#define FLD(T_, off) (LDSF ? *(const LAS T_*)(fragl + (off)) : *(const T_*)(frag + (off)))
    for (int n = 0; n < nchunks; ++n, frag += fstride) {
        const float egl = FLD(float, FR_SC);
        bf16x8 Sb[4];
#pragma unroll
        for (int s = 0; s < 4; ++s) { u32x4 p; p.x = pk2(S[2 * s][0], S[2 * s][1]); p.y = pk2(S[2 * s][2], S[2 * s][3]); p.z = pk2(S[2 * s + 1][0], S[2 * s + 1][1]); p.w = pk2(S[2 * s + 1][2], S[2 * s + 1][3]); Sb[s] = __builtin_bit_cast(bf16x8, p); }
        f32x4 vn[MT], o[MT];
#pragma unroll
        for (int m = 0; m < MT; ++m) { vn[m] = FLD(f32x4, FR_U + ((size_t)(vs * MT + m) * 64 + lane) * 16); o[m] = (f32x4){0.f, 0.f, 0.f, 0.f};
#pragma unroll
            for (int s = 0; s < 4; ++s) { const bf16x8 w = FLD(bf16x8, FR_W + ((size_t)(m * 4 + s) * 64 + lane) * 16), qf = FLD(bf16x8, FR_Q + ((size_t)(m * 4 + s) * 64 + lane) * 16);
                vn[m] = __builtin_amdgcn_mfma_f32_16x16x32_bf16(w, Sb[s], vn[m], 0, 0, 0); o[m] = __builtin_amdgcn_mfma_f32_16x16x32_bf16(qf, Sb[s], o[m], 0, 0, 0); } }
        bf16x8 vb[SC];
#pragma unroll
        for (int s = 0; s < SC; ++s) { u32x4 p; p.x = pk2(vn[2 * s < MT ? 2 * s : 0][0], vn[2 * s < MT ? 2 * s : 0][1]); p.y = pk2(vn[2 * s < MT ? 2 * s : 0][2], vn[2 * s < MT ? 2 * s : 0][3]);
            if (2 * s + 1 < MT) { p.z = pk2(vn[2 * s + 1 < MT ? 2 * s + 1 : 0][0], vn[2 * s + 1 < MT ? 2 * s + 1 : 0][1]); p.w = pk2(vn[2 * s + 1 < MT ? 2 * s + 1 : 0][2], vn[2 * s + 1 < MT ? 2 * s + 1 : 0][3]); } else { p.z = 0u; p.w = 0u; }
            vb[s] = __builtin_bit_cast(bf16x8, p); }
#pragma unroll
        for (int m = 0; m < MT; ++m)
#pragma unroll
            for (int s = 0; s < SC; ++s) { const bf16x8 a = FLD(bf16x8, FR_A + ((size_t)(m * SC + s) * 64 + lane) * 16); o[m] = __builtin_amdgcn_mfma_f32_16x16x32_bf16(a, vb[s], o[m], 0, 0, 0); }
#pragma unroll
        for (int T = 0; T < 8; ++T) { S[T] *= egl;
#pragma unroll
            for (int s = 0; s < SC; ++s) { const bf16x8 kf = FLD(bf16x8, FR_K + ((size_t)(T * SC + s) * 64 + lane) * 16); S[T] = __builtin_amdgcn_mfma_f32_16x16x32_bf16(kf, vb[s], S[T], 0, 0, 0); } }
#pragma unroll
        for (int m = 0; m < MT; ++m)
#pragma unroll
            for (int r = 0; r < 4; ++r) { const int c = 16 * m + 4 * q + r; if (c < NVALID) oraw_base[(size_t)(n * C + c) * D + 16 * vs + c16] = (bf16)f2bf(o[m][r]); }
    }
#pragma unroll
    for (int T = 0; T < 8; ++T) { float* sp = Sout + (size_t)(16 * T + 4 * q) * HD + 16 * vs + c16; sp[0] = S[T][0]; sp[HD] = S[T][1]; sp[2 * HD] = S[T][2]; sp[3 * HD] = S[T][3]; }
#undef FLD
}

DEVI void p4_prep(Frame& F) {
    constexpr int NC = SEQ / CHUNK;
    PrepPre<CHUNK> pre;
    if (F.vcu < NCHUNK_P) { const int u = F.vcu, n = u % NC, bh = u / NC; prep_prefetch<CHUNK, CHUNK>(pre, F, (bh / NH) * SEQ, n * CHUNK, bh % NH); }
    for (int u = F.vcu; u < NCHUNK_P; u += F.G) {
        const int n = u % NC, bh = u / NC, h = bh % NH, b = bh / NH;
        const int u2 = u + F.G, n2 = u2 % NC, bh2 = u2 / NC;
        delta_prep<CHUNK, CHUNK, false>(F, F.lds, b * SEQ, n * CHUNK, h, nullptr, F.ws + WS_FRAG + (size_t)u * CHUNK_BYTES, &pre, u2 < NCHUNK_P, (bh2 / NH) * SEQ, n2 * CHUNK, bh2 % NH);
    }
}

template <bool SAMPLE>
DEVI void s5_job(Frame& F, LAS unsigned char* L  , int row0, int nrows, int g, int b0) {
    const int lane = F.lane, hi = lane >> 5, l31 = lane & 31, q = lane >> 4, c16 = lane & 15;
    LAS float* BUT = (LAS float*)L;
    LAS unsigned* Hs = (LAS unsigned*)(L + 10240);
    const bf16* ub = (const bf16*)(F.ws + WS_UB); bf16* y5 = (bf16*)(F.ws + WS_Y5);
    float are, aim;
    {
        const float lre = fminf(F.in[I_LAMRE][g * NP + lane], -1e-4f), lim = F.in[I_LAMIM][g * NP + lane], dt = f_exp(F.in[I_LOGSTEP][g]);
        const float mag = f_exp(lre * dt), ang = lim * dt; are = mag * f_cos(ang); aim = mag * f_sin(ang);
    }
    bf16x8 bbf[4];
#pragma unroll
    for (int nt = 0; nt < 4; ++nt) { const int pp = 32 * nt + l31, p = pp & 63;
        const float lre = fminf(F.in[I_LAMRE][g * NP + p], -1e-4f), lim = F.in[I_LAMIM][g * NP + p], dt = f_exp(F.in[I_LOGSTEP][g]);
        const float mag = f_exp(lre * dt), ang = lim * dt, nr = mag * f_cos(ang) - 1.f, ni = mag * f_sin(ang), den = lre * lre + lim * lim;
        const float cre = (nr * lre + ni * lim) / den, cim = (ni * lre - nr * lim) / den;
        const float* br = F.in[I_BRE] + ((size_t)g * NP + p) * 16 + 8 * hi; const float* bi = F.in[I_BIM] + ((size_t)g * NP + p) * 16 + 8 * hi; float e[8];
#pragma unroll
        for (int j = 0; j < 8; ++j) e[j] = pp < 64 ? cre * br[j] - cim * bi[j] : cre * bi[j] + cim * br[j];
        u32x4 pk; pk.x = pk2(e[0], e[1]); pk.y = pk2(e[2], e[3]); pk.z = pk2(e[4], e[5]); pk.w = pk2(e[6], e[7]); bbf[nt] = __builtin_bit_cast(bf16x8, pk); }
    bf16x8 ccf[4];
#pragma unroll
    for (int s = 0; s < 4; ++s) { float e[8];
#pragma unroll
        for (int j = 0; j < 8; ++j) { const int p = 16 * s + 4 * q + (j >> 1); e[j] = (j & 1) ? -F.in[I_CIM][((size_t)g * 16 + c16) * NP + p] : F.in[I_CRE][((size_t)g * 16 + c16) * NP + p]; }
        u32x4 pk; pk.x = pk2(e[0], e[1]); pk.y = pk2(e[2], e[3]); pk.z = pk2(e[4], e[5]); pk.w = pk2(e[6], e[7]); ccf[s] = __builtin_bit_cast(bf16x8, pk); }
    const float dsk = F.in[I_DSKIP][g * 16 + c16];
    float hre = 0.f, him = 0.f;
    for (int r0 = 0; r0 < nrows; r0 += 32) {
        const bf16x8 uf = *(const bf16x8*)(ub + (size_t)(row0 + r0 + l31) * MIX_B + g * 16 + 8 * hi);
        f32x16 bu[4];
#pragma unroll
        for (int nt = 0; nt < 4; ++nt) { const f32x16 z = {0.f, 0.f, 0.f, 0.f, 0.f, 0.f, 0.f, 0.f, 0.f, 0.f, 0.f, 0.f, 0.f, 0.f, 0.f, 0.f}; bu[nt] = __builtin_amdgcn_mfma_f32_32x32x16_bf16(uf, bbf[nt], z, 0, 0, 0); }
#pragma unroll
        for (int hf = 0; hf < 2; ++hf) {
            WAVE_LDS_SYNC();
#pragma unroll
            for (int nt = 0; nt < 4; ++nt)
#pragma unroll
                for (int i2 = 0; i2 < 2; ++i2) { const int i = 2 * hf + i2; *(LAS f32x4*)(BUT + (32 * nt + l31) * 20 + 8 * i2 + 4 * hi) = (f32x4){bu[nt][4 * i], bu[nt][4 * i + 1], bu[nt][4 * i + 2], bu[nt][4 * i + 3]}; }
            WAVE_LDS_SYNC();
            float br_[16], bi_[16];
#pragma unroll
            for (int j = 0; j < 4; ++j) { const f32x4 a = *(const LAS f32x4*)(BUT + lane * 20 + 4 * j), b = *(const LAS f32x4*)(BUT + (64 + lane) * 20 + 4 * j);
                br_[4 * j] = a[0]; br_[4 * j + 1] = a[1]; br_[4 * j + 2] = a[2]; br_[4 * j + 3] = a[3]; bi_[4 * j] = b[0]; bi_[4 * j + 1] = b[1]; bi_[4 * j + 2] = b[2]; bi_[4 * j + 3] = b[3]; }
#pragma unroll
            for (int tt = 0; tt < 16; ++tt) {
                if (SAMPLE && (tt & 7) == 0) { const int b = b0 + (r0 + 16 * hf + tt) / 8; hre = F.in[I_SSRE][((size_t)b * NG + g) * NP + lane]; him = F.in[I_SSIM][((size_t)b * NG + g) * NP + lane]; }
                const float nre = are * hre - aim * him + br_[tt], nim = are * him + aim * hre + bi_[tt]; hre = nre; him = nim;
                Hs[tt * 68 + lane] = pk2(hre, him);
                if (SAMPLE && (tt & 7) == 7) { const int b = b0 + (r0 + 16 * hf + tt) / 8; F.out[O_SRES + ((size_t)b * NG + g) * NP + lane] = hre; F.out[O_SIMS + ((size_t)b * NG + g) * NP + lane] = him; }
            }
            WAVE_LDS_SYNC();
            f32x4 y = {0.f, 0.f, 0.f, 0.f};
#pragma unroll
            for (int s = 0; s < 4; ++s) { const bf16x8 a = *(const LAS bf16x8*)(Hs + c16 * 68 + 16 * s + 4 * q); y = __builtin_amdgcn_mfma_f32_16x16x32_bf16(a, ccf[s], y, 0, 0, 0); }
#pragma unroll
            for (int r = 0; r < 4; ++r) { const size_t row = (size_t)(row0 + r0 + 16 * hf + 4 * q + r); const float u = bf2f(ub[row * MIX_B + g * 16 + c16]);
                y5[row * MIX_B + g * 16 + c16] = (bf16)f2bf(geluf_(y[r] + dsk * u)); }
        }
    }
    if (!SAMPLE) { F.out[O_SREP + ((size_t)b0 * NG + g) * NP + lane] = hre; F.out[O_SIMP + ((size_t)b0 * NG + g) * NP + lane] = him; }
}

struct DaFr { f32x4 u; bf16x8 wq[4]; bf16x8 a[2]; bf16x8 k[2]; float egl; };
DEVI void da_load(DaFr& f, const unsigned char* frag, int vs, int m, int role, int T, int lane) {
    const unsigned l16 = (unsigned)lane * 16u;
    f.egl = *(const float*)(frag + FR_SC);
    f.u = (f32x4){0.f, 0.f, 0.f, 0.f};
    if (role == 0) f.u = *(const f32x4*)(frag + (FR_U + (unsigned)(vs * 4 + m) * 1024u + l16));
    const unsigned wqo = (role == 0 ? FR_W : FR_Q) + (unsigned)(m * 4) * 1024u + l16;
#pragma unroll
    for (int s = 0; s < 4; ++s) f.wq[s] = *(const bf16x8*)(frag + (wqo + (unsigned)s * 1024u));
    const unsigned ao = FR_A + (unsigned)(m * 2) * 1024u + l16, ko = FR_K + (unsigned)(T * 2) * 1024u + l16;
#pragma unroll
    for (int s = 0; s < 2; ++s) { f.a[s] = *(const bf16x8*)(frag + (ao + (unsigned)s * 1024u)); f.k[s] = *(const bf16x8*)(frag + (ko + (unsigned)s * 1024u)); }
}
#define TSEG(k) do { if (TS_PHASE >= 60 && TS_PHASE < 70) { const unsigned long long tn_ = __builtin_amdgcn_s_memrealtime(); if (TS_PHASE - 60 == (k)) tsacc += tn_ - tprev; tprev = tn_; } } while (0)
DEVI void delta_apply8(Frame& F, LAS unsigned char* L, const unsigned char* frag, size_t fstride, int nchunks, float* Sout, bf16* oraw_base, int vs, unsigned long long& tsacc) {
    unsigned long long tprev = 0;
    const int w = F.wave, lane = F.lane, q = lane >> 4, c16 = lane & 15, m = w & 3, role = w >> 2, T = w;
    LAS unsigned char* SbL = L; LAS unsigned char* vbL = L + 4096;
    f32x4 S = {0.f, 0.f, 0.f, 0.f};
    *(LAS u32x2*)(SbL + ((T >> 1) * 64 + lane) * 16 + 8 * (T & 1)) = (u32x2){0u, 0u};
    DaFr f0, f1, f2;
    da_load(f0, frag, vs, m, role, T, lane); f1 = f0; f2 = f0;
    if (1 < nchunks) da_load(f1, frag + fstride, vs, m, role, T, lane);
    if (2 < nchunks) da_load(f2, frag + 2 * fstride, vs, m, role, T, lane);
    LDS_BARRIER();
#define DA_STEP(cur, n) do { \
        TSEG(9); f32x4 acc = cur.u; \
        _Pragma("unroll") for (int s = 0; s < 4; ++s) { const bf16x8 sb = *(const LAS bf16x8*)(SbL + (s * 64 + lane) * 16); acc = __builtin_amdgcn_mfma_f32_16x16x32_bf16(cur.wq[s], sb, acc, 0, 0, 0); } \
        if (role == 0) *(LAS u32x2*)(vbL + ((m >> 1) * 64 + lane) * 16 + 8 * (m & 1)) = (u32x2){pk2(acc[0], acc[1]), pk2(acc[2], acc[3])}; \
        TSEG(0); LDS_BARRIER(); TSEG(1); \
        bf16x8 vb[2]; \
        _Pragma("unroll") for (int s = 0; s < 2; ++s) vb[s] = *(const LAS bf16x8*)(vbL + (s * 64 + lane) * 16); \
        if (role == 1) { \
            _Pragma("unroll") for (int s = 0; s < 2; ++s) acc = __builtin_amdgcn_mfma_f32_16x16x32_bf16(cur.a[s], vb[s], acc, 0, 0, 0); \
            char* op = (char*)oraw_base + (unsigned)((((n) * CHUNK + 16 * m + 4 * q) * D + 16 * vs + c16) * 2); \
            *(bf16*)op = (bf16)f2bf(acc[0]); *(bf16*)(op + 2 * D) = (bf16)f2bf(acc[1]); *(bf16*)(op + 4 * D) = (bf16)f2bf(acc[2]); *(bf16*)(op + 6 * D) = (bf16)f2bf(acc[3]); \
        } \
        S *= cur.egl; \
        _Pragma("unroll") for (int s = 0; s < 2; ++s) S = __builtin_amdgcn_mfma_f32_16x16x32_bf16(cur.k[s], vb[s], S, 0, 0, 0); \
        *(LAS u32x2*)(SbL + ((T >> 1) * 64 + lane) * 16 + 8 * (T & 1)) = (u32x2){pk2(S[0], S[1]), pk2(S[2], S[3])}; \
        TSEG(2); LDS_BARRIER(); TSEG(3); \
        if ((n) + 3 < nchunks) da_load(cur, frag + (size_t)((n) + 3) * fstride, vs, m, role, T, lane); \
        TSEG(4); \
    } while (0)
    for (int n = 0; n < nchunks; n += 3) {
        DA_STEP(f0, n);
        if (n + 1 < nchunks) DA_STEP(f1, n + 1);
        if (n + 2 < nchunks) DA_STEP(f2, n + 2);
    }
#undef DA_STEP
    float* sp = Sout + (size_t)(16 * T + 4 * q) * HD + 16 * vs + c16; sp[0] = S[0]; sp[HD] = S[1]; sp[2 * HD] = S[2]; sp[3 * HD] = S[3];
}

struct S5C { float are, aim; bf16x8 bbf[4], ccf[4]; float dsk; };
DEVI void s5_consts(S5C& c, const Frame& F, int g, int lane) {
    const int hi = lane >> 5, l31 = lane & 31, q = lane >> 4, c16 = lane & 15;
    { const float lre = fminf(F.in[I_LAMRE][g * NP + lane], -1e-4f), lim = F.in[I_LAMIM][g * NP + lane], dt = f_exp(F.in[I_LOGSTEP][g]);
      const float mag = f_exp(lre * dt), ang = lim * dt; c.are = mag * f_cos(ang); c.aim = mag * f_sin(ang); }
#pragma unroll
    for (int nt = 0; nt < 4; ++nt) { const int pp = 32 * nt + l31, p = pp & 63;
        const float lre = fminf(F.in[I_LAMRE][g * NP + p], -1e-4f), lim = F.in[I_LAMIM][g * NP + p], dt = f_exp(F.in[I_LOGSTEP][g]);
        const float mag = f_exp(lre * dt), ang = lim * dt, nr = mag * f_cos(ang) - 1.f, ni = mag * f_sin(ang), den = lre * lre + lim * lim;
        const float cre = (nr * lre + ni * lim) / den, cim = (ni * lre - nr * lim) / den;
        const float* br = F.in[I_BRE] + ((size_t)g * NP + p) * 16 + 8 * hi; const float* bi = F.in[I_BIM] + ((size_t)g * NP + p) * 16 + 8 * hi; float e[8];
#pragma unroll
        for (int j = 0; j < 8; ++j) e[j] = pp < 64 ? cre * br[j] - cim * bi[j] : cre * bi[j] + cim * br[j];
        u32x4 pk; pk.x = pk2(e[0], e[1]); pk.y = pk2(e[2], e[3]); pk.z = pk2(e[4], e[5]); pk.w = pk2(e[6], e[7]); c.bbf[nt] = __builtin_bit_cast(bf16x8, pk); }
#pragma unroll
    for (int s = 0; s < 4; ++s) { float e[8];
#pragma unroll
        for (int j = 0; j < 8; ++j) { const int p = 16 * s + 4 * q + (j >> 1); e[j] = (j & 1) ? -F.in[I_CIM][((size_t)g * 16 + c16) * NP + p] : F.in[I_CRE][((size_t)g * 16 + c16) * NP + p]; }
        u32x4 pk; pk.x = pk2(e[0], e[1]); pk.y = pk2(e[2], e[3]); pk.z = pk2(e[4], e[5]); pk.w = pk2(e[6], e[7]); c.ccf[s] = __builtin_bit_cast(bf16x8, pk); }
    c.dsk = F.in[I_DSKIP][g * 16 + c16];
}
DEVI void s5_block(Frame& F, LAS unsigned char* L, LAS unsigned char* X, int b, int g) {
    constexpr int NC = SEQ / 32, NSC = (NC + 7) / 8;
    const int lane = F.lane, w = F.wave, hi = lane >> 5, l31 = lane & 31, q = lane >> 4, c16 = lane & 15;
    LAS unsigned char* wl = L + w * 16384;
    LAS float* BUT = (LAS float*)wl; LAS unsigned* Hs = (LAS unsigned*)(wl + 10240); LAS bf16* Us = (LAS bf16*)(wl + 10240 + 4352);
    LAS float* Ex = (LAS float*)X;
    const bf16* ub = (const bf16*)(F.ws + WS_UB); bf16* y5 = (bf16*)(F.ws + WS_Y5);
    S5C c; s5_consts(c, F, g, lane);
    float a32r = c.are, a32i = c.aim;
#pragma unroll
    for (int i = 0; i < 5; ++i) { const float r = a32r * a32r - a32i * a32i, im = 2.f * a32r * a32i; a32r = r; a32i = im; }
    float Hre = 0.f, Him = 0.f;
    bf16x8 ufn = *(const bf16x8*)(ub + (size_t)(b * SEQ + 32 * (w < NC ? w : 0) + l31) * MIX_B + g * 16 + 8 * hi);
    for (int sc = 0; sc < NSC; ++sc) {
        const int ch = 8 * sc + w; const bool act = ch < NC; const int row0 = b * SEQ + 32 * ch;
        const bf16x8 uf = ufn; { const int chn = ch + 8 < NC ? ch + 8 : ch; if (act) ufn = *(const bf16x8*)(ub + (size_t)(b * SEQ + 32 * chn + l31) * MIX_B + g * 16 + 8 * hi); }
        float br_[32], bi_[32];
        float ere = 0.f, eim = 0.f;
        if (act) {
            f32x16 bu[4];
#pragma unroll
            for (int nt = 0; nt < 4; ++nt) { const f32x16 z = {0.f, 0.f, 0.f, 0.f, 0.f, 0.f, 0.f, 0.f, 0.f, 0.f, 0.f, 0.f, 0.f, 0.f, 0.f, 0.f}; bu[nt] = __builtin_amdgcn_mfma_f32_32x32x16_bf16(uf, c.bbf[nt], z, 0, 0, 0); }
            WAVE_LDS_SYNC();
            *(LAS bf16x8*)(Us + l31 * 16 + 8 * hi) = uf;
#pragma unroll
            for (int hf = 0; hf < 2; ++hf) {
                WAVE_LDS_SYNC();
#pragma unroll
                for (int nt = 0; nt < 4; ++nt)
#pragma unroll
                    for (int i2 = 0; i2 < 2; ++i2) { const int i = 2 * hf + i2; *(LAS f32x4*)(BUT + (32 * nt + l31) * 20 + 8 * i2 + 4 * hi) = (f32x4){bu[nt][4 * i], bu[nt][4 * i + 1], bu[nt][4 * i + 2], bu[nt][4 * i + 3]}; }
                WAVE_LDS_SYNC();
#pragma unroll
                for (int j = 0; j < 4; ++j) { const f32x4 x = *(const LAS f32x4*)(BUT + lane * 20 + 4 * j), y = *(const LAS f32x4*)(BUT + (64 + lane) * 20 + 4 * j);
                    br_[16 * hf + 4 * j] = x[0]; br_[16 * hf + 4 * j + 1] = x[1]; br_[16 * hf + 4 * j + 2] = x[2]; br_[16 * hf + 4 * j + 3] = x[3];
                    bi_[16 * hf + 4 * j] = y[0]; bi_[16 * hf + 4 * j + 1] = y[1]; bi_[16 * hf + 4 * j + 2] = y[2]; bi_[16 * hf + 4 * j + 3] = y[3]; }
            }
#pragma unroll
            for (int t = 0; t < 32; ++t) { const float nr = c.are * ere - c.aim * eim + br_[t], ni = c.are * eim + c.aim * ere + bi_[t]; ere = nr; eim = ni; }
        }
        LAS float* Eb = Ex + (sc & 1) * (8 * 64 * 2);
        Eb[(w * 64 + lane) * 2] = ere; Eb[(w * 64 + lane) * 2 + 1] = eim;
        LDS_BARRIER();
        float cre = Hre, cim = Him;
        float hre = 0.f, him = 0.f;
#pragma unroll
        for (int i = 0; i < 8; ++i) { if (i == w) { hre = cre; him = cim; }
            const float e0 = Eb[(i * 64 + lane) * 2], e1 = Eb[(i * 64 + lane) * 2 + 1];
            if (8 * sc + i < NC) { const float nr = a32r * cre - a32i * cim + e0, ni = a32r * cim + a32i * cre + e1; cre = nr; cim = ni; } }
        Hre = cre; Him = cim;
        if (act) {
#pragma unroll
            for (int hf = 0; hf < 2; ++hf) {
                WAVE_LDS_SYNC();
#pragma unroll
                for (int tt = 0; tt < 16; ++tt) { const int t = 16 * hf + tt; const float nr = c.are * hre - c.aim * him + br_[t], ni = c.are * him + c.aim * hre + bi_[t]; hre = nr; him = ni; Hs[tt * 68 + lane] = pk2(hre, him); }
                WAVE_LDS_SYNC();
                f32x4 y = {0.f, 0.f, 0.f, 0.f};
#pragma unroll
                for (int s = 0; s < 4; ++s) { const bf16x8 a = *(const LAS bf16x8*)(Hs + c16 * 68 + 16 * s + 4 * q); y = __builtin_amdgcn_mfma_f32_16x16x32_bf16(a, c.ccf[s], y, 0, 0, 0); }
#pragma unroll
                for (int r = 0; r < 4; ++r) { const int tl = 16 * hf + 4 * q + r; const float u = bf2f(Us[tl * 16 + c16]);
                    y5[(size_t)(row0 + tl) * MIX_B + g * 16 + c16] = (bf16)f2bf(geluf_(y[r] + c.dsk * u)); }
            }
        }
    }
    if (w == 0) { F.out[O_SREP + ((size_t)b * NG + g) * NP + lane] = Hre; F.out[O_SIMP + ((size_t)b * NG + g) * NP + lane] = Him; }
    LDS_BARRIER();
}

static_assert(HD == 128, "state tile byte strides below assume 128 x 128 states");
DEVI void sample_delta_wave(Frame& F, LAS unsigned char* L, int b, int h) {
    constexpr int LDQ = 136, T8 = DEC_SEQ;
    LAS bf16* Qs = (LAS bf16*)L; LAS bf16* Ks = Qs + T8 * LDQ; LAS bf16* Kbs = Ks + T8 * LDQ; LAS bf16* VbS = Kbs + T8 * LDQ; LAS bf16* KgS = VbS + T8 * LDQ;
    LAS float* Ls = (LAS float*)(KgS + T8 * LDQ); LAS float* Td = Ls + 64; LAS bf16* As = (LAS bf16*)(Td + 64); LAS float* gcs = (LAS float*)(As + 64); LAS float* bts = gcs + 8; LAS float* egs = bts + 8;
    const int lane = F.lane, q = lane >> 4, c16 = lane & 15, row0 = MP + b * DEC_SEQ;
    const bf16* qkv = (const bf16*)(F.ws + WS_QKVB); const float* ab = (const float*)(F.ws + WS_AB); const float* cst = F.in[I_SCONV] + (size_t)b * 3 * QKV;
    const bool lo = c16 < 8, q2 = q < 2;
    WAVE_LDS_SYNC();
    { float g = 0.f, bt = 0.f;
      if (lane < T8) { const float* abr = ab + (size_t)(row0 + lane) * 16; const float x = abr[h] + F.in[I_DTBIAS][h]; const float sp = x > 20.f ? x : log1pf(f_exp(x)); g = -f_exp(F.in[I_ALOG][h]) * sp; bt = sigmoidf_(abr[NH + h]); }
      float gc = g;
#pragma unroll
      for (int d = 1; d < 8; d <<= 1) { const float o = __shfl_up(gc, d); if (lane >= d) gc += o; }
      if (lane < T8) { gcs[lane] = gc; bts[lane] = bt; egs[lane] = f_exp(gc); } }
    float val[T8][6], sq[T8], sk[T8];
    { float w4[6][4], win[6][3];
#pragma unroll
      for (int sg = 0; sg < 3; ++sg) { const int gcol = sg * MIX_A + h * HD + 2 * lane;
#pragma unroll
        for (int j = 0; j < 4; ++j) { const f32x2_ t2 = *(const f32x2_*)(F.in[I_WCONV] + (size_t)j * QKV + gcol); w4[sg * 2][j] = t2.x; w4[sg * 2 + 1][j] = t2.y; }
#pragma unroll
        for (int j = 0; j < 3; ++j) { const f32x2_ t2 = *(const f32x2_*)(cst + (size_t)j * QKV + gcol); win[sg * 2][j] = t2.x; win[sg * 2 + 1][j] = t2.y; } }
#pragma unroll
      for (int t = 0; t < T8; ++t) {
#pragma unroll
        for (int sg = 0; sg < 3; ++sg) { const unsigned x = *(const unsigned*)(qkv + (size_t)(row0 + t) * QKV + sg * MIX_A + h * HD + 2 * lane);
#pragma unroll
            for (int e = 0; e < 2; ++e) { const int s6 = sg * 2 + e; const float cur = bf2f(e ? (x >> 16) : x);
                const float cv = w4[s6][0] * win[s6][0] + w4[s6][1] * win[s6][1] + w4[s6][2] * win[s6][2] + w4[s6][3] * cur;
                win[s6][0] = win[s6][1]; win[s6][1] = win[s6][2]; win[s6][2] = cur; val[t][s6] = siluf_(cv); } }
        sq[t] = val[t][0] * val[t][0] + val[t][1] * val[t][1]; sk[t] = val[t][2] * val[t][2] + val[t][3] * val[t][3]; } }
#pragma unroll
    for (int o = 1; o < 64; o <<= 1) {
#pragma unroll
        for (int t = 0; t < T8; ++t) { sq[t] += __shfl_xor(sq[t], o); sk[t] += __shfl_xor(sk[t], o); } }
    WAVE_LDS_SYNC();
#pragma unroll
    for (int t = 0; t < T8; ++t) { const float rq = f_rsqrt(sq[t] + 1e-6f) * 0.08838834764831845f, rk = f_rsqrt(sk[t] + 1e-6f), bt = bts[t], eg = egs[t];
        const float q0 = val[t][0] * rq, q1 = val[t][1] * rq, k0 = val[t][2] * rk, k1 = val[t][3] * rk;
        *(LAS unsigned*)(Qs + t * LDQ + 2 * lane) = pk2(q0, q1); *(LAS unsigned*)(Ks + t * LDQ + 2 * lane) = pk2(k0, k1); *(LAS unsigned*)(Kbs + t * LDQ + 2 * lane) = pk2(k0 * bt, k1 * bt);
        *(LAS unsigned*)(VbS + t * LDQ + 2 * lane) = pk2(val[t][4] * bt, val[t][5] * bt); *(LAS unsigned*)(KgS + t * LDQ + 2 * lane) = pk2(k0 * bt * eg, k1 * bt * eg); }
    WAVE_LDS_SYNC();
    { f32x4 kk = {0.f, 0.f, 0.f, 0.f}, qk = {0.f, 0.f, 0.f, 0.f}; const int rr = lo ? c16 : 0;
#pragma unroll
      for (int s = 0; s < 4; ++s) { bf16x8 a0 = *(const LAS bf16x8*)(Kbs + rr * LDQ + 32 * s + 8 * q), a1 = *(const LAS bf16x8*)(Qs + rr * LDQ + 32 * s + 8 * q), bk = *(const LAS bf16x8*)(Ks + rr * LDQ + 32 * s + 8 * q);
          if (!lo) { a0 = (bf16x8){0, 0, 0, 0, 0, 0, 0, 0}; a1 = a0; bk = a0; }
          kk = __builtin_amdgcn_mfma_f32_16x16x32_bf16(a0, bk, kk, 0, 0, 0); qk = __builtin_amdgcn_mfma_f32_16x16x32_bf16(a1, bk, qk, 0, 0, 0); }
      if (lo && q2) { const float gj = gcs[c16];
#pragma unroll
          for (int r = 0; r < 4; ++r) { const int i = 4 * q + r; const float dec = f_exp(gcs[i] - gj); Ls[i * 8 + c16] = (i > c16) ? kk[r] * dec : 0.f; As[i * 8 + c16] = (bf16)((i >= c16) ? f2bf(qk[r] * dec) : 0u); } } }
    WAVE_LDS_SYNC();
    if (lane < 8) { float x[8];
#pragma unroll
        for (int i = 0; i < 8; ++i) { float sacc = (i == lane) ? 1.f : 0.f;
#pragma unroll
            for (int j = 0; j < i; ++j) sacc -= Ls[i * 8 + j] * x[j];
            x[i] = sacc; Td[i * 8 + lane] = sacc; } }
    { const float gl = gcs[T8 - 1];
#pragma unroll
      for (int t = 0; t < T8; ++t) { const float eq = egs[t], ek = f_exp(gl - gcs[t]); const unsigned qx = *(LAS unsigned*)(Qs + t * LDQ + 2 * lane), kx = *(LAS unsigned*)(Ks + t * LDQ + 2 * lane);
          *(LAS unsigned*)(Qs + t * LDQ + 2 * lane) = pk2(bf2f(qx) * eq, bf2f(qx >> 16) * eq); *(LAS unsigned*)(Ks + t * LDQ + 2 * lane) = pk2(bf2f(kx) * ek, bf2f(kx >> 16) * ek); } }
    WAVE_LDS_SYNC();
    bf16x8 tdf = {0, 0, 0, 0, 0, 0, 0, 0};
    if (lo && q2) { const f32x4 t4 = *(const LAS f32x4*)(Td + c16 * 8 + 4 * q); const u32x4 p = {pk2(t4[0], t4[1]), pk2(t4[2], t4[3]), 0u, 0u}; tdf = __builtin_bit_cast(bf16x8, p); }
#pragma unroll
    for (int nt = 0; nt < 8; ++nt) { const LAS bf16* R = KgS + 16 * nt + c16; u32x4 pb = {0u, 0u, 0u, 0u};
        if (q2) { pb.x = (unsigned)R[(4 * q) * LDQ] | ((unsigned)R[(4 * q + 1) * LDQ] << 16); pb.y = (unsigned)R[(4 * q + 2) * LDQ] | ((unsigned)R[(4 * q + 3) * LDQ] << 16); }
        const f32x4 z4 = {0.f, 0.f, 0.f, 0.f}; const f32x4 xr = __builtin_amdgcn_mfma_f32_16x16x32_bf16(tdf, __builtin_bit_cast(bf16x8, pb), z4, 0, 0, 0);
        if (q2) {
#pragma unroll
            for (int r = 0; r < 4; ++r) Kbs[(4 * q + r) * LDQ + 16 * nt + c16] = (bf16)f2bf(-xr[r]); } }
    WAVE_LDS_SYNC();
    bf16x8 Wf[4], Qf[4], Af, Kf[8];
    { const int rr = lo ? c16 : 0;
#pragma unroll
      for (int s = 0; s < 4; ++s) { const u32x2 wl_ = *(const LAS u32x2*)(Kbs + rr * LDQ + 32 * s + 4 * q), wh = *(const LAS u32x2*)(Kbs + rr * LDQ + 32 * s + 16 + 4 * q), ql = *(const LAS u32x2*)(Qs + rr * LDQ + 32 * s + 4 * q), qh = *(const LAS u32x2*)(Qs + rr * LDQ + 32 * s + 16 + 4 * q);
          u32x4 pw = {wl_.x, wl_.y, wh.x, wh.y}, pq = {ql.x, ql.y, qh.x, qh.y}; if (!lo) { pw = (u32x4){0u, 0u, 0u, 0u}; pq = pw; }
          Wf[s] = __builtin_bit_cast(bf16x8, pw); Qf[s] = __builtin_bit_cast(bf16x8, pq); }
      u32x4 pa = {0u, 0u, 0u, 0u}; if (lo && q2) { const u32x2 al = *(const LAS u32x2*)(As + c16 * 8 + 4 * q); pa.x = al.x; pa.y = al.y; } Af = __builtin_bit_cast(bf16x8, pa);
#pragma unroll
      for (int T = 0; T < 8; ++T) { u32x4 pk_ = {0u, 0u, 0u, 0u};
          if (q2) { const LAS bf16* kp = Ks + (4 * q) * LDQ + 16 * T + c16; pk_.x = (unsigned)kp[0] | ((unsigned)kp[LDQ] << 16); pk_.y = (unsigned)kp[2 * LDQ] | ((unsigned)kp[3 * LDQ] << 16); }
          Kf[T] = __builtin_bit_cast(bf16x8, pk_); } }
    const float egl = egs[T8 - 1];
    const char* s0 = (const char*)(F.in[I_SDELTA] + ((size_t)b * NH + h) * HD * HD); char* so = (char*)(F.out + O_DELS + ((size_t)b * NH + h) * HD * HD);
    const unsigned lof = (unsigned)(((4 * q) * HD + c16) * 4);
    char* op = (char*)((bf16*)(F.ws + WS_H12) + (size_t)row0 * D + h * HD); const unsigned oo = (unsigned)(((4 * q) * D + c16) * 2);
    f32x4 Sn[8];
#pragma unroll
    for (int T = 0; T < 8; ++T) { const char* sp = s0 + (lof + 8192u * T); Sn[T] = (f32x4){*(const float*)sp, *(const float*)(sp + 512), *(const float*)(sp + 1024), *(const float*)(sp + 1536)}; }
#pragma unroll 1
    for (int vs = 0; vs < 8; ++vs) {
        f32x4 S[8];
#pragma unroll
        for (int T = 0; T < 8; ++T) S[T] = Sn[T];
        if (vs + 1 < 8) {
#pragma unroll
            for (int T = 0; T < 8; ++T) { const char* sp = s0 + (lof + 8192u * T + 64u * (vs + 1)); Sn[T] = (f32x4){*(const float*)sp, *(const float*)(sp + 512), *(const float*)(sp + 1024), *(const float*)(sp + 1536)}; } }
        bf16x8 Sb[4];
#pragma unroll
        for (int s = 0; s < 4; ++s) { u32x4 p; p.x = pk2(S[2 * s][0], S[2 * s][1]); p.y = pk2(S[2 * s][2], S[2 * s][3]); p.z = pk2(S[2 * s + 1][0], S[2 * s + 1][1]); p.w = pk2(S[2 * s + 1][2], S[2 * s + 1][3]); Sb[s] = __builtin_bit_cast(bf16x8, p); }
        f32x4 vn, o = {0.f, 0.f, 0.f, 0.f};
        { const LAS bf16* R = VbS + 16 * vs + c16; u32x4 pb = {0u, 0u, 0u, 0u};
          if (q2) { pb.x = (unsigned)R[(4 * q) * LDQ] | ((unsigned)R[(4 * q + 1) * LDQ] << 16); pb.y = (unsigned)R[(4 * q + 2) * LDQ] | ((unsigned)R[(4 * q + 3) * LDQ] << 16); }
          const f32x4 z4 = {0.f, 0.f, 0.f, 0.f}; vn = __builtin_amdgcn_mfma_f32_16x16x32_bf16(tdf, __builtin_bit_cast(bf16x8, pb), z4, 0, 0, 0); }
#pragma unroll
        for (int s = 0; s < 4; ++s) { vn = __builtin_amdgcn_mfma_f32_16x16x32_bf16(Wf[s], Sb[s], vn, 0, 0, 0); o = __builtin_amdgcn_mfma_f32_16x16x32_bf16(Qf[s], Sb[s], o, 0, 0, 0); }
        const u32x4 pv = {pk2(vn[0], vn[1]), pk2(vn[2], vn[3]), 0u, 0u}; const bf16x8 vb = __builtin_bit_cast(bf16x8, pv);
        o = __builtin_amdgcn_mfma_f32_16x16x32_bf16(Af, vb, o, 0, 0, 0);
#pragma unroll
        for (int T = 0; T < 8; ++T) { S[T] *= egl; S[T] = __builtin_amdgcn_mfma_f32_16x16x32_bf16(Kf[T], vb, S[T], 0, 0, 0);
            char* sp = so + (lof + 8192u * T + 64u * vs); *(float*)sp = S[T][0]; *(float*)(sp + 512) = S[T][1]; *(float*)(sp + 1024) = S[T][2]; *(float*)(sp + 1536) = S[T][3]; }
        if (q2) { char* o2 = op + (oo + 32u * vs); *(bf16*)o2 = (bf16)f2bf(o[0]); *(bf16*)(o2 + 2 * D) = (bf16)f2bf(o[1]); *(bf16*)(o2 + 4 * D) = (bf16)f2bf(o[2]); *(bf16*)(o2 + 6 * D) = (bf16)f2bf(o[3]); }
    }
}

constexpr int LDS_X_OFF = RING_BYTES + 256;
#define TSMARK(i) do { if (TS_PHASE == 50 + (i)) ts0 = __builtin_amdgcn_s_memrealtime(); if (TS_PHASE == 50 + (i) - 1) ts1 = __builtin_amdgcn_s_memrealtime(); } while (0)
DEVI void p5_mix(Frame& F, unsigned long long& ts0, unsigned long long& ts1) {
    TSMARK(0);
    using OL = PrepLds<16>;
    constexpr int FRAG_OFF = (OL::END + 255) & ~255;
    static_assert(FRAG_OFF + CHUNK_BYTES <= RING_BYTES && LDS_X_OFF + 8192 <= LDS_BYTES - 16, "lds");
    TSMARK(1);
    for (int j = F.vcu; j < BATCH * NH * 8; j += F.G) { const int vs = j % 8, bh = j / 8, h = bh % NH, b = bh / NH;
        delta_apply8(F, F.lds + LDS_X_OFF, F.ws + WS_FRAG + (size_t)bh * (SEQ / CHUNK) * CHUNK_BYTES, CHUNK_BYTES, SEQ / CHUNK, F.out + O_DELP + (size_t)bh * HD * HD,
                     (bf16*)(F.ws + WS_H12) + (size_t)(b * SEQ) * D + h * HD, vs, ts1); }
    TSMARK(2);
    for (int j = F.vcu; j < BATCH * NG; j += F.G) s5_block(F, F.lds, F.lds + LDS_X_OFF, j / NG, j % NG);
    TSMARK(3);
    constexpr int NJ_SD = DEC_BATCH * NH, NJ_SS = (DEC_BATCH / 4) * NG;
    const int gw = F.wave * F.G + F.vcu, NGW = F.G * NWAVES;
    LAS unsigned char* wl = F.lds + F.wave * 16384;
    if (NGW >= 2 * NJ_SD) {
        if (gw < NJ_SD) sample_delta_wave(F, wl, gw / NH, gw % NH);
        else for (int jj = gw - NJ_SD; jj < NJ_SS; jj += NGW - NJ_SD) { const int bq = jj / NG, g = jj % NG; s5_job<true>(F, wl, MP + bq * 32, 32, g, bq * 4); }
    } else
    for (int j = gw; j < NJ_SD + NJ_SS; j += NGW) {
        if (j < NJ_SD) sample_delta_wave(F, wl, j / NH, j % NH);
        else { const int jj = j - NJ_SD, bq = jj / NG, g = jj % NG; s5_job<true>(F, wl, MP + bq * 32, 32, g, bq * 4); } }
#if LATE_CONV
    { const bool spare = NGW > NJ_SD;
      const int nh = spare ? NGW - NJ_SD : NGW, hw = spare ? gw - NJ_SD : gw;
      if (hw >= 0) for (int it = hw; it < I_LATE; it += nh) conv_item(F, (LAS float*)wl, I_IN + it); }
#endif
    LDS_BARRIER();
    TSMARK(4);
}

#ifndef HOST_EMU
#define XB_TMO      128
#define XB_XCNT(j)  (256  + 64 * (j))
#define XB_XSUB(j)  (1280 + 64 * (j))
#define XB_XGEN(j)  (2304 + 64 * (j))
#define XB_TOP      3328
#define XB_TOPGEN   3392
#define XCD_BAR_WORDS 3456
#define XB_SPIN_CAP (1u << 18)
__device__ __forceinline__ unsigned xb_ld(unsigned* p)              { return __hip_atomic_load(p, __ATOMIC_RELAXED, __HIP_MEMORY_SCOPE_AGENT); }
__device__ __forceinline__ unsigned xb_add(unsigned* p, unsigned v) { return __hip_atomic_fetch_add(p, v, __ATOMIC_RELAXED, __HIP_MEMORY_SCOPE_AGENT); }
__device__ __forceinline__ unsigned xb_xcc_id() { return (unsigned)__builtin_amdgcn_s_getreg((3 << 11) | 20) & 0xFu; }
#define XB_SPIN(cond, bar) do { unsigned _sp = 0; while (cond) { __builtin_amdgcn_s_sleep(1); \
    if ((++_sp & 255u) == 0u) { if (xb_ld(&(bar)[XB_TMO])) break; if (_sp > XB_SPIN_CAP) { atomicAdd(&(bar)[XB_TMO], 1u); break; } } } } while (0)
struct XcdBarrier { unsigned* bar; unsigned x; volatile LAS unsigned* st; };
__device__ __forceinline__ XcdBarrier xcd_barrier_post(unsigned* bar, volatile LAS unsigned* st) {
    XcdBarrier b; b.bar = bar; b.x = xb_xcc_id(); b.st = st;
    if (threadIdx.x == 0) (void)xb_add(&bar[XB_XCNT(b.x)], 1u);
    return b;
}
__device__ __forceinline__ void xcd_barrier_complete(unsigned* bar, unsigned x, unsigned& nloc, unsigned& nx) {
    const unsigned G = gridDim.x * gridDim.y * gridDim.z;
    unsigned sum, cnt, mine, sp = 0u;
    for (;;) {
        sum = 0u; cnt = 0u; mine = 0u;
#pragma unroll
        for (unsigned j = 0; j < 16; ++j) { const unsigned c = xb_ld(&bar[XB_XCNT(j)]); sum += c; cnt += (c > 0u) ? 1u : 0u; mine = (j == x) ? c : mine; }
        if (sum == G) break;
        __builtin_amdgcn_s_sleep(1);
        if ((++sp & 255u) == 0u) { if (xb_ld(&bar[XB_TMO])) break; if (sp > XB_SPIN_CAP) { atomicAdd(&bar[XB_TMO], 1u); break; } }
    }
    nloc = mine > 0u ? mine : 1u; nx = cnt > 0u ? cnt : 1u;
}
__device__ __forceinline__ void xcd_barrier(const XcdBarrier& b, unsigned& seq) {
    asm volatile("s_waitcnt vmcnt(0)" ::: "memory");
    __syncthreads();
    if (threadIdx.x == 0) {
        unsigned* bar = b.bar;
        __builtin_amdgcn_s_waitcnt(0);
        unsigned nloc = b.st[0], nx = b.st[1];
        if (nloc == 0u) { xcd_barrier_complete(bar, b.x, nloc, nx); b.st[0] = nloc; b.st[1] = nx; }
        const unsigned old = xb_add(&bar[XB_XSUB(b.x)], 1u);
        const unsigned gen = old / nloc;
        if (old + 1u == (gen + 1u) * nloc) {
            __builtin_amdgcn_fence(__ATOMIC_RELEASE, "agent");
            asm volatile("s_waitcnt vmcnt(0)" ::: "memory");
            const unsigned og = xb_add(&bar[XB_TOP], 1u);
            const unsigned tg = og / nx;
            if (og + 1u == (tg + 1u) * nx) xb_add(&bar[XB_TOPGEN], 1u);
        }
        { unsigned sp_ = 0;
          while (xb_ld(&bar[XB_TOPGEN]) <= seq) { if ((++sp_ & 255u) == 0u) { if (xb_ld(&bar[XB_TMO])) break; if (sp_ > XB_SPIN_CAP) { atomicAdd(&bar[XB_TMO], 1u); break; } } } }
        __builtin_amdgcn_fence(__ATOMIC_ACQUIRE, "agent");
        asm volatile("s_waitcnt vmcnt(0)" ::: "memory");
    }
    ++seq;
    __syncthreads();
}
#endif

constexpr int NPHASE = 12;
#ifndef MK_COOP
#define MK_COOP 1
#endif
#ifndef MK_PLAIN
#define MK_PLAIN 0
#endif
#ifndef MK_XCDBAR
#define MK_XCDBAR 1
#endif
constexpr int CTL_BAR_WORD = 1024;
#ifndef SELF_INIT
#define SELF_INIT 1
#endif
constexpr int CTL_FLAG_WORD = 64; constexpr unsigned CTL_MAGIC = 0x5EA1F1A6u;
constexpr int LDS_ST_OFF = LDS_BYTES - 16;
static_assert(PrepLds<CHUNK>::END <= LDS_ST_OFF, "prep scratch vs barrier words");
__global__ void __launch_bounds__(NTHREADS, 2) fwd_kernel(Args args) {
#ifdef HOST_EMU
    unsigned char* lds = emu_lds();
#else
    extern __shared__ __attribute__((aligned(16))) unsigned char lds[];
#endif
    Frame F; F.lds = (LAS unsigned char*)lds; F.in = args.in; F.out = args.out; F.ws = args.ws;
    F.tid = threadIdx.x; F.lane = F.tid & 63; F.wave = __builtin_amdgcn_readfirstlane(F.tid >> 6);
    F.G = gridDim.x; { const int bx = blockIdx.x; F.vcu = (F.G % 8 == 0) ? (bx % 8) * (F.G / 8) + bx / 8 : bx; }
    const int lo = args.ph_lo, hi = args.ph_hi;
#ifdef HOST_EMU
#define GRID_SYNC() emu_grid_sync()
#elif MK_COOP && MK_XCDBAR
#if !MK_PLAIN
    cg::grid_group grid = cg::this_grid();
#endif
    if (F.tid < 2) ((LAS unsigned*)(F.lds + LDS_ST_OFF))[F.tid] = 0u;
#if SELF_INIT
    unsigned* ctlw = (unsigned*)(F.ws + WS_CTL);
    if (blockIdx.x == 0) {
        for (int i = F.tid; i < XCD_BAR_WORDS; i += NTHREADS) __hip_atomic_store(&ctlw[CTL_BAR_WORD + i], 0u, __ATOMIC_RELAXED, __HIP_MEMORY_SCOPE_AGENT);
        asm volatile("s_waitcnt vmcnt(0)" ::: "memory");
        __syncthreads();
        if (F.tid == 0) { __builtin_amdgcn_fence(__ATOMIC_RELEASE, "agent"); __hip_atomic_store(&ctlw[CTL_FLAG_WORD], CTL_MAGIC, __ATOMIC_RELEASE, __HIP_MEMORY_SCOPE_AGENT); }
    }
    XcdBarrier xbar;
#else
    __syncthreads();
    const XcdBarrier xbar = xcd_barrier_post((unsigned*)(F.ws + WS_CTL) + CTL_BAR_WORD, (volatile LAS unsigned*)(F.lds + LDS_ST_OFF));
#endif
#if !MK_PLAIN
    if (args.ph_lo < 0) grid.sync();
#endif
    unsigned bar_seq = 0u;
#define GRID_SYNC() xcd_barrier(xbar, bar_seq)
#elif MK_COOP
    cg::grid_group grid = cg::this_grid();
#define GRID_SYNC() grid.sync()
#else
#define GRID_SYNC() do {} while (0)
#endif
#ifndef PHASE_MASK
#define PHASE_MASK 0xFFFF
#endif
#define IN(k) ((((PHASE_MASK) >> (k)) & 1) && lo <= (k) && (k) < hi)
#ifndef REPEAT_MASK
#define REPEAT_MASK 0x0
#endif
#define REP(k) ((((REPEAT_MASK) >> (k)) & 1) ? 2 : 1)
#ifndef TS_DIV
#define TS_DIV 100.0f
#endif
    unsigned long long ts0 = 0, ts1 = 0;
#define SEAM(k) do { if (IN(k) && IN((k) + 1)) GRID_SYNC(); if (TS_PHASE == (k)) ts1 = __builtin_amdgcn_s_memrealtime(); if (TS_PHASE == (k) + 1) ts0 = __builtin_amdgcn_s_memrealtime(); } while (0)
    using namespace pg8;
    if (TS_PHASE == 0 || TS_PHASE == 99) ts0 = __builtin_amdgcn_s_memrealtime();
    if (IN(0)) { p0_prologue(F); }
#if !defined(HOST_EMU) && MK_COOP && MK_XCDBAR && SELF_INIT
    {   if (F.tid == 0) { unsigned sp = 0; while (__hip_atomic_load(&ctlw[CTL_FLAG_WORD], __ATOMIC_ACQUIRE, __HIP_MEMORY_SCOPE_AGENT) != CTL_MAGIC) { __builtin_amdgcn_s_sleep(2); if (++sp > (1u << 22)) break; } }
        __syncthreads();
        xbar = xcd_barrier_post(ctlw + CTL_BAR_WORD, (volatile LAS unsigned*)(F.lds + LDS_ST_OFF)); }
#endif
    SEAM(0);
    if (IN(1)) { for (int rep = 0; rep < REP(1); ++rep) { p1_ada(F, ts0, ts1); if (rep + 1 < REP(1)) GRID_SYNC(); } } if (TS_PHASE == 74) ts0 = __builtin_amdgcn_s_memrealtime(); SEAM(1); if (TS_PHASE == 74) ts1 = __builtin_amdgcn_s_memrealtime();
    if (IN(2)) { for (int rep = 0; rep < REP(2); ++rep) { p2_h1(F); if (rep + 1 < REP(2)) GRID_SYNC(); } } SEAM(2);
    if (IN(3)) {
        {
        Gemm g{(const bf16*)(F.ws + WS_H12), (const bf16*)(F.ws + WS_WIN), M, NIN, D}; StaticOrder S; S.init(M, NIN, D, F.G, (int)blockIdx.x);
        EpiInProj E{0, (bf16*)(F.ws + WS_QKVB), (bf16*)(F.ws + WS_ZB), (bf16*)(F.ws + WS_UB), (float*)(F.ws + WS_AB), F.out + O_CONVP, F.out + O_CONVS};
        gemm_phase<EpiInProj, StaticOrder, true, true>(F.lds, g, S, E);
        }
        if (REP(3) == 2) { GRID_SYNC();
        Gemm g{(const bf16*)(F.ws + WS_H12), (const bf16*)(F.ws + WS_WIN), M, NIN, D}; StaticOrder S; S.init(M, NIN, D, F.G, (int)blockIdx.x);
        EpiInProj E{0, (bf16*)(F.ws + WS_QKVB), (bf16*)(F.ws + WS_ZB), (bf16*)(F.ws + WS_UB), (float*)(F.ws + WS_AB), F.out + O_CONVP, F.out + O_CONVS};
        gemm_phase<EpiInProj, StaticOrder, true, true>(F.lds, g, S, E);
        }
    } SEAM(3);
    if (IN(4)) { for (int rep = 0; rep < REP(4); ++rep) { p4_prep(F); if (rep + 1 < REP(4)) GRID_SYNC(); } } SEAM(4);
    if (IN(5)) { for (int rep = 0; rep < REP(5); ++rep) { p5_mix(F, ts0, ts1); if (rep + 1 < REP(5)) GRID_SYNC(); } } SEAM(5);
    if (IN(6)) {
        Gemm g{(const bf16*)(F.ws + WS_Y5), (const bf16*)(F.ws + WS_WGLU), M, 2 * MIX_B, MIX_B}; StaticOrder S; S.init(M, 2 * MIX_B, MIX_B, F.G, (int)blockIdx.x);
        EpiGlu E{0, (bf16*)(F.ws + WS_ACAT), (unsigned long long*)(F.ws + WS_CTL + CTL_RS5)};
        gemm_phase<EpiGlu, StaticOrder, true, true>(F.lds, g, S, E);
        const int rem = S.nwg % F.G, nheavy = (S.nwg > F.G && rem * 2 <= F.G) ? rem : 0;
        if ((int)blockIdx.x >= nheavy) p6_onorm(F, (int)blockIdx.x - nheavy, F.G - nheavy);
    } SEAM(6);
    if (IN(7)) {
        {
        Gemm g{(const bf16*)(F.ws + WS_ACAT), (const bf16*)(F.ws + WS_WOUT), M, D, D}; SplitOrder S; S.init(MP, M, D, D, KS_OUT, F.G, (int)blockIdx.x);
        EpiF32Rs<true> E{MIX_B / 64, (bf16*)(F.ws + WS_MIX), (bf16*)(F.ws + WS_MIXS), (const unsigned long long*)(F.ws + WS_CTL + CTL_RS5)};
        gemm_phase<EpiF32Rs<true>, SplitOrder, true, true>(F.lds, g, S, E);
        }
        if (REP(7) == 2) { GRID_SYNC();
        Gemm g{(const bf16*)(F.ws + WS_ACAT), (const bf16*)(F.ws + WS_WOUT), M, D, D}; SplitOrder S; S.init(MP, M, D, D, KS_OUT, F.G, (int)blockIdx.x);
        EpiF32Rs<true> E{MIX_B / 64, (bf16*)(F.ws + WS_MIX), (bf16*)(F.ws + WS_MIXS), (const unsigned long long*)(F.ws + WS_CTL + CTL_RS5)};
        gemm_phase<EpiF32Rs<true>, SplitOrder, true, true>(F.lds, g, S, E);
        }
    } SEAM(7);
    if (IN(8)) { p8_x1h2(F); } SEAM(8);
    if (IN(9)) {
        Gemm g{(const bf16*)(F.ws + WS_H12), (const bf16*)(F.ws + WS_WGU), M, 2 * D_FF, D}; StaticOrder S; S.init(M, 2 * D_FF, D, F.G, (int)blockIdx.x);
        EpiSwiglu E{0, (bf16*)(F.ws + WS_HMID)};
        gemm_phase<EpiSwiglu, StaticOrder, true, true>(F.lds, g, S, E);
#if DN_LATE && !LATE_CONV
        { const int rem = S.nwg % F.G, nheavy = (S.nwg > F.G && rem * 2 <= F.G) ? rem : 0;
          if ((int)blockIdx.x >= nheavy) { const int nb = F.G - nheavy, hw = ((int)blockIdx.x - nheavy) * NWAVES + F.wave;
              for (int it = hw; it < I_DN; it += nb * NWAVES) conv_item(F, (LAS float*)(F.lds + F.wave * 16384), I_IN + I_LATE - I_DN + it); } }
#endif
    } SEAM(9);
    if (IN(10)) {
        {
        Gemm g{(const bf16*)(F.ws + WS_HMID), (const bf16*)(F.ws + WS_WDN), M, D, D_FF}; SplitOrder S; S.init(MP, M, D, D_FF, KS_DN, F.G, (int)blockIdx.x);
        EpiF32Rs<false> E{0, (bf16*)(F.ws + WS_F), (bf16*)(F.ws + WS_FS), nullptr};
        gemm_phase<EpiF32Rs<false>, SplitOrder, true, true>(F.lds, g, S, E);
        }
        if (REP(10) == 2) { GRID_SYNC();
        Gemm g{(const bf16*)(F.ws + WS_HMID), (const bf16*)(F.ws + WS_WDN), M, D, D_FF}; SplitOrder S; S.init(MP, M, D, D_FF, KS_DN, F.G, (int)blockIdx.x);
        EpiF32Rs<false> E{0, (bf16*)(F.ws + WS_F), (bf16*)(F.ws + WS_FS), nullptr};
        gemm_phase<EpiF32Rs<false>, SplitOrder, true, true>(F.lds, g, S, E);
        }
    } SEAM(10);
#if !defined(HOST_EMU) && MK_COOP && MK_XCDBAR && SELF_INIT
    if (blockIdx.x == 0 && F.tid == 0) __hip_atomic_store(&ctlw[CTL_FLAG_WORD], 0u, __ATOMIC_RELAXED, __HIP_MEMORY_SCOPE_AGENT);
#endif
    if (IN(11)) { for (int rep = 0; rep < REP(11); ++rep) { p11_out(F); if (rep + 1 < REP(11)) GRID_SYNC(); } }
#if TS_PHASE >= 0
    if (TS_PHASE == 11 || TS_PHASE == 99) ts1 = __builtin_amdgcn_s_memrealtime();
    if (blockIdx.x == 0 && F.tid == 0) F.out[O_YP] += (float)(ts1 - ts0) / TS_DIV;
#endif
    (void)ts0; (void)ts1;
#undef IN
#undef SEAM
}

#ifndef HOST_EMU
extern "C" void kernel_launch(void* const* d_in, const int* in_sizes, int n_in, void* d_out, int out_size, void* d_ws, size_t ws_size, hipStream_t stream) {
    static int grid = 0;
    if (grid == 0) {
        if (n_in != N_IN || (size_t)out_size != O_END || ws_size < WS_END) { fprintf(stderr, "kernel_launch: unexpected sizes n_in %d out %d ws %zu (need %zu)\n", n_in, out_size, ws_size, (size_t)WS_END); grid = -1; return; }
        int dev = 0, cus = 0, per_cu = 0;
        hipGetDevice(&dev); hipDeviceGetAttribute(&cus, hipDeviceAttributeMultiprocessorCount, dev);
        hipFuncSetAttribute((const void*)fwd_kernel, hipFuncAttributeMaxDynamicSharedMemorySize, LDS_BYTES);
        hipOccupancyMaxActiveBlocksPerMultiprocessor(&per_cu, (const void*)fwd_kernel, NTHREADS, LDS_BYTES);
        if (per_cu < 1) { fprintf(stderr, "kernel_launch: occupancy query says %d blocks per CU\n", per_cu); per_cu = 1; }
        grid = cus * 1;
        (void)hipGetLastError();
    }
    if (grid < 0) return;
#if !(MK_COOP && MK_XCDBAR && SELF_INIT)
    hipMemsetAsync((char*)d_ws + WS_CTL, 0, CTL_USED, stream);
#endif
    Args a{};
    for (int i = 0; i < N_IN; ++i) a.in[i] = (const float*)d_in[i];
    a.out = (float*)d_out; a.ws = (unsigned char*)d_ws;
#if MK_COOP && MK_PLAIN
    a.ph_lo = 0; a.ph_hi = NPHASE;
    hipLaunchKernelGGL(fwd_kernel, dim3(grid), dim3(NTHREADS), LDS_BYTES, stream, a);
#elif MK_COOP
    a.ph_lo = 0; a.ph_hi = NPHASE;
    void* params[] = {&a};
    hipError_t e = hipLaunchCooperativeKernel((const void*)fwd_kernel, dim3(grid), dim3(NTHREADS), params, LDS_BYTES, stream);
    if (e != hipSuccess) fprintf(stderr, "cooperative launch failed: %s\n", hipGetErrorString(e));
#else
    for (int p = 0; p < NPHASE; ++p) { a.ph_lo = p; a.ph_hi = p + 1; hipLaunchKernelGGL(fwd_kernel, dim3(grid), dim3(NTHREADS), LDS_BYTES, stream, a); }
#endif
}
#endif
```
